# Optimizing an MI355X kernel written in HIP

```python
import jax
import jax.numpy as jnp
from jax import lax
import numpy as np

D_MODEL = 1024
BATCH = 8
SEQ = 2048
DEPTH = 2
DEC_BATCH = 32
DEC_SEQ = 8
PAST_LEN = 16384
PAGE_SIZE = 128

N_MIXERS = 2
N_LAYERS_A = (DEPTH + 1) // 2
N_LAYERS_B = DEPTH // 2
EPS = 1e-6
L2_EPS = 1e-6

H_A = 8
DK_A = 128
DV_A = 128
WIDTH_A = H_A * DV_A
CONV_W = 4
CONV_DIM = H_A * (2 * DK_A + DV_A)
CHUNK = 64
W_IN_A = CONV_DIM + WIDTH_A + 2 * H_A

H_B = 8
DH_B = 128
DIL_GROUPS = ((128, 1), (512, 4), (2048, 16))
N_GROUPS = len(DIL_GROUPS)
WIDTH_B = H_B * DH_B
W_IN_B = 3 * N_GROUPS * WIDTH_B + WIDTH_B
ATTN_SCALE = DH_B ** -0.5

kernel_name = 'hybrid_gdn_dilated_window_step'


def rms_norm(x, g):
    xf = x.astype(jnp.float32)
    y = xf * lax.rsqrt(jnp.mean(xf * xf, axis=-1, keepdims=True) + EPS)
    return (y * g.astype(jnp.float32)).astype(x.dtype)


def l2_normalize(x):
    xf = x.astype(jnp.float32)
    return xf * lax.rsqrt(jnp.sum(xf * xf, axis=-1, keepdims=True) + L2_EPS)


def ada_modulate(x, c, norm_g, ada_w, ada_b):
    mod = jnp.einsum('bd,de->be', jax.nn.silu(c), ada_w) + ada_b
    shift, scale, gate = jnp.split(mod[:, None, :], 3, axis=-1)
    h = rms_norm(x, norm_g) * (1 + scale) + shift
    return h, gate


def causal_conv_silu(u, buf, w):
    L = u.shape[1]
    ext = jnp.concatenate([buf.astype(u.dtype), u], axis=1)
    y = ext[:, 0:L] * w[0]
    for i in range(1, CONV_W):
        y = y + ext[:, i:i + L] * w[i]
    return jax.nn.silu(y), ext[:, L:]


def gated_delta_rule(q, k, v, g, beta, S0):
    B, L, H, DK = q.shape
    DV = v.shape[-1]
    C = min(CHUNK, L)
    pad = (-L) % C
    if pad:
        pw = ((0, 0), (0, pad), (0, 0), (0, 0))
        q, k, v = jnp.pad(q, pw), jnp.pad(k, pw), jnp.pad(v, pw)
        g, beta = jnp.pad(g, pw[:3]), jnp.pad(beta, pw[:3])
    n = (L + pad) // C

    def blocks(t):
        t = t.reshape((B, n, C, H) + t.shape[3:])
        return jnp.moveaxis(t, (1, 3), (0, 2))

    qc, kc, vc, bc = blocks(q), blocks(k), blocks(v), blocks(beta)
    gc = jnp.cumsum(blocks(g), axis=-1)
    pos = jnp.arange(C)
    tril = pos[:, None] >= pos[None, :]
    strict = pos[:, None] > pos[None, :]
    diff = gc[..., :, None] - gc[..., None, :]
    decay = jnp.where(tril, jnp.exp(jnp.where(tril, diff, 0.0)), 0.0)
    kb = kc * bc[..., None]
    n_mat = jnp.where(strict, jnp.einsum('nbhik,nbhjk->nbhij', kb, kc) * decay, 0.0)
    a_mat = n_mat + jnp.eye(C, dtype=n_mat.dtype)
    rhs = jnp.concatenate([vc * bc[..., None], kb * jnp.exp(gc)[..., None]], axis=-1)
    sol = lax.linalg.triangular_solve(a_mat, rhs, left_side=True, lower=True, unit_diagonal=True)
    w_val, k_cum = sol[..., :DV], sol[..., DV:]
    qk = jnp.einsum('nbhik,nbhjk->nbhij', qc, kc) * decay
    q_dec = qc * jnp.exp(gc)[..., None]
    k_dec = kc * jnp.exp(gc[..., -1:] - gc)[..., None]
    g_tot = jnp.exp(gc[..., -1])

    def step(S, xs):
        w_c, kcum_c, qk_c, qdec_c, kdec_c, gtot_c = xs
        u = w_c - jnp.einsum('bhck,bhkv->bhcv', kcum_c, S)
        o = jnp.einsum('bhck,bhkv->bhcv', qdec_c, S) + jnp.einsum('bhij,bhjv->bhiv', qk_c, u)
        S = S * gtot_c[..., None, None] + jnp.einsum('bhck,bhcv->bhkv', kdec_c, u)
        return S, o

    S, o = lax.scan(step, S0, (w_val, k_cum, qk, q_dec, k_dec, g_tot))
    o = jnp.moveaxis(o, (0, 2), (1, 3)).reshape(B, n * C, H, DV)[:, :L]
    return o, S


def mixer_a(h, conv_buf, S0, w_in, conv_w, A_log, dt_bias, out_g, w_out):
    B, L, _ = h.shape
    proj = jnp.einsum('bld,de->ble', h, w_in)
    qkv = proj[..., :CONV_DIM]
    z = proj[..., CONV_DIM:CONV_DIM + WIDTH_A]
    a = proj[..., CONV_DIM + WIDTH_A:CONV_DIM + WIDTH_A + H_A]
    b = proj[..., CONV_DIM + WIDTH_A + H_A:]
    qkv, new_buf = causal_conv_silu(qkv, conv_buf, conv_w)
    q = l2_normalize(qkv[..., :H_A * DK_A].reshape(B, L, H_A, DK_A)) * (DK_A ** -0.5)
    k = l2_normalize(qkv[..., H_A * DK_A:2 * H_A * DK_A].reshape(B, L, H_A, DK_A))
    v = qkv[..., 2 * H_A * DK_A:].reshape(B, L, H_A, DV_A).astype(jnp.float32)
    g = -jnp.exp(A_log.astype(jnp.float32)) * jax.nn.softplus(a.astype(jnp.float32) + dt_bias.astype(jnp.float32))
    beta = jax.nn.sigmoid(b.astype(jnp.float32))
    o, S = gated_delta_rule(q, k, v, g, beta, S0.astype(jnp.float32))
    o = rms_norm(o, out_g).reshape(B, L, WIDTH_A) * jax.nn.silu(z.astype(jnp.float32))
    y = jnp.einsum('ble,ed->bld', o.astype(h.dtype), w_out)
    return y, new_buf, S


def dilated_attn_prompt(q, k, v, window, dil):
    B, S, H, Dh = q.shape
    n = window // dil
    Sd = S // dil
    blk = n
    nb = -(-Sd // blk)
    Sp = nb * blk

    def sub(t):
        t = t.reshape(B, Sd, dil, H, Dh).transpose(0, 2, 1, 3, 4)
        t = jnp.pad(t, ((0, 0), (0, 0), (0, Sp - Sd), (0, 0), (0, 0)))
        return t.reshape(B, dil, nb, blk, H, Dh)

    def with_prev(t):
        prev = jnp.pad(t, ((0, 0), (0, 0), (1, 0), (0, 0), (0, 0), (0, 0)))[:, :, :-1]
        return jnp.concatenate([prev, t], axis=3)

    qs = sub(q).astype(jnp.float32)
    kk = with_prev(sub(k)).astype(jnp.float32)
    vv = with_prev(sub(v)).astype(jnp.float32)
    s = jnp.einsum('brnqhe,brnkhe->brnhqk', qs, kk) * ATTN_SCALE
    qi = jnp.arange(nb)[:, None, None] * blk + jnp.arange(blk)[None, :, None]
    ki = jnp.arange(nb)[:, None, None] * blk - blk + jnp.arange(2 * blk)[None, None, :]
    rel = qi - ki
    valid = (rel >= 0) & (rel <= n) & (ki >= 0)
    s = jnp.where(valid[:, None], s, -jnp.inf)
    m = jnp.max(s, axis=-1, keepdims=True)
    p = jnp.exp(s - m)
    l = jnp.sum(p, axis=-1, keepdims=True)
    o = jnp.einsum('brnhqk,brnkhe->brnqhe', p / l, vv)
    lse = (m + jnp.log(l))[..., 0].transpose(0, 1, 2, 4, 3)
    o = o.reshape(B, dil, Sp, H, Dh)[:, :, :Sd].transpose(0, 2, 1, 3, 4).reshape(B, S, H, Dh)
    lse = lse.reshape(B, dil, Sp, H)[:, :, :Sd].transpose(0, 2, 1, 3).reshape(B, S, H)
    return o, lse


def dilated_attn_step(q, k, v, kv_buf, window, dil):
    Bd, L, H, Dh = q.shape
    n = window // dil
    Lbuf = kv_buf.shape[1]
    k_all = jnp.concatenate([kv_buf[:, :, 0].astype(k.dtype), k], axis=1)
    v_all = jnp.concatenate([kv_buf[:, :, 1].astype(v.dtype), v], axis=1)
    idx = Lbuf + jnp.arange(L)[:, None] - dil * jnp.arange(n + 1)[None, :]
    valid = idx >= 0
    idx = jnp.maximum(idx, 0)
    kg = k_all[:, idx].astype(jnp.float32)
    vg = v_all[:, idx].astype(jnp.float32)
    s = jnp.einsum('blhe,blmhe->blhm', q.astype(jnp.float32), kg) * ATTN_SCALE
    s = jnp.where(valid[:, None, :], s, -jnp.inf)
    m = jnp.max(s, axis=-1, keepdims=True)
    p = jnp.exp(s - m)
    l = jnp.sum(p, axis=-1, keepdims=True)
    o = jnp.einsum('blhm,blmhe->blhe', p / l, vg)
    lse = (m + jnp.log(l))[..., 0]
    return o, lse


def mixer_b(h, kv_bufs, w_in, w_out):
    B, L, _ = h.shape
    proj = jnp.einsum('bld,de->ble', h, w_in)
    qkv = proj[..., :3 * N_GROUPS * WIDTH_B].reshape(B, L, 3, N_GROUPS, H_B, DH_B)
    z = proj[..., 3 * N_GROUPS * WIDTH_B:]
    outs, lses, new_kv = [], [], []
    for gi, (window, dil) in enumerate(DIL_GROUPS):
        q, k, v = qkv[:, :, 0, gi], qkv[:, :, 1, gi], qkv[:, :, 2, gi]
        if kv_bufs is None:
            o, lse = dilated_attn_prompt(q, k, v, window, dil)
            keep = min(window, L)
            new_kv.append(jnp.stack([k[:, L - keep:], v[:, L - keep:]], axis=2))
        else:
            o, lse = dilated_attn_step(q, k, v, kv_bufs[gi], window, dil)
            new_kv.append(jnp.stack([k, v], axis=2))
        outs.append(o)
        lses.append(lse)
    wts = jax.nn.softmax(jnp.stack(lses, axis=0), axis=0)
    o = jnp.sum(wts[..., None] * jnp.stack(outs, axis=0), axis=0)
    o = o.reshape(B, L, WIDTH_B) * jax.nn.silu(z.astype(jnp.float32))
    y = jnp.einsum('ble,ed->bld', o.astype(h.dtype), w_out)
    return y, new_kv


def setup_inputs(seed: int = 0) -> dict:
    key = jax.random.key(seed)
    ks = jax.random.split(key, 24)
    f32 = jnp.float32
    n_buf = [min(w, PAST_LEN) for (w, _) in DIL_GROUPS]
    dt = jnp.exp(jax.random.uniform(ks[14], (N_LAYERS_A, H_A), f32) * (np.log(0.1) - np.log(0.001)) + np.log(0.001))
    return {
        'x_prompt': jax.random.normal(ks[0], (BATCH, SEQ, D_MODEL), f32),
        'x_sample': jax.random.normal(ks[1], (DEC_BATCH, DEC_SEQ, D_MODEL), f32),
        'state_delta': 0.1 * jax.random.normal(ks[2], (N_LAYERS_A, DEC_BATCH, H_A, DK_A, DV_A), f32),
        'state_conv': jax.random.normal(ks[3], (N_LAYERS_A, DEC_BATCH, CONV_W - 1, CONV_DIM), f32),
        'cache_kv_w128': jax.random.normal(ks[4], (N_LAYERS_B, DEC_BATCH, n_buf[0], 2, H_B, DH_B), f32),
        'cache_kv_w512': jax.random.normal(ks[5], (N_LAYERS_B, DEC_BATCH, n_buf[1], 2, H_B, DH_B), f32),
        'cache_kv_w2048': jax.random.normal(ks[6], (N_LAYERS_B, DEC_BATCH, n_buf[2], 2, H_B, DH_B), f32),
        'c_prompt': jax.random.normal(ks[7], (BATCH, D_MODEL), f32),
        'c_sample': jax.random.normal(ks[8], (DEC_BATCH, D_MODEL), f32),
        'norm_g': 1.0 + 0.02 * jax.random.normal(ks[9], (DEPTH, D_MODEL), f32),
        'ada_w': 0.5 * D_MODEL ** -0.5 * jax.random.normal(ks[10], (DEPTH, D_MODEL, 3 * D_MODEL), f32),
        'ada_b': 0.01 * jax.random.normal(ks[11], (DEPTH, 3 * D_MODEL), f32),
        'a_w_in': D_MODEL ** -0.5 * jax.random.normal(ks[12], (N_LAYERS_A, D_MODEL, W_IN_A), f32),
        'a_conv_w': CONV_W ** -0.5 * jax.random.normal(ks[13], (N_LAYERS_A, CONV_W, CONV_DIM), f32),
        'a_A_log': jnp.log(jax.random.uniform(ks[15], (N_LAYERS_A, H_A), f32, 1.0, 16.0)),
        'a_dt_bias': dt + jnp.log(-jnp.expm1(-dt)),
        'a_out_norm_g': 1.0 + 0.02 * jax.random.normal(ks[16], (N_LAYERS_A, DV_A), f32),
        'a_w_out': WIDTH_A ** -0.5 * jax.random.normal(ks[17], (N_LAYERS_A, WIDTH_A, D_MODEL), f32),
        'b_w_in': D_MODEL ** -0.5 * jax.random.normal(ks[18], (N_LAYERS_B, D_MODEL, W_IN_B), f32),
        'b_w_out': WIDTH_B ** -0.5 * jax.random.normal(ks[19], (N_LAYERS_B, WIDTH_B, D_MODEL), f32),
        'final_norm_g': 1.0 + 0.02 * jax.random.normal(ks[20], (D_MODEL,), f32),
    }


def reference(x_prompt, x_sample, state_delta, state_conv, cache_kv_w128, cache_kv_w512, cache_kv_w2048,
              c_prompt, c_sample, norm_g, ada_w, ada_b, a_w_in, a_conv_w, a_A_log, a_dt_bias, a_out_norm_g,
              a_w_out, b_w_in, b_w_out, final_norm_g):
    kv_caches = (cache_kv_w128, cache_kv_w512, cache_kv_w2048)
    xp, xs = x_prompt, x_sample
    bp = xp.shape[0]
    delta_p, delta_s, conv_p, conv_s = [], [], [], []
    kv_p = [[] for _ in DIL_GROUPS]
    kv_s = [[] for _ in DIL_GROUPS]
    for layer in range(DEPTH):
        hp, gate_p = ada_modulate(xp, c_prompt, norm_g[layer], ada_w[layer], ada_b[layer])
        hs, gate_s = ada_modulate(xs, c_sample, norm_g[layer], ada_w[layer], ada_b[layer])
        i = layer // N_MIXERS
        if layer % N_MIXERS == 0:
            params = (a_w_in[i], a_conv_w[i], a_A_log[i], a_dt_bias[i], a_out_norm_g[i], a_w_out[i])
            zero_buf = jnp.zeros((bp, CONV_W - 1, CONV_DIM), xp.dtype)
            zero_S = jnp.zeros((bp, H_A, DK_A, DV_A), jnp.float32)
            yp, buf_p, S_p = mixer_a(hp, zero_buf, zero_S, *params)
            ys, buf_s, S_s = mixer_a(hs, state_conv[i], state_delta[i], *params)
            delta_p.append(S_p.astype(state_delta.dtype))
            delta_s.append(S_s.astype(state_delta.dtype))
            conv_p.append(buf_p)
            conv_s.append(buf_s)
        else:
            yp, new_p = mixer_b(hp, None, b_w_in[i], b_w_out[i])
            ys, new_s = mixer_b(hs, [cache[i] for cache in kv_caches], b_w_in[i], b_w_out[i])
            for gi in range(N_GROUPS):
                kv_p[gi].append(new_p[gi])
                kv_s[gi].append(new_s[gi])
        xp = xp + gate_p * yp
        xs = xs + gate_s * ys
    y_prompt = rms_norm(xp, final_norm_g)
    y_sample = rms_norm(xs, final_norm_g)
    return (y_prompt, y_sample,
            jnp.stack(delta_p), jnp.stack(delta_s), jnp.stack(conv_p), jnp.stack(conv_s),
            jnp.stack(kv_p[0]), jnp.stack(kv_s[0]), jnp.stack(kv_p[1]), jnp.stack(kv_s[1]),
            jnp.stack(kv_p[2]), jnp.stack(kv_s[2]))
```

```cpp
#include <hip/hip_runtime.h>
#include <hip/hip_cooperative_groups.h>
#include <cstdio>
namespace cg = cooperative_groups;

#define LAS __attribute__((address_space(3)))
#define DI __device__ __forceinline__
typedef unsigned short bf16_t;
typedef short bf16x8 __attribute__((ext_vector_type(8)));
typedef short s16x4 __attribute__((ext_vector_type(4)));
typedef float f32x4 __attribute__((ext_vector_type(4)));
typedef float f32x2 __attribute__((ext_vector_type(2)));
typedef unsigned u32x4 __attribute__((ext_vector_type(4)));
typedef unsigned u32x2 __attribute__((ext_vector_type(2)));
typedef __bf16 bf16x2_t __attribute__((ext_vector_type(2)));

constexpr int DM = 1024, MP = 16384, MS = 256, MT = MP + MS;
constexpr int NCH = 2048 + 256;
constexpr float EPS = 1e-6f;
constexpr float QSCALE = 0.08838834764831845f * 1.4426950408889634f;
constexpr int LDS_BYTES = 151552;

constexpr size_t WS_WTA  = 0;
constexpr size_t WS_WTAO = WS_WTA  + (size_t)4096 * 1024 * 2;
constexpr size_t WS_WTB  = WS_WTAO + (size_t)1024 * 1024 * 2;
constexpr size_t WS_WTBO = WS_WTB  + (size_t)10240 * 1024 * 2;
constexpr size_t WS_MOD  = WS_WTBO + (size_t)1024 * 1024 * 2;
constexpr size_t WS_ACT  = WS_MOD  + (size_t)2 * 40 * 3072 * 4;
constexpr size_t WS_P0   = WS_ACT  + (size_t)MT * 1024 * 2;
constexpr size_t WS_GB   = WS_P0   + (size_t)MT * 4096 * 2;
constexpr size_t WS_WV   = WS_GB   + (size_t)MT * 16 * 4;
constexpr size_t WS_KC   = WS_WV   + (size_t)NCH * 8192 * 2;
constexpr size_t WS_QD   = WS_KC   + (size_t)NCH * 8192 * 2;
constexpr size_t WS_KDT  = WS_QD   + (size_t)NCH * 8192 * 2;
constexpr size_t WS_QK   = WS_KDT  + (size_t)NCH * 8192 * 2;
constexpr size_t WS_GT   = WS_QK   + (size_t)NCH * 4096 * 2;
constexpr size_t WS_O0   = WS_GT   + (size_t)NCH * 4;
constexpr size_t WS_X1   = WS_O0   + (size_t)MT * 1024 * 2;
constexpr size_t WS_P1   = WS_X1   + (size_t)MT * 1024 * 4;
constexpr size_t WS_OG   = WS_P0;
constexpr size_t WS_LSE  = WS_P1   + (size_t)MT * 10240 * 2;
constexpr size_t WS_BAR  = WS_LSE  + (size_t)3 * MT * 8 * 4;
constexpr size_t WS_END  = WS_BAR  + 16384;

constexpr size_t O_YP   = 0;
constexpr size_t O_YS   = O_YP + (size_t)MP * 1024;
constexpr size_t O_DP   = O_YS + (size_t)MS * 1024;
constexpr size_t O_DS   = O_DP + (size_t)8 * 8 * 128 * 128;
constexpr size_t O_CP   = O_DS + (size_t)32 * 8 * 128 * 128;
constexpr size_t O_CS   = O_CP + (size_t)8 * 3 * 3072;
constexpr size_t O_KVP0 = O_CS + (size_t)32 * 3 * 3072;
constexpr size_t O_KVS0 = O_KVP0 + (size_t)8 * 128 * 2048;
constexpr size_t O_KVP1 = O_KVS0 + (size_t)32 * 8 * 2048;
constexpr size_t O_KVS1 = O_KVP1 + (size_t)8 * 512 * 2048;
constexpr size_t O_KVP2 = O_KVS1 + (size_t)32 * 8 * 2048;
constexpr size_t O_KVS2 = O_KVP2 + (size_t)8 * 2048 * 2048;

struct Params { const float* in[21]; float* out; unsigned char* ws; };
enum { I_XP = 0, I_XS, I_SD, I_SC, I_C128, I_C512, I_C2048, I_CP, I_CS, I_NG, I_ADAW, I_ADAB, I_AWIN, I_ACONV, I_ALOG, I_ADT, I_AOG, I_AWOUT, I_BWIN, I_BWOUT, I_FNG };

DI int TID() { int t = (int)threadIdx.x; asm volatile("" : "+v"(t)); return t; }
DI unsigned pk2(float a, float b) { f32x2 v = {a, b}; bf16x2_t r = __builtin_convertvector(v, bf16x2_t); return __builtin_bit_cast(unsigned, r); }
DI float bflo(unsigned u) { return __uint_as_float(u << 16); }
DI float bfhi(unsigned u) { return __uint_as_float(u & 0xffff0000u); }

DI float wave_max(float v) { for (int o = 32; o > 0; o >>= 1) v = fmaxf(v, __shfl_xor(v, o)); return v; }
template <int CTRL> DI float dpp_f(float v) { return __builtin_bit_cast(float, __builtin_amdgcn_update_dpp(0, __builtin_bit_cast(int, v), CTRL, 0xf, 0xf, true)); }
DI float row16_sum(float v) { v += dpp_f<0xB1>(v); v += dpp_f<0x4E>(v); v += dpp_f<0x141>(v); v += dpp_f<0x140>(v); return v; }
DI float wave_sum(float v) {
    v = row16_sum(v);
    const int iv = __builtin_bit_cast(int, v);
    const float r0 = __builtin_bit_cast(float, __builtin_amdgcn_readlane(iv, 0)), r1 = __builtin_bit_cast(float, __builtin_amdgcn_readlane(iv, 16));
    const float r2 = __builtin_bit_cast(float, __builtin_amdgcn_readlane(iv, 32)), r3 = __builtin_bit_cast(float, __builtin_amdgcn_readlane(iv, 48));
    return (r0 + r1) + (r2 + r3);
}
DI float siluf(float x) { return x * __builtin_amdgcn_rcpf(1.f + __expf(-x)); }
DI int batch_of(int row) { return row < MP ? (row >> 11) : 8 + ((row - MP) >> 3); }
DI f32x4 mfma16(bf16x8 a, bf16x8 b, f32x4 c) { return __builtin_amdgcn_mfma_f32_16x16x32_bf16(a, b, c, 0, 0, 0); }
DI void lds_sync() { asm volatile("s_waitcnt lgkmcnt(0)" ::: "memory"); __builtin_amdgcn_s_barrier(); asm volatile("" ::: "memory"); }
DI bf16x8 lds_ld8(const LAS unsigned char* p) { return *(const LAS bf16x8*)p; }


DI void pin16x2(float (&a)[16], float (&b)[16]) {
    f32x4 p0 = {a[0], a[1], a[2], a[3]}, p1 = {a[4], a[5], a[6], a[7]}, p2 = {a[8], a[9], a[10], a[11]}, p3 = {a[12], a[13], a[14], a[15]};
    f32x4 q0 = {b[0], b[1], b[2], b[3]}, q1 = {b[4], b[5], b[6], b[7]}, q2 = {b[8], b[9], b[10], b[11]}, q3 = {b[12], b[13], b[14], b[15]};
    asm volatile("" : "+v"(p0), "+v"(p1), "+v"(p2), "+v"(p3), "+v"(q0), "+v"(q1), "+v"(q2), "+v"(q3));
#pragma unroll
    for (int j = 0; j < 4; ++j) { a[j] = p0[j]; a[4 + j] = p1[j]; a[8 + j] = p2[j]; a[12 + j] = p3[j]; b[j] = q0[j]; b[4 + j] = q1[j]; b[8 + j] = q2[j]; b[12 + j] = q3[j]; }
}
DI void pin16x4(float (&a)[16], float (&b)[16], float (&c)[16], float (&d)[16]) {
    f32x4 p[16];
#pragma unroll
    for (int j = 0; j < 4; ++j) { p[j] = (f32x4){a[4 * j], a[4 * j + 1], a[4 * j + 2], a[4 * j + 3]}; p[4 + j] = (f32x4){b[4 * j], b[4 * j + 1], b[4 * j + 2], b[4 * j + 3]};
                                  p[8 + j] = (f32x4){c[4 * j], c[4 * j + 1], c[4 * j + 2], c[4 * j + 3]}; p[12 + j] = (f32x4){d[4 * j], d[4 * j + 1], d[4 * j + 2], d[4 * j + 3]}; }
    asm volatile("" : "+v"(p[0]), "+v"(p[1]), "+v"(p[2]), "+v"(p[3]), "+v"(p[4]), "+v"(p[5]), "+v"(p[6]), "+v"(p[7]), "+v"(p[8]), "+v"(p[9]), "+v"(p[10]), "+v"(p[11]), "+v"(p[12]), "+v"(p[13]), "+v"(p[14]), "+v"(p[15]));
#pragma unroll
    for (int j = 0; j < 4; ++j)
#pragma unroll
        for (int e = 0; e < 4; ++e) { a[4 * j + e] = p[j][e]; b[4 * j + e] = p[4 + j][e]; c[4 * j + e] = p[8 + j][e]; d[4 * j + e] = p[12 + j][e]; }
}
template <class T> DI void pin4x4x4x4(T (&a)[4], T (&b)[4], T (&c)[4], T (&d)[4]) {
    asm volatile("" : "+v"(a[0]), "+v"(a[1]), "+v"(a[2]), "+v"(a[3]), "+v"(b[0]), "+v"(b[1]), "+v"(b[2]), "+v"(b[3]), "+v"(c[0]), "+v"(c[1]), "+v"(c[2]), "+v"(c[3]), "+v"(d[0]), "+v"(d[1]), "+v"(d[2]), "+v"(d[3]));
}
template <class T> DI void pin4(T (&a)[4]) { asm volatile("" : "+v"(a[0]), "+v"(a[1]), "+v"(a[2]), "+v"(a[3])); }
template <class T> DI void pin8(T (&a)[8]) { asm volatile("" : "+v"(a[0]), "+v"(a[1]), "+v"(a[2]), "+v"(a[3]), "+v"(a[4]), "+v"(a[5]), "+v"(a[6]), "+v"(a[7])); }
template <class T, class U> DI void pin4x4(T (&a)[4], U (&b)[4]) { asm volatile("" : "+v"(a[0]), "+v"(a[1]), "+v"(a[2]), "+v"(a[3]), "+v"(b[0]), "+v"(b[1]), "+v"(b[2]), "+v"(b[3])); }
template <class T, class U> DI void pin8x8(T (&a)[8], U (&b)[8]) { asm volatile("" : "+v"(a[0]), "+v"(a[1]), "+v"(a[2]), "+v"(a[3]), "+v"(a[4]), "+v"(a[5]), "+v"(a[6]), "+v"(a[7]),
                                                                                      "+v"(b[0]), "+v"(b[1]), "+v"(b[2]), "+v"(b[3]), "+v"(b[4]), "+v"(b[5]), "+v"(b[6]), "+v"(b[7])); }

namespace pg8 {
constexpr int BM = 256, BK = 64, HALF = 128, HTB = HALF * BK * 2, STAGE_BYTES = 8 * HTB, NXCD = 8, WGM = 8;
DI int lds_byte(int r, int c) { const int st = (r >> 4) * 2 + (c >> 5), rr = r & 15, cc = c & 31, ob = rr * 64 + cc * 2; return st * 1024 + (ob ^ (((ob >> 9) & 1) << 5)); }
DI void stage_rc(int b, int& R, int& C) { const int st = b / 1024, sb = b % 1024, swz = sb ^ (((sb >> 9) & 1) << 5); R = (st >> 1) * 16 + swz / 64; C = (st & 1) * 32 + (swz % 64) / 2; }
DI int perm32(int rho) { const int n = rho >> 4, i = rho & 15; return 8 * (i >> 2) + 4 * n + (i & 3); }
struct Unit { int pm, pn; };
struct Gemm { const bf16_t* A; const bf16_t* Bt; int M, N, K; };
struct StaticOrder {
    int nM, nN, nwg, G, c;
    DI void init(int M, int N, int G_, int c_) { nM = M / BM; nN = N / BM; nwg = nM * nN; G = G_; c = c_; }
    DI bool next(int i, Unit& u) const {
        const long L = (long)i * G + c; if (L >= nwg) return false;
        int wgid = (int)L; { const int q = nwg / NXCD, r = nwg % NXCD, xcd = wgid % NXCD, off = wgid / NXCD; wgid = (xcd < r ? xcd * (q + 1) : r * (q + 1) + (xcd - r) * q) + off; }
        const int nig = WGM * nN, gid = wgid / nig, fm = gid * WGM, gsz = (nM - fm) < WGM ? (nM - fm) : WGM;
        u.pm = fm + ((wgid % nig) % gsz); u.pn = (wgid % nig) / gsz; return true;
    }
};

template <class Epi>
DI void gemm_phase(LAS unsigned char* lds, const Gemm g, const StaticOrder& S, const Epi& E) {
    const int tid = TID(), wid = __builtin_amdgcn_readfirstlane(tid >> 6), lane = tid & 63, wr = wid >> 2, wc = wid & 3, fr = lane & 15, fq = lane >> 4;
    const int K = g.K, nt = K / BK;
    unsigned voffA[2], voffB[2];
#pragma unroll
    for (int i = 0; i < 2; ++i) { int R, C; stage_rc(tid * 16 + i * 8192, R, C); const int Rb = (R & ~31) + perm32(R & 31);
        voffA[i] = (unsigned)(R * K + C) * 2u; voffB[i] = (unsigned)(Rb * K + C) * 2u; }
    const size_t kstep = (size_t)(BK * 2);
    const size_t hstep = (size_t)HALF * K * 2;
    const size_t tstep = 2 * hstep;
    const unsigned ldsw = (unsigned)wid * 1024u;
    const int aoff = lds_byte(wr * 64 + fr, fq * 8), boff = lds_byte(wc * 32 + fr, fq * 8);
#define PG8_SA(b, h) (((b) * 2 + (h)) * HTB)
#define PG8_SB(b, h) ((4 + (b) * 2 + (h)) * HTB)
#define PG8_STAGE(bufoff, gbase, voff) do { _Pragma("unroll") for (int _i = 0; _i < 2; ++_i) \
        __builtin_amdgcn_global_load_lds((const unsigned*)((const char*)(gbase) + (voff)[_i]), (LAS unsigned*)(lds + (bufoff) + ldsw + _i * 8192), 16, 0, 0); } while (0)
#define PG8_LDA(dst, b, h) do { _Pragma("unroll") for (int m = 0; m < 4; ++m) _Pragma("unroll") for (int k = 0; k < 2; ++k) dst[m][k] = *(const LAS bf16x8*)(lds + PG8_SA(b, h) + aoff + m * 2048 + k * 1024); } while (0)
#define PG8_LDB(dst, b, h) do { _Pragma("unroll") for (int n = 0; n < 2; ++n) _Pragma("unroll") for (int k = 0; k < 2; ++k) dst[n][k] = *(const LAS bf16x8*)(lds + PG8_SB(b, h) + boff + n * 2048 + k * 1024); } while (0)
#define PG8_MMA(ai, bj, At, Bt) do { __builtin_amdgcn_s_setprio(1); _Pragma("unroll") for (int m = 0; m < 4; ++m) _Pragma("unroll") for (int n = 0; n < 2; ++n) _Pragma("unroll") for (int k = 0; k < 2; ++k) \
        acc[ai][bj][m][n] = __builtin_amdgcn_mfma_f32_16x16x32_bf16(Bt[n][k], At[m][k], acc[ai][bj][m][n], 0, 0, 0); __builtin_amdgcn_s_setprio(0); } while (0)
#define PG8_WAIT_V(n) asm volatile("s_waitcnt vmcnt(" #n ")" ::: "memory")
#define PG8_WAIT_L(n) asm volatile("s_waitcnt lgkmcnt(" #n ")" ::: "memory")
#define PG8_BAR __builtin_amdgcn_s_barrier()
#define PG8_SCHED __builtin_amdgcn_sched_barrier(0)
    Unit cur, nxt; int ui = 0;
    if (!S.next(0, cur)) return;
    f32x4 acc[2][2][4][2];
#pragma unroll
    for (int a = 0; a < 2; ++a)
#pragma unroll
        for (int b = 0; b < 2; ++b)
#pragma unroll
            for (int m = 0; m < 4; ++m)
#pragma unroll
                for (int n = 0; n < 2; ++n) acc[a][b][m][n] = (f32x4){0.f, 0.f, 0.f, 0.f};
    bf16x8 At[4][2], B0[2][2], B1[2][2];
    const char* cA = (const char*)g.A + (size_t)cur.pm * tstep; const char* cB = (const char*)g.Bt + (size_t)cur.pn * tstep;
    PG8_STAGE(PG8_SB(0, 0), cB, voffB); PG8_STAGE(PG8_SA(0, 0), cA, voffA); PG8_STAGE(PG8_SB(0, 1), cB + hstep, voffB); PG8_STAGE(PG8_SA(0, 1), cA + hstep, voffA);
    if (wr == 1) PG8_BAR;
    PG8_WAIT_V(4); PG8_BAR;
    PG8_STAGE(PG8_SB(1, 0), cB + kstep, voffB); PG8_STAGE(PG8_SA(1, 0), cA + kstep, voffA); PG8_STAGE(PG8_SB(1, 1), cB + hstep + kstep, voffB);
    PG8_WAIT_V(6); PG8_BAR;
    for (;;) {
        const bool has_next = S.next(ui + 1, nxt);
        const char* nA = has_next ? (const char*)g.A + (size_t)nxt.pm * tstep : cA; const char* nB = has_next ? (const char*)g.Bt + (size_t)nxt.pn * tstep : cB;
        for (int t = 0; t < nt; t += 2) {
            const bool last = (t == nt - 2);
            const char* a1 = cA + (size_t)(t + 1) * kstep;
            const char* a2 = last ? nA : cA + (size_t)(t + 2) * kstep; const char* b2 = last ? nB : cB + (size_t)(t + 2) * kstep;
            const char* a3 = a2 + kstep; const char* b3 = b2 + kstep;
            PG8_LDB(B0, 0, 0); PG8_SCHED; PG8_LDA(At, 0, 0); PG8_STAGE(PG8_SA(1, 1), a1 + hstep, voffA);
            PG8_WAIT_L(8); PG8_BAR; PG8_WAIT_L(0); PG8_MMA(0, 0, At, B0); PG8_BAR; PG8_SCHED;
            PG8_LDB(B1, 0, 1); PG8_STAGE(PG8_SB(0, 0), b2, voffB);
            PG8_BAR; PG8_WAIT_L(0); PG8_MMA(0, 1, At, B1); PG8_BAR;
            PG8_LDA(At, 0, 1); PG8_STAGE(PG8_SA(0, 0), a2, voffA);
            PG8_BAR; PG8_WAIT_L(0); PG8_MMA(1, 0, At, B0); PG8_BAR; PG8_SCHED;
            PG8_STAGE(PG8_SB(0, 1), b2 + hstep, voffB);
            PG8_WAIT_V(6); PG8_BAR; PG8_MMA(1, 1, At, B1); PG8_BAR;
            PG8_LDB(B0, 1, 0); PG8_SCHED; PG8_LDA(At, 1, 0); PG8_STAGE(PG8_SA(0, 1), a2 + hstep, voffA);
            PG8_WAIT_L(8); PG8_BAR; PG8_WAIT_L(0); PG8_MMA(0, 0, At, B0); PG8_BAR; PG8_SCHED;
            PG8_LDB(B1, 1, 1); PG8_STAGE(PG8_SB(1, 0), b3, voffB);
            PG8_BAR; PG8_WAIT_L(0); PG8_MMA(0, 1, At, B1); PG8_BAR;
            PG8_LDA(At, 1, 1); PG8_STAGE(PG8_SA(1, 0), a3, voffA);
            PG8_BAR; PG8_WAIT_L(0); PG8_MMA(1, 0, At, B0); PG8_BAR; PG8_SCHED;
            PG8_STAGE(PG8_SB(1, 1), b3 + hstep, voffB);
            PG8_WAIT_V(6); PG8_BAR; PG8_MMA(1, 1, At, B1); PG8_BAR;
        }
        E(acc, cur, wr, wc, fr, fq);
        if (!has_next) break;
#pragma unroll
        for (int a = 0; a < 2; ++a)
#pragma unroll
            for (int b = 0; b < 2; ++b)
#pragma unroll
                for (int m = 0; m < 4; ++m)
#pragma unroll
                    for (int n = 0; n < 2; ++n) acc[a][b][m][n] = (f32x4){0.f, 0.f, 0.f, 0.f};
        cur = nxt; cA = nA; cB = nB; ++ui;
    }
    PG8_WAIT_V(0);
    if (wr == 0) PG8_BAR;
    PG8_BAR;
#undef PG8_SA
#undef PG8_SB
#undef PG8_STAGE
#undef PG8_LDA
#undef PG8_LDB
#undef PG8_MMA
#undef PG8_WAIT_V
#undef PG8_WAIT_L
#undef PG8_BAR
#undef PG8_SCHED
}
}

template <class F> struct Epi8 {
    F f;
    DI void operator()(const f32x4 (&acc)[2][2][4][2], const pg8::Unit& u, int wr, int wc, int fr, int fq) const {
        const int row0 = u.pm * 256 + wr * 64 + fr, col0 = u.pn * 256 + wc * 32 + 8 * fq;
        if constexpr (F::HAS_TILE) { f.tile(acc, row0, col0); return; }
#pragma unroll
        for (int ai = 0; ai < 2; ++ai)
#pragma unroll
            for (int m = 0; m < 4; ++m)
#pragma unroll
                for (int bj = 0; bj < 2; ++bj) f.store8(row0 + ai * 128 + m * 16, col0 + bj * 128, acc[ai][bj][m][0], acc[ai][bj][m][1]);
    }
};

template <class F> DI void small_gemm(const bf16_t* A, const bf16_t* Wt, int N, int rowbase, const F& f) {
    const int lane = TID() & 63, wid = TID() >> 6, r16 = lane & 15, fq = lane >> 4;
    const int ntile = 16 * (N / 32), nw = gridDim.x * 8;
    for (int t = blockIdx.x * 8 + wid; t < ntile; t += nw) {
        const int rt = t & 15, ct = t >> 4;
        const bf16_t* ap = A + (size_t)(rt * 16 + r16) * 1024 + fq * 8;
        const bf16_t* b0 = Wt + (size_t)(ct * 32 + pg8::perm32(r16)) * 1024 + fq * 8;
        const bf16_t* b1 = Wt + (size_t)(ct * 32 + pg8::perm32(16 + r16)) * 1024 + fq * 8;
        f32x4 acc0 = {0.f, 0.f, 0.f, 0.f}, acc1 = {0.f, 0.f, 0.f, 0.f};
#pragma unroll 1
        for (int kb = 0; kb < 4; ++kb) {
            bf16x8 a[8], x0[8], x1[8];
#pragma unroll
            for (int u = 0; u < 8; ++u) { const int ko = (kb * 8 + u) * 32; a[u] = *(const bf16x8*)(ap + ko); x0[u] = *(const bf16x8*)(b0 + ko); x1[u] = *(const bf16x8*)(b1 + ko); }
            asm volatile("" : "+v"(a[0]), "+v"(x0[0]), "+v"(x1[0]), "+v"(a[1]), "+v"(x0[1]), "+v"(x1[1]), "+v"(a[2]), "+v"(x0[2]), "+v"(x1[2]), "+v"(a[3]), "+v"(x0[3]), "+v"(x1[3]), "+v"(a[4]), "+v"(x0[4]), "+v"(x1[4]), "+v"(a[5]), "+v"(x0[5]), "+v"(x1[5]), "+v"(a[6]), "+v"(x0[6]), "+v"(x1[6]), "+v"(a[7]), "+v"(x0[7]), "+v"(x1[7]));
#pragma unroll
            for (int u = 0; u < 8; ++u) { acc0 = mfma16(x0[u], a[u], acc0); acc1 = mfma16(x1[u], a[u], acc1); }
        }
        f.store8(rowbase + rt * 16 + r16, ct * 32 + 8 * fq, acc0, acc1);
    }
}

template <class F> DI void gemm_all(LAS unsigned char* lds, const bf16_t* A, const bf16_t* Wt, int N, const F& f) {
    pg8::Gemm g{A, Wt, MP, N, 1024}; pg8::StaticOrder S; S.init(MP, N, (int)gridDim.x, (int)blockIdx.x); Epi8<F> E{f};
    pg8::gemm_phase(lds, g, S, E);
    small_gemm(A + (size_t)MP * 1024, Wt, N, MP, f);
}

DI void st_bf16x8(bf16_t* p, f32x4 v0, f32x4 v1) { u32x4 w; w.x = pk2(v0[0], v0[1]); w.y = pk2(v0[2], v0[3]); w.z = pk2(v1[0], v1[1]); w.w = pk2(v1[2], v1[3]); *(u32x4*)p = w; }

struct EpiA {
    static constexpr bool HAS_TILE = true;
    bf16_t* P0; float* out;
    DI void tile(const f32x4 (&acc)[2][2][4][2], int row0, int col0) const {
        const int ucol = col0 & ~255, urow = row0 & ~255;
        const bool tail = ucol < 3072 && (urow & 2047) == 1792;
#pragma unroll
        for (int ai = 0; ai < 2; ++ai)
#pragma unroll
            for (int m = 0; m < 4; ++m) {
                const int row = row0 + ai * 128 + m * 16, s = row & 2047;
#pragma unroll
                for (int bj = 0; bj < 2; ++bj) {
                    const f32x4 v0 = acc[ai][bj][m][0], v1 = acc[ai][bj][m][1];
                    if (tail && s >= 2045) { float* o = out + O_CP + (size_t)((row >> 11) * 3 + (s - 2045)) * 3072 + col0 + bj * 128; *(f32x4*)o = v0; *(f32x4*)(o + 4) = v1; }
                    st_bf16x8(P0 + (size_t)row * 4096 + col0 + bj * 128, v0, v1);
                }
            }
    }
    DI void store8(int row, int col, f32x4 v0, f32x4 v1) const {
        st_bf16x8(P0 + (size_t)row * 4096 + col, v0, v1);
        if (col < 3072) {
            float* o = nullptr;
            if (row < MP) { const int s = row & 2047; if (s >= 2045) o = out + O_CP + (size_t)((row >> 11) * 3 + (s - 2045)) * 3072 + col; }
            else { const int r = row - MP, l = r & 7; if (l >= 5) o = out + O_CS + (size_t)((r >> 3) * 3 + (l - 5)) * 3072 + col; }
            if (o) { *(f32x4*)o = v0; *(f32x4*)(o + 4) = v1; }
        }
    }
};
DI void ld8_as_f32(const float* p, f32x4& a, f32x4& b) { a = *(const f32x4*)p; b = *(const f32x4*)(p + 4); }
DI void ld8_as_f32(const bf16_t* p, f32x4& a, f32x4& b) { const u32x4 w = *(const u32x4*)p; a = (f32x4){bflo(w.x), bfhi(w.x), bflo(w.y), bfhi(w.y)}; b = (f32x4){bflo(w.z), bfhi(w.z), bflo(w.w), bfhi(w.w)}; }
DI void st8_from_f32(float* p, f32x4 a, f32x4 b) { *(f32x4*)p = a; *(f32x4*)(p + 4) = b; }
DI void st8_from_f32(bf16_t* p, f32x4 a, f32x4 b) { st_bf16x8(p, a, b); }
template <class TI, class TO> struct EpiRes {
    static constexpr bool HAS_TILE = true;
    const TI* xp; const TI* xs; const float* mod; TO* dst;
    DI void tile(const f32x4 (&acc)[2][2][4][2], int row0, int col0) const {
        const float* gt = mod + (size_t)(row0 >> 11) * 3072 + 2048 + col0;
        f32x4 g[2][2];
#pragma unroll
        for (int bj = 0; bj < 2; ++bj) { g[bj][0] = *(const f32x4*)(gt + bj * 128); g[bj][1] = *(const f32x4*)(gt + bj * 128 + 4); }
#pragma unroll
        for (int ai = 0; ai < 2; ++ai) {
            f32x4 xv[16];
            if constexpr (sizeof(TI) == 2) {
                u32x4 xr[8];
#pragma unroll
                for (int m = 0; m < 4; ++m)
#pragma unroll
                    for (int bj = 0; bj < 2; ++bj) xr[m * 2 + bj] = *(const u32x4*)(xp + (size_t)(row0 + ai * 128 + m * 16) * 1024 + col0 + bj * 128);
                pin8(xr);
#pragma unroll
                for (int q = 0; q < 8; ++q) { const u32x4 w = xr[q]; xv[2 * q] = (f32x4){bflo(w.x), bfhi(w.x), bflo(w.y), bfhi(w.y)}; xv[2 * q + 1] = (f32x4){bflo(w.z), bfhi(w.z), bflo(w.w), bfhi(w.w)}; }
            } else {
#pragma unroll
                for (int m = 0; m < 4; ++m) { const TI* x = xp + (size_t)(row0 + ai * 128 + m * 16) * 1024 + col0;
#pragma unroll
                    for (int bj = 0; bj < 2; ++bj) ld8_as_f32(x + bj * 128, xv[m * 4 + bj * 2], xv[m * 4 + bj * 2 + 1]); }
                asm volatile("" : "+v"(xv[0]), "+v"(xv[1]), "+v"(xv[2]), "+v"(xv[3]), "+v"(xv[4]), "+v"(xv[5]), "+v"(xv[6]), "+v"(xv[7]), "+v"(xv[8]), "+v"(xv[9]), "+v"(xv[10]), "+v"(xv[11]), "+v"(xv[12]), "+v"(xv[13]), "+v"(xv[14]), "+v"(xv[15]));
            }
#pragma unroll
            for (int m = 0; m < 4; ++m) { TO* d = dst + (size_t)(row0 + ai * 128 + m * 16) * 1024 + col0;
#pragma unroll
                for (int bj = 0; bj < 2; ++bj) st8_from_f32(d + bj * 128, xv[m * 4 + bj * 2] + g[bj][0] * acc[ai][bj][m][0], xv[m * 4 + bj * 2 + 1] + g[bj][1] * acc[ai][bj][m][1]); }
        }
    }
    DI void store8(int row, int col, f32x4 v0, f32x4 v1) const {
        const TI* x = (row < MP ? xp + (size_t)row * 1024 : xs + (size_t)(row - MP) * 1024) + col;
        const float* gt = mod + (size_t)batch_of(row) * 3072 + 2048 + col;
        f32x4 x0, x1; ld8_as_f32(x, x0, x1);
        const f32x4 g0 = *(const f32x4*)gt, g1 = *(const f32x4*)(gt + 4);
        st8_from_f32(dst + (size_t)row * 1024 + col, x0 + g0 * v0, x1 + g1 * v1);
    }
};
struct EpiB {
    static constexpr bool HAS_TILE = true;
    bf16_t* P1; float* out;
    DI void tile(const f32x4 (&acc)[2][2][4][2], int row0, int col0) const {
        const int ucol = col0 & ~255, urow = row0 & ~255;
        const bool isq = ucol < 3072, iskv = ucol >= 3072 && ucol < 9216;
        const int cc = ucol - 3072, kv = cc >= 3072 ? 1 : 0, g = ((cc - kv * 3072) >> 10), W = g == 0 ? 128 : (g == 1 ? 512 : 2048);
        const int b = urow >> 11, s0 = urow & 2047;
        const bool any_out = iskv && (s0 + 256 > 2048 - W);
        const size_t obase = (g == 0 ? O_KVP0 : (g == 1 ? O_KVP1 : O_KVP2)) + ((size_t)b * W * 2 + kv) * 1024 + ((col0 - 3072 - kv * 3072) & 1023);
        const float sc = isq ? QSCALE : 1.f;
#pragma unroll
        for (int ai = 0; ai < 2; ++ai)
#pragma unroll
            for (int m = 0; m < 4; ++m) {
                const int row = row0 + ai * 128 + m * 16, s = row & 2047;
#pragma unroll
                for (int bj = 0; bj < 2; ++bj) {
                    const f32x4 v0 = acc[ai][bj][m][0], v1 = acc[ai][bj][m][1];
                    if (any_out && s >= 2048 - W) { float* o = out + obase + (size_t)(s - (2048 - W)) * 2048 + bj * 128; *(f32x4*)o = v0; *(f32x4*)(o + 4) = v1; }
                    st_bf16x8(P1 + (size_t)row * 10240 + col0 + bj * 128, v0 * sc, v1 * sc);
                }
            }
    }
    DI void store8(int row, int col, f32x4 v0, f32x4 v1) const {
        if (col >= 3072 && col < 9216) {
            const int cc = col - 3072, kv = cc / 3072, g = (cc - kv * 3072) >> 10, he = cc & 1023;
            float* o = nullptr;
            if (row < MP) {
                const int b = row >> 11, s = row & 2047, W = g == 0 ? 128 : (g == 1 ? 512 : 2048);
                const size_t base = g == 0 ? O_KVP0 : (g == 1 ? O_KVP1 : O_KVP2);
                if (s >= 2048 - W) o = out + base + ((size_t)(b * W + (s - (2048 - W))) * 2 + kv) * 1024 + he;
            } else {
                const size_t base = g == 0 ? O_KVS0 : (g == 1 ? O_KVS1 : O_KVS2);
                o = out + base + ((size_t)(row - MP) * 2 + kv) * 1024 + he;
            }
            if (o) { *(f32x4*)o = v0; *(f32x4*)(o + 4) = v1; }
        }
        if (col < 3072) { v0 *= QSCALE; v1 *= QSCALE; }
        st_bf16x8(P1 + (size_t)row * 10240 + col, v0, v1);
    }
};

DI void ada_item(const Params& p, LAS unsigned char* lds, int it) {
    const int tid = TID(), l = it / 96, col0 = (it % 96) * 32, col = tid & 31, ks = tid >> 5;
    LAS float* cs = (LAS float*)lds;
    const float* aw = p.in[I_ADAW] + (size_t)l * 1024 * 3072;
    float acc[40];
#pragma unroll
    for (int b = 0; b < 40; ++b) acc[b] = 0.f;
    for (int half = 0; half < 2; ++half) {
        __syncthreads();
        for (int idx = tid; idx < 40 * 512; idx += 512) {
            const int b = idx % 40, kk = idx / 40;
            const float c = b < 8 ? p.in[I_CP][b * 1024 + half * 512 + kk] : p.in[I_CS][(b - 8) * 1024 + half * 512 + kk];
            cs[kk * 40 + b] = siluf(c);
        }
        __syncthreads();
        float wv[32];
#pragma unroll
        for (int kk = 0; kk < 32; ++kk) wv[kk] = aw[(size_t)(half * 512 + ks * 32 + kk) * 3072 + col0 + col];
        { float (&w0)[16] = *reinterpret_cast<float (*)[16]>(&wv[0]); float (&w1)[16] = *reinterpret_cast<float (*)[16]>(&wv[16]); pin16x2(w0, w1); }
#pragma unroll
        for (int kk = 0; kk < 32; ++kk) {
            const int k = ks * 32 + kk;
            const float w = wv[kk];
            asm volatile("" ::: "memory");
#pragma unroll
            for (int b4 = 0; b4 < 10; ++b4) {
                const f32x4 c4 = *(const LAS f32x4*)(cs + k * 40 + b4 * 4);
                acc[b4 * 4 + 0] += c4[0] * w; acc[b4 * 4 + 1] += c4[1] * w; acc[b4 * 4 + 2] += c4[2] * w; acc[b4 * 4 + 3] += c4[3] * w;
            }
        }
    }
    __syncthreads();
    LAS float* red = (LAS float*)lds;
#pragma unroll
    for (int b = 0; b < 40; ++b) red[(ks * 40 + b) * 32 + col] = acc[b];
    __syncthreads();
    float* MOD = (float*)(p.ws + WS_MOD);
    for (int idx = tid; idx < 1280; idx += 512) {
        const int b = idx >> 5, c = idx & 31;
        float s = p.in[I_ADAB][l * 3072 + col0 + c];
#pragma unroll
        for (int k16 = 0; k16 < 16; ++k16) s += red[(k16 * 40 + b) * 32 + c];
        MOD[(size_t)(l * 40 + b) * 3072 + col0 + c] = s;
    }
}
struct TileRef { const float* src; bf16_t* dst; int pitch, k0, n0; };
DI TileRef tile_ref(const Params& p, int t) {
    TileRef r; int tt;
    if (t < 512) { r.src = p.in[I_AWIN]; r.dst = (bf16_t*)(p.ws + WS_WTA); r.pitch = 4112; tt = t; }
    else if (t < 640) { r.src = p.in[I_AWOUT]; r.dst = (bf16_t*)(p.ws + WS_WTAO); r.pitch = 1024; tt = t - 512; }
    else if (t < 1920) { r.src = p.in[I_BWIN]; r.dst = (bf16_t*)(p.ws + WS_WTB); r.pitch = 10240; tt = t - 640; }
    else { r.src = p.in[I_BWOUT]; r.dst = (bf16_t*)(p.ws + WS_WTBO); r.pitch = 1024; tt = t - 1920; }
    r.k0 = (tt & 15) * 64; r.n0 = (tt >> 4) * 128; return r;
}
DI void tile_load(const TileRef& r, int tid, f32x4 (&v)[4]) {
#pragma unroll
    for (int i = 0; i < 4; ++i) { const int kk = (tid >> 5) + 16 * i, nn = (tid & 31) * 4; v[i] = *(const f32x4*)(r.src + (size_t)(r.k0 + kk) * r.pitch + r.n0 + nn); }
}
DI void phase_prep(const Params& p, LAS unsigned char* lds) {
    const int bid = blockIdx.x, G = gridDim.x;
    for (int it = bid; it < 192; it += G) ada_item(p, lds, it);
    int t, tstep, tend;
    if (G == 256) { if (bid < 192) { t = bid * 7; tstep = 1; tend = t + 7; } else { t = 1344 + (bid - 192); tstep = 64; tend = 2048; } }
    else { t = bid; tstep = G; tend = 2048; }
    const int tid = TID();
    LAS float* T = (LAS float*)lds;
    f32x4 cur[4], nxt[4];
    TileRef rc, rn;
    if (t < tend) { rc = tile_ref(p, t); tile_load(rc, tid, cur); }
    for (; t < tend; t += tstep) {
        const int tn = t + tstep;
        if (tn < tend) { rn = tile_ref(p, tn); tile_load(rn, tid, nxt); }
        lds_sync();
#pragma unroll
        for (int i = 0; i < 4; ++i) { const int kk = (tid >> 5) + 16 * i, nn = (tid & 31) * 4;
            T[kk * 129 + nn] = cur[i][0]; T[kk * 129 + nn + 1] = cur[i][1]; T[kk * 129 + nn + 2] = cur[i][2]; T[kk * 129 + nn + 3] = cur[i][3]; }
        lds_sync();
#pragma unroll
        for (int q = 0; q < 2; ++q) {
            const int task = tid + 512 * q, nn = task >> 3, kc = task & 7;
            u32x4 w;
            w.x = pk2(T[(kc * 8 + 0) * 129 + nn], T[(kc * 8 + 1) * 129 + nn]); w.y = pk2(T[(kc * 8 + 2) * 129 + nn], T[(kc * 8 + 3) * 129 + nn]);
            w.z = pk2(T[(kc * 8 + 4) * 129 + nn], T[(kc * 8 + 5) * 129 + nn]); w.w = pk2(T[(kc * 8 + 6) * 129 + nn], T[(kc * 8 + 7) * 129 + nn]);
            *(u32x4*)(rc.dst + (size_t)(rc.n0 + nn) * 1024 + rc.k0 + kc * 8) = w;
        }
#pragma unroll
        for (int i = 0; i < 4; ++i) cur[i] = nxt[i];
        rc = rn;
    }
}

template <bool AB> DI void phase_norm(const Params& p, LAS unsigned char* lds, const float* xp, const float* xs, int layer) {
    const int tid = TID(), lane = tid & 63, wid = tid >> 6;
    LAS float* wab = (LAS float*)lds;
    if (AB) {
        for (int idx = tid; idx < 16384; idx += 512) { const int k = idx >> 4, j = idx & 15; wab[k * 20 + j] = p.in[I_AWIN][(size_t)k * 4112 + 4096 + j]; }
        __syncthreads();
    }
    const float* MODl = (const float*)(p.ws + WS_MOD) + (size_t)layer * 40 * 3072;
    const float* ng = p.in[I_NG] + layer * 1024;
    bf16_t* ACT = (bf16_t*)(p.ws + WS_ACT);
    float* GB = (float*)(p.ws + WS_GB);
    const int nw = gridDim.x * 8;
    float gsv[16], shv[16];
    auto ld_mod = [&](int b) {
        const float* mb = MODl + (size_t)b * 3072;
        float sc[16], g16[16];
#pragma unroll
        for (int i = 0; i < 16; ++i) { const int c = lane + 64 * i; sc[i] = mb[1024 + c]; shv[i] = mb[c]; g16[i] = ng[c]; }
#pragma unroll
        for (int i = 0; i < 16; ++i) gsv[i] = g16[i] * (1.f + sc[i]);
    };
    auto ld_row = [&](int row, float (&v)[16]) {
        const float* x = row < MP ? xp + (size_t)row * 1024 : xs + (size_t)(row - MP) * 1024;
#pragma unroll
        for (int i = 0; i < 16; ++i) v[i] = x[lane + 64 * i];
    };
    auto do_row = [&](int row, float (&v)[16]) {
        float ss = 0.f;
#pragma unroll
        for (int i = 0; i < 16; ++i) ss += v[i] * v[i];
        ss = wave_sum(ss);
        const float rstd = rsqrtf(ss * (1.f / 1024.f) + EPS);
#pragma unroll
        for (int i = 0; i < 16; ++i) {
            const int c = lane + 64 * i;
            v[i] = v[i] * rstd * gsv[i] + shv[i];
            ACT[(size_t)row * 1024 + c] = (bf16_t)(pk2(v[i], 0.f) & 0xffffu);
        }
        if (AB) {
            float pa[16];
#pragma unroll
            for (int j = 0; j < 16; ++j) pa[j] = 0.f;
#pragma unroll
            for (int i = 0; i < 16; ++i) {
                const int c = lane + 64 * i;
                asm volatile("" ::: "memory");
#pragma unroll
                for (int q = 0; q < 4; ++q) { const f32x4 w = *(const LAS f32x4*)(wab + c * 20 + q * 4); pa[q * 4] += v[i] * w[0]; pa[q * 4 + 1] += v[i] * w[1]; pa[q * 4 + 2] += v[i] * w[2]; pa[q * 4 + 3] += v[i] * w[3]; }
            }
            float mine = 0.f;
#pragma unroll
            for (int j = 0; j < 16; ++j) { const float sm = wave_sum(pa[j]); if (lane == j) mine = sm; }
            if (lane < 16) {
                float r;
                if (lane < 8) { const float a = mine + p.in[I_ADT][lane]; const float sp = a > 20.f ? a : log1pf(__expf(a)); r = -__expf(p.in[I_ALOG][lane]) * sp; }
                else r = 1.f / (1.f + __expf(-mine));
                GB[(size_t)row * 16 + lane] = r;
            }
        }
    };
    for (int chunk = blockIdx.x * 8 + wid; chunk < MP / 8; chunk += nw) {
        const int r0 = chunk * 8;
        ld_mod(r0 >> 11);
#pragma unroll 1
        for (int h4 = 0; h4 < 2; ++h4) {
            float va[16], vb[16], vc[16], vd[16];
            const int r = r0 + 4 * h4;
            ld_row(r, va); ld_row(r + 1, vb); ld_row(r + 2, vc); ld_row(r + 3, vd);
            pin16x4(va, vb, vc, vd);
            do_row(r, va); do_row(r + 1, vb); do_row(r + 2, vc); do_row(r + 3, vd);
        }
    }
    for (int r = blockIdx.x * 8 + wid; r < MS; r += nw) {
        float va[16];
        ld_mod(8 + (r >> 3));
        ld_row(MP + r, va);
        do_row(MP + r, va);
    }
}

DI void phase_norm1(const Params& p) {
    const int lane = TID() & 63, wid = TID() >> 6;
    const float* MODl = (const float*)(p.ws + WS_MOD) + (size_t)40 * 3072;
    const float* ng = p.in[I_NG] + 1024;
    const bf16_t* X1 = (const bf16_t*)(p.ws + WS_X1);
    bf16_t* ACT = (bf16_t*)(p.ws + WS_ACT);
    const int nw = gridDim.x * 8;
    float gsv[16], shv[16];
    auto ld_mod = [&](int b) {
        const float* mb = MODl + (size_t)b * 3072 + lane * 16;
#pragma unroll
        for (int q = 0; q < 4; ++q) { const f32x4 sc = *(const f32x4*)(mb + 1024 + q * 4), sh = *(const f32x4*)(mb + q * 4), g = *(const f32x4*)(ng + lane * 16 + q * 4);
#pragma unroll
            for (int e = 0; e < 4; ++e) { gsv[q * 4 + e] = g[e] * (1.f + sc[e]); shv[q * 4 + e] = sh[e]; } }
    };
    auto do_row = [&](int row, u32x4 a, u32x4 b) {
        float v[16] = {bflo(a.x), bfhi(a.x), bflo(a.y), bfhi(a.y), bflo(a.z), bfhi(a.z), bflo(a.w), bfhi(a.w), bflo(b.x), bfhi(b.x), bflo(b.y), bfhi(b.y), bflo(b.z), bfhi(b.z), bflo(b.w), bfhi(b.w)};
        float ss = 0.f;
#pragma unroll
        for (int i = 0; i < 16; ++i) ss += v[i] * v[i];
        ss = wave_sum(ss);
        const float rstd = rsqrtf(ss * (1.f / 1024.f) + EPS);
#pragma unroll
        for (int i = 0; i < 16; ++i) v[i] = v[i] * rstd * gsv[i] + shv[i];
        u32x4 w0, w1;
        w0.x = pk2(v[0], v[1]); w0.y = pk2(v[2], v[3]); w0.z = pk2(v[4], v[5]); w0.w = pk2(v[6], v[7]);
        w1.x = pk2(v[8], v[9]); w1.y = pk2(v[10], v[11]); w1.z = pk2(v[12], v[13]); w1.w = pk2(v[14], v[15]);
        u32x4* d = (u32x4*)(ACT + (size_t)row * 1024 + lane * 16); d[0] = w0; d[1] = w1;
    };
    const int chunk0 = gridDim.x == 256 ? ((int)(blockIdx.x & 7) * 256 + (int)(blockIdx.x >> 3) * 8 + wid) : (int)blockIdx.x * 8 + wid;
    for (int chunk = chunk0; chunk < MP / 8; chunk += nw) {
        const int r0 = chunk * 8;
        ld_mod(r0 >> 11);
#pragma unroll 1
        for (int h4 = 0; h4 < 2; ++h4) {
            u32x4 r[8];
#pragma unroll
            for (int j = 0; j < 4; ++j) { const u32x4* src = (const u32x4*)(X1 + (size_t)(r0 + 4 * h4 + j) * 1024 + lane * 16); r[2 * j] = src[0]; r[2 * j + 1] = src[1]; }
            pin8(r);
#pragma unroll
            for (int j = 0; j < 4; ++j) do_row(r0 + 4 * h4 + j, r[2 * j], r[2 * j + 1]);
        }
    }
    for (int rr = blockIdx.x * 8 + wid; rr < MS; rr += nw) {
        ld_mod(8 + (rr >> 3));
        const u32x4* src = (const u32x4*)(X1 + (size_t)(MP + rr) * 1024 + lane * 16);
        const u32x4 a = src[0], b = src[1];
        do_row(MP + rr, a, b);
    }
}

constexpr int PQ = 0, PK = 17408, PT = 34816, PR = 53248, PN = 118784, PG = 136192;
DI void prep_item(const Params& p, LAS unsigned char* lds, int ci) {
    const int tid = TID(), lane = tid & 63, wid = tid >> 6;
    const bf16_t* P0 = (const bf16_t*)(p.ws + WS_P0);
    const float* GB = (const float*)(p.ws + WS_GB);
    int h, row0, nvalid, nprev; const float* sconv = nullptr;
    if (ci < 2048) { const int bh = ci >> 5, n = ci & 31; h = bh & 7; row0 = (bh >> 3) * 2048 + n * 64; nvalid = 64; nprev = n * 64; }
    else { const int sb = (ci - 2048) >> 3; h = (ci - 2048) & 7; row0 = MP + sb * 8; nvalid = 8; nprev = 0; sconv = p.in[I_SC] + (size_t)sb * 3 * 3072; }
    LAS float* sg = (LAS float*)(lds + PG);
    LAS float* cw = (LAS float*)(lds + PG + 1024);
    const int i = tid >> 3, sub = tid & 7;
    lds_sync();
    u32x4 raw[4][3][2];
#pragma unroll
    for (int t = 0; t < 4; ++t) {
        const int rel = i - 3 + t;
#pragma unroll
        for (int sct = 0; sct < 3; ++sct) {
            const int ch = sct * 1024 + h * 128 + sub * 16;
            raw[t][sct][0] = (u32x4){0u, 0u, 0u, 0u}; raw[t][sct][1] = (u32x4){0u, 0u, 0u, 0u};
            if (i < nvalid) {
                if (rel >= 0 || nprev > 0) {
                    const u32x4* src = (const u32x4*)(P0 + (size_t)(row0 + rel) * 4096 + ch);
                    raw[t][sct][0] = src[0]; raw[t][sct][1] = src[1];
                } else if (sconv) {
                    const f32x4* src = (const f32x4*)(sconv + (size_t)(3 + rel) * 3072 + ch);
                    const f32x4 a = src[0], b = src[1], c = src[2], d = src[3];
                    raw[t][sct][0] = (u32x4){pk2(a[0], a[1]), pk2(a[2], a[3]), pk2(b[0], b[1]), pk2(b[2], b[3])};
                    raw[t][sct][1] = (u32x4){pk2(c[0], c[1]), pk2(c[2], c[3]), pk2(d[0], d[1]), pk2(d[2], d[3])};
                }
            }
        }
    }
    for (int idx = tid; idx < 1536; idx += 512) { const int t = idx / 384, rem = idx - t * 384, sct = rem >> 7, c = rem & 127; cw[idx] = p.in[I_ACONV][(size_t)t * 3072 + sct * 1024 + h * 128 + c]; }
    if (wid == 0) {
        float g = lane < nvalid ? GB[(size_t)(row0 + lane) * 16 + h] : 0.f;
        const float be = lane < nvalid ? GB[(size_t)(row0 + lane) * 16 + 8 + h] : 0.f;
#pragma unroll
        for (int o = 1; o < 64; o <<= 1) { const float t = __shfl_up(g, o); if (lane >= o) g += t; }
        sg[lane] = g; sg[64 + lane] = be; sg[128 + lane] = __expf(g);
        if (lane == 63) { sg[192] = g; ((float*)(p.ws + WS_GT))[ci] = __expf(g); }
    }
    asm volatile("" : "+v"(raw[0][0][0]), "+v"(raw[0][0][1]), "+v"(raw[0][1][0]), "+v"(raw[0][1][1]), "+v"(raw[0][2][0]), "+v"(raw[0][2][1]), "+v"(raw[1][0][0]), "+v"(raw[1][0][1]), "+v"(raw[1][1][0]), "+v"(raw[1][1][1]), "+v"(raw[1][2][0]), "+v"(raw[1][2][1]), "+v"(raw[2][0][0]), "+v"(raw[2][0][1]), "+v"(raw[2][1][0]), "+v"(raw[2][1][1]), "+v"(raw[2][2][0]), "+v"(raw[2][2][1]), "+v"(raw[3][0][0]), "+v"(raw[3][0][1]), "+v"(raw[3][1][0]), "+v"(raw[3][1][1]), "+v"(raw[3][2][0]), "+v"(raw[3][2][1]));
    lds_sync();
    {
        float y[3][16];
#pragma unroll
        for (int sct = 0; sct < 3; ++sct) {
#pragma unroll
            for (int j = 0; j < 16; ++j) y[sct][j] = 0.f;
#pragma unroll
            for (int t = 0; t < 4; ++t) {
                const u32x4 a = raw[t][sct][0], b = raw[t][sct][1];
                const float u[16] = {bflo(a.x), bfhi(a.x), bflo(a.y), bfhi(a.y), bflo(a.z), bfhi(a.z), bflo(a.w), bfhi(a.w),
                                     bflo(b.x), bfhi(b.x), bflo(b.y), bfhi(b.y), bflo(b.z), bfhi(b.z), bflo(b.w), bfhi(b.w)};
#pragma unroll
                for (int q = 0; q < 4; ++q) { const f32x4 w = *(const LAS f32x4*)(cw + (t * 3 + sct) * 128 + sub * 16 + q * 4);
                    y[sct][q * 4] += w[0] * u[q * 4]; y[sct][q * 4 + 1] += w[1] * u[q * 4 + 1]; y[sct][q * 4 + 2] += w[2] * u[q * 4 + 2]; y[sct][q * 4 + 3] += w[3] * u[q * 4 + 3]; }
            }
#pragma unroll
            for (int j = 0; j < 16; ++j) y[sct][j] = siluf(y[sct][j]);
        }
        float sq = 0.f, sk = 0.f;
#pragma unroll
        for (int j = 0; j < 16; ++j) { sq += y[0][j] * y[0][j]; sk += y[1][j] * y[1][j]; }
        sq += dpp_f<0xB1>(sq); sq += dpp_f<0x4E>(sq); sq += dpp_f<0x141>(sq);
        sk += dpp_f<0xB1>(sk); sk += dpp_f<0x4E>(sk); sk += dpp_f<0x141>(sk);
        const float rq = rsqrtf(sq + EPS) * 0.08838834764831845f, rk = rsqrtf(sk + EPS);
        const float gci = sg[i], bei = sg[64 + i], egi = sg[128 + i], ekd = __expf(sg[192] - gci);
        LAS float* R = (LAS float*)(lds + PR) + i * 256;
        u32x4 qa, qb, ka, kb, da, db;
        float qn[16], kn[16];
#pragma unroll
        for (int j = 0; j < 16; ++j) { qn[j] = y[0][j] * rq; kn[j] = y[1][j] * rk; }
        qa.x = pk2(qn[0], qn[1]); qa.y = pk2(qn[2], qn[3]); qa.z = pk2(qn[4], qn[5]); qa.w = pk2(qn[6], qn[7]);
        qb.x = pk2(qn[8], qn[9]); qb.y = pk2(qn[10], qn[11]); qb.z = pk2(qn[12], qn[13]); qb.w = pk2(qn[14], qn[15]);
        ka.x = pk2(kn[0], kn[1]); ka.y = pk2(kn[2], kn[3]); ka.z = pk2(kn[4], kn[5]); ka.w = pk2(kn[6], kn[7]);
        kb.x = pk2(kn[8], kn[9]); kb.y = pk2(kn[10], kn[11]); kb.z = pk2(kn[12], kn[13]); kb.w = pk2(kn[14], kn[15]);
        *(LAS u32x4*)(lds + PQ + i * 272 + sub * 32) = qa; *(LAS u32x4*)(lds + PQ + i * 272 + sub * 32 + 16) = qb;
        *(LAS u32x4*)(lds + PK + i * 272 + sub * 32) = ka; *(LAS u32x4*)(lds + PK + i * 272 + sub * 32 + 16) = kb;
        da.x = pk2(qn[0] * egi, qn[1] * egi); da.y = pk2(qn[2] * egi, qn[3] * egi); da.z = pk2(qn[4] * egi, qn[5] * egi); da.w = pk2(qn[6] * egi, qn[7] * egi);
        db.x = pk2(qn[8] * egi, qn[9] * egi); db.y = pk2(qn[10] * egi, qn[11] * egi); db.z = pk2(qn[12] * egi, qn[13] * egi); db.w = pk2(qn[14] * egi, qn[15] * egi);
        bf16_t* qd = (bf16_t*)(p.ws + WS_QD) + (size_t)ci * 8192 + i * 128 + sub * 16;
        *(u32x4*)qd = da; *(u32x4*)(qd + 8) = db;
        LAS bf16_t* T = (LAS bf16_t*)(lds + PT);
#pragma unroll
        for (int j = 0; j < 16; ++j) T[(sub * 16 + j) * 72 + i] = (bf16_t)(pk2(kn[j] * ekd, 0.f) & 0xffffu);
        const float kbs = bei * egi;
#pragma unroll
        for (int q = 0; q < 4; ++q) {
            *(LAS f32x4*)(R + sub * 16 + q * 4) = (f32x4){y[2][q * 4] * bei, y[2][q * 4 + 1] * bei, y[2][q * 4 + 2] * bei, y[2][q * 4 + 3] * bei};
            *(LAS f32x4*)(R + 128 + sub * 16 + q * 4) = (f32x4){kn[q * 4] * kbs, kn[q * 4 + 1] * kbs, kn[q * 4 + 2] * kbs, kn[q * 4 + 3] * kbs};
        }
    }
    lds_sync();
    {
        const int r16 = lane & 15, fq = lane >> 4;
        bf16_t* QK = (bf16_t*)(p.ws + WS_QK) + (size_t)ci * 4096;
        LAS float* Nm = (LAS float*)(lds + PN);
#pragma unroll
        for (int t = 0; t < 4; ++t) {
            const int id = wid * 4 + t, mat = id >> 4, ti = (id & 15) >> 2, tj = id & 3;
            f32x4 acc = {0.f, 0.f, 0.f, 0.f};
            if (tj <= ti) {
                const LAS unsigned char* xa = lds + PK + (tj * 16 + r16) * 272 + fq * 16;
                const LAS unsigned char* xb = lds + (mat ? PQ : PK) + (ti * 16 + r16) * 272 + fq * 16;
#pragma unroll
                for (int ks = 0; ks < 4; ++ks) acc = mfma16(lds_ld8(xa + ks * 64), lds_ld8(xb + ks * 64), acc);
            }
            const int i = ti * 16 + r16, j0 = tj * 16 + fq * 4;
            const float gi = sg[i], bi = sg[64 + i];
            f32x4 o;
#pragma unroll
            for (int r = 0; r < 4; ++r) {
                const int j = j0 + r;
                const bool ok = mat ? (j <= i) : (j < i);
                const float dec = ok ? __expf(gi - sg[j]) : 0.f;
                o[r] = ok ? acc[r] * dec * (mat ? 1.f : bi) : 0.f;
            }
            if (mat) { u32x2 w; w.x = pk2(o[0], o[1]); w.y = pk2(o[2], o[3]); *(u32x2*)(QK + i * 64 + j0) = w; }
            else *(LAS f32x4*)(Nm + i * 68 + j0) = o;
        }
    }
    lds_sync();
    if (tid < 256) {
        const LAS float* R = (const LAS float*)(lds + PR) + tid;
        int zv = 0; asm volatile("" : "+v"(zv));
        const LAS float* Nm = (const LAS float*)(lds + PN + zv);
        float x[64];
        f32x4 nb[2][16];
        x[0] = R[0];
        float rn = R[256];
        nb[1][0] = *(const LAS f32x4*)(Nm + 68);
#pragma unroll
        for (int i = 1; i < 64; ++i) {
            const float r = rn;
            if (i + 1 < 64) {
                rn = R[(i + 1) * 256];
#pragma unroll
                for (int j4 = 0; j4 < (i + 4) / 4; ++j4) nb[(i + 1) & 1][j4] = *(const LAS f32x4*)(Nm + (i + 1) * 68 + j4 * 4);
            }
            float a0 = 0.f, a1 = 0.f, a2 = 0.f, a3 = 0.f;
#pragma unroll
            for (int j4 = 0; j4 < (i + 3) / 4; ++j4) {
                const f32x4 nv = nb[i & 1][j4];
                if (j4 * 4 + 0 < i) a0 += nv[0] * x[j4 * 4 + 0];
                if (j4 * 4 + 1 < i) a1 += nv[1] * x[j4 * 4 + 1];
                if (j4 * 4 + 2 < i) a2 += nv[2] * x[j4 * 4 + 2];
                if (j4 * 4 + 3 < i) a3 += nv[3] * x[j4 * 4 + 3];
            }
            x[i] = r - ((a0 + a1) + (a2 + a3));
            asm volatile("" ::: "memory");
        }
        if (tid < 128) {
            u32x4* d = (u32x4*)((bf16_t*)(p.ws + WS_WV) + (size_t)ci * 8192 + tid * 64);
#pragma unroll
            for (int q = 0; q < 8; ++q) { u32x4 w; w.x = pk2(x[q * 8], x[q * 8 + 1]); w.y = pk2(x[q * 8 + 2], x[q * 8 + 3]); w.z = pk2(x[q * 8 + 4], x[q * 8 + 5]); w.w = pk2(x[q * 8 + 6], x[q * 8 + 7]); d[q] = w; }
        } else {
            bf16_t* d = (bf16_t*)(p.ws + WS_KC) + (size_t)ci * 8192 + (tid - 128);
#pragma unroll
            for (int i = 0; i < 64; ++i) d[i * 128] = (bf16_t)(pk2(x[i], 0.f) & 0xffffu);
        }
    } else {
        bf16_t* d = (bf16_t*)(p.ws + WS_KDT) + (size_t)ci * 8192;
#pragma unroll
        for (int q = 0; q < 4; ++q) { const int idx = (tid - 256) + q * 256, r = idx >> 3, c8 = idx & 7; *(u32x4*)(d + r * 64 + c8 * 8) = *(const LAS u32x4*)(lds + PT + r * 144 + c8 * 16); }
    }
}
DI void phase_dprep(const Params& p, LAS unsigned char* lds) { for (int ci = blockIdx.x; ci < NCH; ci += gridDim.x) prep_item(p, lds, ci); }

constexpr int SKC = 0, SQD = 17408, SKD = 34816, SQK = 53248, SST = 62464, SUT = 71168;
DI void scan_item(const Params& p, LAS unsigned char* lds, int item) {
    const int tid = TID(), lane = tid & 63, wid = tid >> 6, r16 = lane & 15, fq = lane >> 4;
    int ch0, nch, rowbase, h, dvs, nvalid; const float* S0 = nullptr; float* Sout;
    if (item < 256) { const int bh = item >> 2; dvs = item & 3; h = bh & 7; ch0 = bh * 32; nch = 32; rowbase = (bh >> 3) * 2048; nvalid = 64; Sout = p.out + O_DP + (size_t)bh * 16384; }
    else { const int it = item - 256, sbh = it >> 2; dvs = it & 3; h = sbh & 7; ch0 = 2048 + sbh; nch = 1; rowbase = MP + (sbh >> 3) * 8; nvalid = 8;
           S0 = p.in[I_SD] + (size_t)sbh * 16384; Sout = p.out + O_DS + (size_t)sbh * 16384; }
    const int dvoff = dvs * 32;
    const int dk0 = wid * 16;
    f32x4 accS[2];
#pragma unroll
    for (int vt = 0; vt < 2; ++vt)
#pragma unroll
        for (int r = 0; r < 4; ++r) accS[vt][r] = S0 ? S0[(size_t)(dk0 + 4 * fq + r) * 128 + dvoff + vt * 16 + r16] : 0.f;
    const bf16_t* gKC = (const bf16_t*)(p.ws + WS_KC); const bf16_t* gQD = (const bf16_t*)(p.ws + WS_QD);
    const bf16_t* gKD = (const bf16_t*)(p.ws + WS_KDT); const bf16_t* gQK = (const bf16_t*)(p.ws + WS_QK);
    const bf16_t* gWV = (const bf16_t*)(p.ws + WS_WV); const float* gGT = (const float*)(p.ws + WS_GT);
    bf16_t* O0 = (bf16_t*)(p.ws + WS_O0);
    u32x4 st[7];
    auto issue = [&](int ci) {
        const u32x4* a = (const u32x4*)(gKC + (size_t)ci * 8192); const u32x4* b = (const u32x4*)(gQD + (size_t)ci * 8192);
        const u32x4* c = (const u32x4*)(gKD + (size_t)ci * 8192); const u32x4* d = (const u32x4*)(gQK + (size_t)ci * 4096);
        st[0] = a[tid]; st[1] = a[tid + 512]; st[2] = b[tid]; st[3] = b[tid + 512]; st[4] = c[tid]; st[5] = c[tid + 512]; st[6] = d[tid];
    };
    auto commit = [&]() {
#pragma unroll
        for (int l = 0; l < 2; ++l) { const int idx = tid + 512 * l;
            *(LAS u32x4*)(lds + SKC + (idx >> 4) * 272 + (idx & 15) * 16) = st[l];
            *(LAS u32x4*)(lds + SQD + (idx >> 4) * 272 + (idx & 15) * 16) = st[2 + l];
            *(LAS u32x4*)(lds + SKD + (idx >> 3) * 144 + (idx & 7) * 16) = st[4 + l]; }
        *(LAS u32x4*)(lds + SQK + (tid >> 3) * 144 + (tid & 7) * 16) = st[6];
    };
    auto put_St = [&]() {
#pragma unroll
        for (int vt = 0; vt < 2; ++vt) { u32x2 w; w.x = pk2(accS[vt][0], accS[vt][1]); w.y = pk2(accS[vt][2], accS[vt][3]);
            *(LAS u32x2*)(lds + SST + (vt * 16 + r16) * 272 + (dk0 + 4 * fq) * 2) = w; }
    };
    lds_sync();
    issue(ch0); put_St(); commit();
    lds_sync();
    const int c0 = (wid & 3) * 16, v0 = (wid >> 2) * 16;
    u32x2 wv_n = *(const u32x2*)(gWV + (size_t)ch0 * 8192 + (dvoff + v0 + r16) * 64 + c0 + 4 * fq);
    float gtot_n = gGT[ch0];
    for (int n = 0; n < nch; ++n) {
        const int ci = ch0 + n;
        const u32x2 wv = wv_n; const float gtot = gtot_n;
        if (n + 1 < nch) { issue(ci + 1); wv_n = *(const u32x2*)(gWV + (size_t)(ci + 1) * 8192 + (dvoff + v0 + r16) * 64 + c0 + 4 * fq); gtot_n = gGT[ci + 1]; }
        f32x4 a1 = {0.f, 0.f, 0.f, 0.f};
        { bf16x8 fa[4], fb[4];
#pragma unroll
          for (int ks = 0; ks < 4; ++ks) { fa[ks] = lds_ld8(lds + SKC + (c0 + r16) * 272 + ks * 64 + fq * 16); fb[ks] = lds_ld8(lds + SST + (v0 + r16) * 272 + ks * 64 + fq * 16); }
          pin4x4(fa, fb);
#pragma unroll
          for (int ks = 0; ks < 4; ++ks) a1 = mfma16(fa[ks], fb[ks], a1); }
        { u32x2 w; w.x = pk2(bflo(wv.x) - a1[0], bfhi(wv.x) - a1[1]); w.y = pk2(bflo(wv.y) - a1[2], bfhi(wv.y) - a1[3]);
          *(LAS u32x2*)(lds + SUT + (v0 + r16) * 144 + (c0 + 4 * fq) * 2) = w; }
        lds_sync();
        f32x4 a2 = {0.f, 0.f, 0.f, 0.f};
        bf16x8 ga[8], gb[8];
#pragma unroll
        for (int ks = 0; ks < 4; ++ks) { ga[ks] = lds_ld8(lds + SST + (v0 + r16) * 272 + ks * 64 + fq * 16); gb[ks] = lds_ld8(lds + SQD + (c0 + r16) * 272 + ks * 64 + fq * 16); }
#pragma unroll
        for (int ks = 0; ks < 2; ++ks) { ga[4 + ks] = lds_ld8(lds + SUT + (v0 + r16) * 144 + ks * 64 + fq * 16); gb[4 + ks] = lds_ld8(lds + SQK + (c0 + r16) * 144 + ks * 64 + fq * 16); }
#pragma unroll
        for (int ks = 0; ks < 2; ++ks) { ga[6 + ks] = lds_ld8(lds + SKD + (dk0 + r16) * 144 + ks * 64 + fq * 16); gb[6 + ks] = lds_ld8(lds + SUT + ((1 - (wid >> 2)) * 16 + r16) * 144 + ks * 64 + fq * 16); }
        pin8x8(ga, gb);
#pragma unroll
        for (int ks = 0; ks < 6; ++ks) a2 = mfma16(ga[ks], gb[ks], a2);
        if (c0 + r16 < nvalid) { u32x2 w; w.x = pk2(a2[0], a2[1]); w.y = pk2(a2[2], a2[3]);
            *(u32x2*)(O0 + (size_t)(rowbase + n * 64 + c0 + r16) * 1024 + h * 128 + dvoff + v0 + 4 * fq) = w; }
#pragma unroll
        for (int vt = 0; vt < 2; ++vt) {
            accS[vt] *= gtot;
            const bool own = (vt == (wid >> 2));
#pragma unroll
            for (int ks = 0; ks < 2; ++ks) accS[vt] = mfma16(ga[6 + ks], own ? ga[4 + ks] : gb[6 + ks], accS[vt]);
        }
        lds_sync();
        put_St();
        if (n + 1 < nch) commit();
        lds_sync();
    }
#pragma unroll
    for (int vt = 0; vt < 2; ++vt)
#pragma unroll
        for (int r = 0; r < 4; ++r) Sout[(size_t)(dk0 + 4 * fq + r) * 128 + dvoff + vt * 16 + r16] = accS[vt][r];
}
DI void phase_scan(const Params& p, LAS unsigned char* lds) {
    const int bid = blockIdx.x, G = gridDim.x;
    if (G == 256) {
        const int xcd = bid & 7, idx = bid >> 3, dvs = idx & 3, hx = xcd * 8 + (idx >> 2);
        scan_item(p, lds, hx * 4 + dvs);
        for (int i = 0; i < 4; ++i) scan_item(p, lds, 256 + (i * 64 + hx) * 4 + dvs);
    } else {
        for (int it = bid; it < 256 + 1024; it += G) scan_item(p, lds, it);
    }
}

DI void phase_gate0(const Params& p) {
    const int lane = TID() & 63, wid = TID() >> 6;
    const bf16_t* O0 = (const bf16_t*)(p.ws + WS_O0); const bf16_t* P0 = (const bf16_t*)(p.ws + WS_P0); bf16_t* ACT = (bf16_t*)(p.ws + WS_ACT);
    const float* og = p.in[I_AOG] + (lane & 7) * 16;
    const int nw = gridDim.x * 8;
    auto ld_row = [&](int row, u32x4 (&r)[4]) {
        const u32x4* so = (const u32x4*)(O0 + (size_t)row * 1024 + lane * 16); const u32x4* sz = (const u32x4*)(P0 + (size_t)row * 4096 + 3072 + lane * 16);
        r[0] = so[0]; r[1] = so[1]; r[2] = sz[0]; r[3] = sz[1];
    };
    auto do_row = [&](int row, const u32x4 (&r)[4]) {
        float o[16], z[16];
#pragma unroll
        for (int q = 0; q < 2; ++q) { const u32x4 a = r[q], b = r[2 + q];
            o[q * 8] = bflo(a.x); o[q * 8 + 1] = bfhi(a.x); o[q * 8 + 2] = bflo(a.y); o[q * 8 + 3] = bfhi(a.y); o[q * 8 + 4] = bflo(a.z); o[q * 8 + 5] = bfhi(a.z); o[q * 8 + 6] = bflo(a.w); o[q * 8 + 7] = bfhi(a.w);
            z[q * 8] = bflo(b.x); z[q * 8 + 1] = bfhi(b.x); z[q * 8 + 2] = bflo(b.y); z[q * 8 + 3] = bfhi(b.y); z[q * 8 + 4] = bflo(b.z); z[q * 8 + 5] = bfhi(b.z); z[q * 8 + 6] = bflo(b.w); z[q * 8 + 7] = bfhi(b.w); }
        float ss = 0.f;
#pragma unroll
        for (int j = 0; j < 16; ++j) ss += o[j] * o[j];
        ss += dpp_f<0xB1>(ss); ss += dpp_f<0x4E>(ss); ss += dpp_f<0x141>(ss);
        const float rstd = rsqrtf(ss * (1.f / 128.f) + EPS);
        float rr[16];
#pragma unroll
        for (int j = 0; j < 16; ++j) rr[j] = o[j] * rstd * og[j] * siluf(z[j]);
        u32x4 w0, w1;
        w0.x = pk2(rr[0], rr[1]); w0.y = pk2(rr[2], rr[3]); w0.z = pk2(rr[4], rr[5]); w0.w = pk2(rr[6], rr[7]);
        w1.x = pk2(rr[8], rr[9]); w1.y = pk2(rr[10], rr[11]); w1.z = pk2(rr[12], rr[13]); w1.w = pk2(rr[14], rr[15]);
        u32x4* d = (u32x4*)(ACT + (size_t)row * 1024 + lane * 16); d[0] = w0; d[1] = w1;
    };
    const int chunk0 = gridDim.x == 256 ? ((int)(blockIdx.x & 7) * 256 + (int)(blockIdx.x >> 3) * 8 + wid) : (int)blockIdx.x * 8 + wid;
    for (int chunk = chunk0; chunk < MP / 8; chunk += nw) {
#pragma unroll 1
        for (int h4 = 0; h4 < 2; ++h4) {
            u32x4 ra[4], rb[4], rc[4], rd[4];
            const int row = chunk * 8 + 4 * h4;
            ld_row(row, ra); ld_row(row + 1, rb); ld_row(row + 2, rc); ld_row(row + 3, rd); pin4x4x4x4(ra, rb, rc, rd);
            do_row(row, ra); do_row(row + 1, rb); do_row(row + 2, rc); do_row(row + 3, rd);
        }
    }
    for (int r = blockIdx.x * 8 + wid; r < MS; r += nw) { u32x4 ra[4]; ld_row(MP + r, ra); do_row(MP + r, ra); }
}

constexpr int AK = 0, AV = 73984;
struct AttnPre { u32x4 k[8]; u32x4 v[8]; bf16x8 q[4]; };
struct AttnIt { int g, b, h, r, j0, d, Sd; };
DI AttnIt attn_decode(int item) {
    AttnIt a; const int x = item & 15; a.h = (item >> 4) & 7; a.b = (item >> 7) & 7; a.g = item >> 10;
    const int dshift = a.g * 2; a.d = 1 << dshift; a.Sd = 2048 >> dshift; const int nqb = a.Sd >> 7;
    a.r = x / nqb; a.j0 = (x % nqb) * 128; return a;
}
DI void attn_issue(const Params& p, int item, AttnPre& pre) {
    const int tid = TID(), lane = tid & 63, wid = tid >> 6, r16 = lane & 15, fq = lane >> 4;
    const AttnIt a = attn_decode(item);
    const bf16_t* base = (const bf16_t*)(p.ws + WS_P1) + (size_t)a.b * 2048 * 10240 + a.g * 1024 + a.h * 128;
    const size_t rstride = (size_t)a.d * 10240;
    const bf16_t* kbase = base + (long)((a.j0 - 128) * a.d + a.r) * 10240;
    const int kg = tid >> 4, ec = tid & 15;
    if (a.j0 != 0) {
#pragma unroll
        for (int k = 0; k < 8; ++k) { const int idx = tid + 512 * k; pre.k[k] = *(const u32x4*)(kbase + (size_t)(idx >> 4) * rstride + 3072 + (idx & 15) * 8); }
#pragma unroll
        for (int i = 0; i < 8; ++i) pre.v[i] = *(const u32x4*)(kbase + (size_t)(kg * 8 + i) * rstride + 6144 + ec * 8);
    } else {
#pragma unroll
        for (int k = 0; k < 4; ++k) pre.k[k] = (u32x4){0u, 0u, 0u, 0u};
#pragma unroll
        for (int k = 4; k < 8; ++k) { const int idx = tid + 512 * k; pre.k[k] = *(const u32x4*)(kbase + (size_t)(idx >> 4) * rstride + 3072 + (idx & 15) * 8); }
#pragma unroll
        for (int i = 0; i < 8; ++i) { pre.v[i] = (u32x4){0u, 0u, 0u, 0u}; if (tid >= 256) pre.v[i] = *(const u32x4*)(kbase + (size_t)(kg * 8 + i) * rstride + 6144 + ec * 8); }
    }
    const int qtok = (a.j0 + 16 * wid + r16) * a.d + a.r;
#pragma unroll
    for (int ks = 0; ks < 4; ++ks) pre.q[ks] = *(const bf16x8*)(base + (size_t)qtok * 10240 + ks * 32 + fq * 8);
}
DI void st_f32x8_from_bf16(float* d, u32x4 w) {
    *(f32x4*)d = (f32x4){bflo(w.x), bfhi(w.x), bflo(w.y), bfhi(w.y)}; *(f32x4*)(d + 4) = (f32x4){bflo(w.z), bfhi(w.z), bflo(w.w), bfhi(w.w)};
}
DI void attn_commit(LAS unsigned char* lds, const AttnPre& pre, const Params& p, int item) {
    const int tid = TID();
    const AttnIt a = attn_decode(item);
#pragma unroll
    for (int k = 0; k < 8; ++k) { const int idx = tid + 512 * k; *(LAS u32x4*)(lds + AK + (idx >> 4) * 272 + (idx & 15) * 16) = pre.k[k]; }
    const int kg = tid >> 4, ec = tid & 15;
#pragma unroll
    for (int e2 = 0; e2 < 4; ++e2) {
        u32x4 lo, hi;
#pragma unroll
        for (int pq = 0; pq < 4; ++pq) { const unsigned x0 = pre.v[2 * pq][e2], x1 = pre.v[2 * pq + 1][e2]; lo[pq] = (x0 & 0xffffu) | (x1 << 16); hi[pq] = (x0 >> 16) | (x1 & 0xffff0000u); }
        *(LAS u32x4*)(lds + AV + (ec * 8 + 2 * e2) * 560 + kg * 16) = lo;
        *(LAS u32x4*)(lds + AV + (ec * 8 + 2 * e2 + 1) * 560 + kg * 16) = hi;
    }
}
DI void attn_compute(const Params& p, LAS unsigned char* lds, int item, const bf16x8 (&qf)[4]) {
    const int tid = TID(), lane = tid & 63, wid = tid >> 6, r16 = lane & 15, fq = lane >> 4;
    const AttnIt a = attn_decode(item);
    const int g = a.g, b = a.b, h = a.h;
    const int qj = a.j0 + 16 * wid + r16, qtok = qj * a.d + a.r;
    f32x4 s[10];
    const LAS unsigned char* kbase = lds + AK + (16 * wid + r16) * 272 + fq * 16;
#pragma unroll
    for (int T2 = 0; T2 < 5; ++T2) {
        bf16x8 kf[8];
#pragma unroll
        for (int u = 0; u < 8; ++u) { const int T = 2 * T2 + (u >> 2); kf[u] = lds_ld8(kbase + (T < 9 ? T : 8) * (16 * 272) + (u & 3) * 64); }
        pin8(kf);
#pragma unroll
        for (int u = 0; u < 8; ++u) { const int T = 2 * T2 + (u >> 2); if (T < 9) { if ((u & 3) == 0) s[T] = (f32x4){0.f, 0.f, 0.f, 0.f}; s[T] = mfma16(kf[u], qf[u & 3], s[T]); } }
    }
#pragma unroll
    for (int rr = 0; rr < 4; ++rr) {
        if (r16 - 4 * fq - rr > 0) s[0][rr] = -INFINITY;
        if (r16 - 4 * fq - rr < 0) s[8][rr] = -INFINITY;
    }
    if (a.j0 == 0) {
#pragma unroll
        for (int T = 0; T < 9; ++T)
#pragma unroll
            for (int rr = 0; rr < 4; ++rr) { const int rel = 128 + r16 - 16 * T - 4 * fq - rr; if (qj - rel < 0) s[T][rr] = -INFINITY; }
    }
    float m = -INFINITY;
#pragma unroll
    for (int T = 0; T < 9; ++T) m = fmaxf(m, fmaxf(fmaxf(s[T][0], s[T][1]), fmaxf(s[T][2], s[T][3])));
    m = fmaxf(m, __shfl_xor(m, 16)); m = fmaxf(m, __shfl_xor(m, 32));
    float l = 0.f;
#pragma unroll
    for (int T = 0; T < 9; ++T)
#pragma unroll
        for (int rr = 0; rr < 4; ++rr) { const float pv = __builtin_amdgcn_exp2f(s[T][rr] - m); s[T][rr] = pv; l += pv; }
    s[9] = (f32x4){0.f, 0.f, 0.f, 0.f};
    l += __shfl_xor(l, 16); l += __shfl_xor(l, 32);
    f32x4 o[8];
#pragma unroll
    for (int et = 0; et < 8; ++et) o[et] = (f32x4){0.f, 0.f, 0.f, 0.f};
    const LAS unsigned char* vbase = lds + AV + r16 * 560 + (16 * wid + 4 * fq) * 2;
#pragma unroll
    for (int tp = 0; tp < 5; ++tp) {
        u32x4 pb; pb.x = pk2(s[2 * tp][0], s[2 * tp][1]); pb.y = pk2(s[2 * tp][2], s[2 * tp][3]); pb.z = pk2(s[2 * tp + 1][0], s[2 * tp + 1][1]); pb.w = pk2(s[2 * tp + 1][2], s[2 * tp + 1][3]);
        const bf16x8 pf = __builtin_bit_cast(bf16x8, pb);
        u32x4 vv[8];
#pragma unroll
        for (int et = 0; et < 8; ++et) {
            const LAS unsigned char* vp = vbase + et * (16 * 560) + tp * 64;
            const u32x2 va = *(const LAS u32x2*)vp, vb = *(const LAS u32x2*)(vp + 32);
            vv[et] = (u32x4){va.x, va.y, vb.x, vb.y};
        }
        pin8(vv);
#pragma unroll
        for (int et = 0; et < 8; ++et) o[et] = mfma16(__builtin_bit_cast(bf16x8, vv[et]), pf, o[et]);
    }
    const float il = 1.f / l;
    const size_t orow = (size_t)b * 2048 + qtok;
    bf16_t* og = (bf16_t*)(p.ws + WS_OG) + ((size_t)g * MT + orow) * 1024 + h * 128;
#pragma unroll
    for (int et = 0; et < 8; ++et) { u32x2 w; w.x = pk2(o[et][0] * il, o[et][1] * il); w.y = pk2(o[et][2] * il, o[et][3] * il); *(u32x2*)(og + 16 * et + 4 * fq) = w; }
    if (fq == 0) ((float*)(p.ws + WS_LSE))[((size_t)g * MT + orow) * 8 + h] = 0.6931471805599453f * (m + log2f(l));
}
DI void attn_prompt_all(const Params& p, LAS unsigned char* lds) {
    const int tid = TID();
    lds_sync();
    if (tid < 256) *(LAS u32x4*)(lds + AK + (256 + (tid >> 4)) * 272 + (tid & 15) * 16) = (u32x4){0u, 0u, 0u, 0u};
    else { const int t2 = tid - 256; *(LAS u32x4*)(lds + AV + (t2 >> 1) * 560 + (256 + (t2 & 1) * 8) * 2) = (u32x4){0u, 0u, 0u, 0u}; }
    AttnPre pre;
    const int bid = blockIdx.x, G = gridDim.x, nround = G == 256 ? 12 : (3072 - bid + G - 1) / G;
    auto item_of = [&](int i) { const int idx = i * 2 + (bid >> 7); return G == 256 ? ((((idx >> 3) * 8 + (bid & 7)) * 8 + (idx & 7)) * 16 + ((bid >> 3) & 15)) : bid + i * G; };
    if (nround > 0) attn_issue(p, item_of(0), pre);
    for (int i = 0; i < nround; ++i) {
        const int it = item_of(i);
        lds_sync();
        attn_commit(lds, pre, p, it);
        bf16x8 qf[4];
#pragma unroll
        for (int ks = 0; ks < 4; ++ks) qf[ks] = pre.q[ks];
        if (i + 1 < nround) attn_issue(p, item_of(i + 1), pre);
        lds_sync();
        attn_compute(p, lds, it, qf);
    }
    lds_sync();
}
DI void attn_sample_item(const Params& p, LAS unsigned char* lds, int witem) {
    const int lane = TID() & 63, wid = TID() >> 6;
    const int h = witem & 7, l = (witem >> 3) & 7, bg = witem >> 6, g = bg % 3, b = bg / 3;
    const int d = 1 << (2 * g), Lbuf = 128 << (2 * g);
    const float* cache = p.in[I_C128 + g] + (size_t)b * Lbuf * 2048;
    const float* fresh = p.out + (g == 0 ? O_KVS0 : (g == 1 ? O_KVS1 : O_KVS2)) + (size_t)b * 8 * 2048;
    const int row = MP + b * 8 + l;
    const bf16_t* qp = (const bf16_t*)(p.ws + WS_P1) + (size_t)row * 10240 + g * 1024 + h * 128;
    LAS float* sc = (LAS float*)lds + wid * 136;
    const int sub = lane & 15, kq = lane >> 4;
    float q[8];
    { const u32x2 a = *(const u32x2*)(qp + sub * 4), c = *(const u32x2*)(qp + 64 + sub * 4);
      q[0] = bflo(a.x); q[1] = bfhi(a.x); q[2] = bflo(a.y); q[3] = bfhi(a.y); q[4] = bflo(c.x); q[5] = bfhi(c.x); q[6] = bflo(c.y); q[7] = bfhi(c.y); }
#pragma unroll 1
    for (int bt = 0; bt < 4; ++bt) {
        f32x4 ka[8], kb[8];
#pragma unroll
        for (int u = 0; u < 8; ++u) {
            const int mk = (bt * 8 + u) * 4 + kq, idx = Lbuf + l - d * mk;
            const float* kr = (idx >= Lbuf ? fresh + (size_t)(idx - Lbuf) * 2048 : cache + (size_t)idx * 2048) + h * 128 + sub * 4;
            ka[u] = *(const f32x4*)kr; kb[u] = *(const f32x4*)(kr + 64);
        }
        asm volatile("" ::: "memory");
        float dots[8];
#pragma unroll
        for (int u = 0; u < 8; ++u) dots[u] = q[0] * ka[u][0] + q[1] * ka[u][1] + q[2] * ka[u][2] + q[3] * ka[u][3] + q[4] * kb[u][0] + q[5] * kb[u][1] + q[6] * kb[u][2] + q[7] * kb[u][3];
#pragma unroll
        for (int u = 0; u < 8; ++u) dots[u] = row16_sum(dots[u]);
#pragma unroll
        for (int u = 0; u < 8; ++u) sc[(bt * 8 + u) * 4 + kq] = dots[u];
    }
    {
        const int idx = Lbuf + l - d * 128;
        const float* kr = cache + (size_t)idx * 2048 + h * 128 + sub * 4;
        const f32x4 k0 = *(const f32x4*)kr, k1 = *(const f32x4*)(kr + 64);
        float dot = q[0] * k0[0] + q[1] * k0[1] + q[2] * k0[2] + q[3] * k0[3] + q[4] * k1[0] + q[5] * k1[1] + q[6] * k1[2] + q[7] * k1[3];
        dot = row16_sum(dot);
        sc[128 + kq] = dot;
    }
    __builtin_amdgcn_s_waitcnt(0xc07f);
    __builtin_amdgcn_wave_barrier();
    const float s0 = sc[lane], s1 = sc[64 + lane], s2 = lane == 0 ? sc[128] : -INFINITY;
    const float m = wave_max(fmaxf(fmaxf(s0, s1), s2));
    const float p0 = exp2f(s0 - m), p1 = exp2f(s1 - m), p2 = lane == 0 ? exp2f(s2 - m) : 0.f;
    const float lsum = wave_sum(p0 + p1 + p2);
    __builtin_amdgcn_wave_barrier();
    sc[lane] = p0; sc[64 + lane] = p1; if (lane == 0) sc[128] = p2;
    __builtin_amdgcn_s_waitcnt(0xc07f);
    __builtin_amdgcn_wave_barrier();
    const int half = lane >> 5, l32 = lane & 31;
    f32x4 o = {0.f, 0.f, 0.f, 0.f};
#pragma unroll 1
    for (int bt = 0; bt < 8; ++bt) {
        f32x4 vb[8]; float pw[8];
#pragma unroll
        for (int u = 0; u < 8; ++u) {
            const int mk = 2 * (bt * 8 + u) + half, idx = Lbuf + l - d * mk;
            const float* vr = (idx >= Lbuf ? fresh + (size_t)(idx - Lbuf) * 2048 : cache + (size_t)idx * 2048) + 1024 + h * 128 + l32 * 4;
            vb[u] = *(const f32x4*)vr; pw[u] = sc[mk];
        }
        asm volatile("" ::: "memory");
#pragma unroll
        for (int u = 0; u < 8; ++u) o += pw[u] * vb[u];
    }
    { const int idx = Lbuf + l - d * 128;
      const f32x4 v = *(const f32x4*)(cache + (size_t)idx * 2048 + 1024 + h * 128 + l32 * 4); const float pw = half ? 0.f : sc[128];
      o += pw * v; }
    o[0] += __shfl_xor(o[0], 32); o[1] += __shfl_xor(o[1], 32); o[2] += __shfl_xor(o[2], 32); o[3] += __shfl_xor(o[3], 32);
    const float il = 1.f / lsum;
    if (half == 0) { u32x2 w; w.x = pk2(o[0] * il, o[1] * il); w.y = pk2(o[2] * il, o[3] * il);
        *(u32x2*)((bf16_t*)(p.ws + WS_OG) + ((size_t)g * MT + row) * 1024 + h * 128 + l32 * 4) = w; }
    if (lane == 0) ((float*)(p.ws + WS_LSE))[((size_t)g * MT + row) * 8 + h] = 0.6931471805599453f * (m + log2f(lsum));
    __builtin_amdgcn_wave_barrier();
}
DI void attn_sample_all(const Params& p, LAS unsigned char* lds) {
    const int bid = blockIdx.x, G = gridDim.x, wv = TID() >> 6;
    if (G == 256) { for (int i = 0; i < 3; ++i) { const int bg = i * 32 + (bid & 7) * 4 + (bid >> 6), l = (bid >> 3) & 7; attn_sample_item(p, lds, (bg * 8 + l) * 8 + wv); } }
    else for (int it = bid; it < 768; it += G) attn_sample_item(p, lds, it * 8 + wv);
}
DI void phase_attn(const Params& p, LAS unsigned char* lds) {
    if (blockIdx.x & 1) { attn_sample_all(p, lds); __syncthreads(); }
    attn_prompt_all(p, lds);
    if (!(blockIdx.x & 1)) attn_sample_all(p, lds);
}

DI void phase_gate1(const Params& p) {
    const int lane = TID() & 63, wid = TID() >> 6;
    const bf16_t* OG = (const bf16_t*)(p.ws + WS_OG); const bf16_t* P1 = (const bf16_t*)(p.ws + WS_P1); const float* LSE = (const float*)(p.ws + WS_LSE);
    bf16_t* ACT = (bf16_t*)(p.ws + WS_ACT);
    const int nw = gridDim.x * 8, hd = lane >> 3;
    auto ld_row = [&](int row, u32x4 (&r)[8], float (&ls)[3]) {
#pragma unroll
        for (int g = 0; g < 3; ++g) { const u32x4* so = (const u32x4*)(OG + ((size_t)g * MT + row) * 1024 + lane * 16); r[2 * g] = so[0]; r[2 * g + 1] = so[1]; ls[g] = LSE[((size_t)g * MT + row) * 8 + hd]; }
        const u32x4* sz = (const u32x4*)(P1 + (size_t)row * 10240 + 9216 + lane * 16); r[6] = sz[0]; r[7] = sz[1];
    };
    auto do_row = [&](int row, const u32x4 (&r)[8], const float (&ls)[3]) {
        const float mx = fmaxf(ls[0], fmaxf(ls[1], ls[2]));
        float w[3] = {__expf(ls[0] - mx), __expf(ls[1] - mx), __expf(ls[2] - mx)};
        const float iw = 1.f / (w[0] + w[1] + w[2]);
        float acc[16];
#pragma unroll
        for (int j = 0; j < 16; ++j) acc[j] = 0.f;
#pragma unroll
        for (int g = 0; g < 3; ++g) {
            const float wg = w[g] * iw;
#pragma unroll
            for (int q = 0; q < 2; ++q) { const u32x4 a = r[2 * g + q];
                acc[q * 8] += wg * bflo(a.x); acc[q * 8 + 1] += wg * bfhi(a.x); acc[q * 8 + 2] += wg * bflo(a.y); acc[q * 8 + 3] += wg * bfhi(a.y);
                acc[q * 8 + 4] += wg * bflo(a.z); acc[q * 8 + 5] += wg * bfhi(a.z); acc[q * 8 + 6] += wg * bflo(a.w); acc[q * 8 + 7] += wg * bfhi(a.w); }
        }
        float z[16];
#pragma unroll
        for (int q = 0; q < 2; ++q) { const u32x4 b = r[6 + q];
            z[q * 8] = bflo(b.x); z[q * 8 + 1] = bfhi(b.x); z[q * 8 + 2] = bflo(b.y); z[q * 8 + 3] = bfhi(b.y); z[q * 8 + 4] = bflo(b.z); z[q * 8 + 5] = bfhi(b.z); z[q * 8 + 6] = bflo(b.w); z[q * 8 + 7] = bfhi(b.w); }
        float rr[16];
#pragma unroll
        for (int j = 0; j < 16; ++j) rr[j] = acc[j] * siluf(z[j]);
        u32x4 w0, w1;
        w0.x = pk2(rr[0], rr[1]); w0.y = pk2(rr[2], rr[3]); w0.z = pk2(rr[4], rr[5]); w0.w = pk2(rr[6], rr[7]);
        w1.x = pk2(rr[8], rr[9]); w1.y = pk2(rr[10], rr[11]); w1.z = pk2(rr[12], rr[13]); w1.w = pk2(rr[14], rr[15]);
        u32x4* d = (u32x4*)(ACT + (size_t)row * 1024 + lane * 16); d[0] = w0; d[1] = w1;
    };
    const int chunk0 = gridDim.x == 256 ? ((int)(blockIdx.x & 7) * 256 + (int)(blockIdx.x >> 3) * 8 + wid) : (int)blockIdx.x * 8 + wid;
    for (int chunk = chunk0; chunk < MP / 8; chunk += nw) {
#pragma unroll 1
        for (int h2 = 0; h2 < 4; ++h2) {
            u32x4 ra[8], rb[8]; float la[3], lb[3];
            const int row = chunk * 8 + 2 * h2;
            ld_row(row, ra, la); ld_row(row + 1, rb, lb); pin8x8(ra, rb);
            do_row(row, ra, la); do_row(row + 1, rb, lb);
        }
    }
    for (int r = blockIdx.x * 8 + wid; r < MS; r += nw) { u32x4 ra[8]; float la[3]; ld_row(MP + r, ra, la); do_row(MP + r, ra, la); }
}

DI void phase_final(const Params& p) {
    const int lane = TID() & 63, wid = TID() >> 6;
    const float* fg = p.in[I_FNG];
    const int nw = gridDim.x * 8;
    auto ld_row = [&](int row, f32x4 (&v)[4]) {
        const float* x = p.out + (size_t)row * 1024;
#pragma unroll
        for (int i = 0; i < 4; ++i) v[i] = *(const f32x4*)(x + lane * 4 + 256 * i);
    };
    f32x4 gg[4];
#pragma unroll
    for (int i = 0; i < 4; ++i) gg[i] = *(const f32x4*)(fg + lane * 4 + 256 * i);
    auto do_row = [&](int row, const f32x4 (&v)[4]) {
        float* x = p.out + (size_t)row * 1024;
        float ss = 0.f;
#pragma unroll
        for (int i = 0; i < 4; ++i) ss += v[i][0] * v[i][0] + v[i][1] * v[i][1] + v[i][2] * v[i][2] + v[i][3] * v[i][3];
        ss = wave_sum(ss);
        const float rstd = rsqrtf(ss * (1.f / 1024.f) + EPS);
#pragma unroll
        for (int i = 0; i < 4; ++i) *(f32x4*)(x + lane * 4 + 256 * i) = v[i] * rstd * gg[i];
    };
    const int chunk0 = gridDim.x == 256 ? ((int)(blockIdx.x & 7) * 256 + (int)(blockIdx.x >> 3) * 8 + wid) : (int)blockIdx.x * 8 + wid;
    for (int chunk = chunk0; chunk < MP / 8; chunk += nw) {
#pragma unroll 1
        for (int h4 = 0; h4 < 2; ++h4) {
            f32x4 va[4], vb[4], vc[4], vd[4];
            const int row = chunk * 8 + 4 * h4;
            ld_row(row, va); ld_row(row + 1, vb); ld_row(row + 2, vc); ld_row(row + 3, vd); pin4x4x4x4(va, vb, vc, vd);
            do_row(row, va); do_row(row + 1, vb); do_row(row + 2, vc); do_row(row + 3, vd);
        }
    }
    for (int r = blockIdx.x * 8 + wid; r < MS; r += nw) { f32x4 va[4]; ld_row(MP + r, va); do_row(MP + r, va); }
}

#define XB_TMO      128
#define XB_XCNT(j)  (256  + 64 * (j))
#define XB_XSUB(j)  (1280 + 64 * (j))
#define XB_XGEN(j)  (2304 + 64 * (j))
#define XB_TOP      3328
#define XB_TOPGEN   3392
#define XCD_BAR_WORDS 3456
#define XB_SPIN_CAP (1u << 20)
DI unsigned xb_ld(unsigned* p)              { return __hip_atomic_load(p, __ATOMIC_RELAXED, __HIP_MEMORY_SCOPE_AGENT); }
DI unsigned xb_add(unsigned* p, unsigned v) { return __hip_atomic_fetch_add(p, v, __ATOMIC_RELAXED, __HIP_MEMORY_SCOPE_AGENT); }
DI unsigned xb_xcc_id() { return (unsigned)__builtin_amdgcn_s_getreg((3 << 11) | 20) & 0xFu; }
#define XB_SPIN(cond, bar) do { unsigned _sp = 0; while (cond) { __builtin_amdgcn_s_sleep(1); \
    if ((++_sp & 255u) == 0u) { if (xb_ld(&(bar)[XB_TMO])) break; if (_sp > XB_SPIN_CAP) { atomicAdd(&(bar)[XB_TMO], 1u); break; } } } } while (0)
struct XcdBarrier { unsigned* bar; unsigned x; volatile LAS unsigned* st; };
DI XcdBarrier xcd_barrier_post(unsigned* bar, volatile LAS unsigned* st) {
    XcdBarrier b; b.bar = bar; b.x = xb_xcc_id(); b.st = st;
    if (threadIdx.x == 0) (void)xb_add(&bar[XB_XCNT(b.x)], 1u);
    return b;
}
DI void xcd_barrier_complete(unsigned* bar, unsigned x, unsigned& nloc, unsigned& nx) {
    const unsigned G = gridDim.x * gridDim.y * gridDim.z;
    unsigned sum, cnt, mine, sp = 0u;
    for (;;) {
        sum = 0u; cnt = 0u; mine = 0u;
#pragma unroll
        for (unsigned j = 0; j < 16; ++j) { const unsigned c = xb_ld(&bar[XB_XCNT(j)]); sum += c; cnt += (c > 0u) ? 1u : 0u; mine = (j == x) ? c : mine; }
        if (sum == G) break;
        __builtin_amdgcn_s_sleep(1);
        if ((++sp & 255u) == 0u) { if (xb_ld(&bar[XB_TMO])) break; if (sp > XB_SPIN_CAP) { atomicAdd(&bar[XB_TMO], 1u); break; } }
    }
    nloc = mine > 0u ? mine : 1u; nx = cnt > 0u ? cnt : 1u;
}
DI void xcd_barrier(const XcdBarrier& b) {
    asm volatile("s_waitcnt vmcnt(0)" ::: "memory");
    __syncthreads();
    if (threadIdx.x == 0) {
        unsigned* bar = b.bar;
        __builtin_amdgcn_s_waitcnt(0);
        unsigned nloc = b.st[0], nx = b.st[1];
        if (nloc == 0u) { xcd_barrier_complete(bar, b.x, nloc, nx); b.st[0] = nloc; b.st[1] = nx; }
        const unsigned old = xb_add(&bar[XB_XSUB(b.x)], 1u);
        const unsigned gen = old / nloc;
        if (old + 1u == (gen + 1u) * nloc) {
            __builtin_amdgcn_fence(__ATOMIC_RELEASE, "agent");
            asm volatile("s_waitcnt vmcnt(0)" ::: "memory");
            const unsigned og = xb_add(&bar[XB_TOP], 1u);
            const unsigned tg = og / nx;
            if (og + 1u == (tg + 1u) * nx) xb_add(&bar[XB_TOPGEN], 1u);
            else XB_SPIN(xb_ld(&bar[XB_TOPGEN]) == tg, bar);
            __builtin_amdgcn_fence(__ATOMIC_ACQUIRE, "agent");
            xb_add(&bar[XB_XGEN(b.x)], 1u);
            asm volatile("s_waitcnt vmcnt(0)" ::: "memory");
        } else {
            XB_SPIN(xb_ld(&bar[XB_XGEN(b.x)]) == gen, bar);
            __builtin_amdgcn_fence(__ATOMIC_ACQUIRE, "agent");
            asm volatile("s_waitcnt vmcnt(0)" ::: "memory");
        }
    }
    __syncthreads();
}

#ifndef EXTRA_SYNCS
#define EXTRA_SYNCS 0
#endif

#ifndef DUP_MASK
#define DUP_MASK 0u
#endif
__global__ void __launch_bounds__(512, 2) hybrid_fwd(Params p) {
    extern __shared__ __attribute__((aligned(16))) unsigned char shm[];
    LAS unsigned char* lds = (LAS unsigned char*)shm;
    cg::grid_group grid = cg::this_grid();
    const float* MOD = (const float*)(p.ws + WS_MOD);
    bf16_t* ACT = (bf16_t*)(p.ws + WS_ACT);
    bf16_t* X1 = (bf16_t*)(p.ws + WS_X1);
    if (p.ws == nullptr) grid.sync();
    volatile LAS unsigned* xst = (volatile LAS unsigned*)(lds + LDS_BYTES - 16);
    if (threadIdx.x == 0) { xst[0] = 0u; xst[1] = 0u; }
    __syncthreads();
    const XcdBarrier xb = xcd_barrier_post((unsigned*)(p.ws + WS_BAR), xst);

    for (int rep = 0; rep < EXTRA_SYNCS; ++rep) xcd_barrier(xb);
    for (int rep = 0; rep < 1 + (int)((DUP_MASK >> 0) & 1u); ++rep) {
    phase_prep(p, lds);
    xcd_barrier(xb);
    }
    for (int rep = 0; rep < 1 + (int)((DUP_MASK >> 1) & 1u); ++rep) {
    phase_norm<true>(p, lds, p.in[I_XP], p.in[I_XS], 0);
    xcd_barrier(xb);
    }
    for (int rep = 0; rep < 1 + (int)((DUP_MASK >> 2) & 1u); ++rep) {
    { EpiA e{(bf16_t*)(p.ws + WS_P0), p.out}; gemm_all(lds, ACT, (const bf16_t*)(p.ws + WS_WTA), 4096, e); }
    xcd_barrier(xb);
    }
    for (int rep = 0; rep < 1 + (int)((DUP_MASK >> 3) & 1u); ++rep) {
    phase_dprep(p, lds);
    xcd_barrier(xb);
    }
    for (int rep = 0; rep < 1 + (int)((DUP_MASK >> 4) & 1u); ++rep) {
    phase_scan(p, lds);
    xcd_barrier(xb);
    }
    for (int rep = 0; rep < 1 + (int)((DUP_MASK >> 5) & 1u); ++rep) {
    phase_gate0(p);
    xcd_barrier(xb);
    }
    for (int rep = 0; rep < 1 + (int)((DUP_MASK >> 6) & 1u); ++rep) {
    { EpiRes<float, bf16_t> e{p.in[I_XP], p.in[I_XS], MOD, X1}; gemm_all(lds, ACT, (const bf16_t*)(p.ws + WS_WTAO), 1024, e); }
    xcd_barrier(xb);
    }
    for (int rep = 0; rep < 1 + (int)((DUP_MASK >> 7) & 1u); ++rep) {
    phase_norm1(p);
    xcd_barrier(xb);
    }
    for (int rep = 0; rep < 1 + (int)((DUP_MASK >> 8) & 1u); ++rep) {
    { EpiB e{(bf16_t*)(p.ws + WS_P1), p.out}; gemm_all(lds, ACT, (const bf16_t*)(p.ws + WS_WTB), 10240, e); }
    xcd_barrier(xb);
    }
    for (int rep = 0; rep < 1 + (int)((DUP_MASK >> 9) & 1u); ++rep) {
    phase_attn(p, lds);
    xcd_barrier(xb);
    }
    for (int rep = 0; rep < 1 + (int)((DUP_MASK >> 10) & 1u); ++rep) {
    phase_gate1(p);
    xcd_barrier(xb);
    }
    for (int rep = 0; rep < 1 + (int)((DUP_MASK >> 11) & 1u); ++rep) {
    { EpiRes<bf16_t, float> e{X1, X1 + (size_t)MP * 1024, MOD + 40 * 3072, p.out}; gemm_all(lds, ACT, (const bf16_t*)(p.ws + WS_WTBO), 1024, e); }
    xcd_barrier(xb);
    }
    phase_final(p);
}

extern "C" void kernel_launch(void* const* d_in, const int* in_sizes, int n_in, void* d_out, int out_size, void* d_ws, size_t ws_size, hipStream_t stream) {
    static int grid_blocks = 0;
    if (!grid_blocks) {
        if (n_in != 21 || ws_size < WS_END) { fprintf(stderr, "kernel_launch: unexpected inputs (n_in %d, ws %zu < %zu)\n", n_in, ws_size, (size_t)WS_END); grid_blocks = -1; return; }
        int dev = 0, cus = 0, per_cu = 0;
        hipGetDevice(&dev);
        hipDeviceGetAttribute(&cus, hipDeviceAttributeMultiprocessorCount, dev);
        if (hipFuncSetAttribute((const void*)hybrid_fwd, hipFuncAttributeMaxDynamicSharedMemorySize, LDS_BYTES) != hipSuccess) { fprintf(stderr, "kernel_launch: hipFuncSetAttribute failed\n"); }
        hipOccupancyMaxActiveBlocksPerMultiprocessor(&per_cu, (const void*)hybrid_fwd, 512, LDS_BYTES);
        per_cu = 1;
        grid_blocks = cus * per_cu;
    }
    if (grid_blocks < 0) return;
    Params p{};
    for (int i = 0; i < 21; ++i) p.in[i] = (const float*)d_in[i];
    p.out = (float*)d_out; p.ws = (unsigned char*)d_ws;
    if (hipMemsetAsync((unsigned char*)d_ws + WS_BAR, 0, XCD_BAR_WORDS * 4, stream) != hipSuccess) { fprintf(stderr, "kernel_launch: memset of barrier words failed\n"); return; }
    void* args[] = {&p};
    hipError_t e = hipLaunchCooperativeKernel((const void*)hybrid_fwd, dim3(grid_blocks), dim3(512), args, LDS_BYTES, stream);
    if (e != hipSuccess) fprintf(stderr, "cooperative launch failed: %s (grid %d)\n", hipGetErrorString(e), grid_blocks);
}
```

```cpp
#include <hip/hip_runtime.h>
#include <hip/hip_cooperative_groups.h>
#include <cstdio>
namespace cg = cooperative_groups;

#define LAS __attribute__((address_space(3)))
#define DI __device__ __forceinline__
typedef unsigned short bf16_t;
typedef short bf16x8 __attribute__((ext_vector_type(8)));
typedef short s16x4 __attribute__((ext_vector_type(4)));
typedef float f32x4 __attribute__((ext_vector_type(4)));
typedef float f32x2 __attribute__((ext_vector_type(2)));
typedef unsigned u32x4 __attribute__((ext_vector_type(4)));
typedef unsigned u32x2 __attribute__((ext_vector_type(2)));
typedef __bf16 bf16x2_t __attribute__((ext_vector_type(2)));

constexpr int DM = 1024, MP = 16384, MS = 256, MT = MP + MS;
constexpr int NCH = 2048 + 256;
constexpr float EPS = 1e-6f;
constexpr float QSCALE = 0.08838834764831845f * 1.4426950408889634f;
constexpr int LDS_BYTES = 151552;

constexpr size_t WS_WTA  = 0;
constexpr size_t WS_WTAO = WS_WTA  + (size_t)4096 * 1024 * 2;
constexpr size_t WS_WTB  = WS_WTAO + (size_t)1024 * 1024 * 2;
constexpr size_t WS_WTBO = WS_WTB  + (size_t)10240 * 1024 * 2;
constexpr size_t WS_MOD  = WS_WTBO + (size_t)1024 * 1024 * 2;
constexpr size_t WS_ACT  = WS_MOD  + (size_t)2 * 40 * 3072 * 4;
constexpr size_t WS_P0   = WS_ACT  + (size_t)MT * 1024 * 2;
constexpr size_t WS_GB   = WS_P0   + (size_t)MT * 4096 * 2;
constexpr size_t WS_WV   = WS_GB   + (size_t)MT * 16 * 4;
constexpr size_t WS_KC   = WS_WV   + (size_t)NCH * 8192 * 2;
constexpr size_t WS_QD   = WS_KC   + (size_t)NCH * 8192 * 2;
constexpr size_t WS_KDT  = WS_QD   + (size_t)NCH * 8192 * 2;
constexpr size_t WS_QK   = WS_KDT  + (size_t)NCH * 8192 * 2;
constexpr size_t WS_GT   = WS_QK   + (size_t)NCH * 4096 * 2;
constexpr size_t WS_O0   = WS_GT   + (size_t)NCH * 4;
constexpr size_t WS_X1   = WS_O0   + (size_t)MT * 1024 * 2;
constexpr size_t WS_P1   = WS_X1   + (size_t)MT * 1024 * 4;
constexpr size_t WS_OG   = WS_P0;
constexpr size_t WS_LSE  = WS_P1   + (size_t)MT * 10240 * 2;
constexpr size_t WS_BAR  = WS_LSE  + (size_t)3 * MT * 8 * 4;
constexpr size_t WS_END  = WS_BAR  + 16384;

constexpr size_t O_YP   = 0;
constexpr size_t O_YS   = O_YP + (size_t)MP * 1024;
constexpr size_t O_DP   = O_YS + (size_t)MS * 1024;
constexpr size_t O_DS   = O_DP + (size_t)8 * 8 * 128 * 128;
constexpr size_t O_CP   = O_DS + (size_t)32 * 8 * 128 * 128;
constexpr size_t O_CS   = O_CP + (size_t)8 * 3 * 3072;
constexpr size_t O_KVP0 = O_CS + (size_t)32 * 3 * 3072;
constexpr size_t O_KVS0 = O_KVP0 + (size_t)8 * 128 * 2048;
constexpr size_t O_KVP1 = O_KVS0 + (size_t)32 * 8 * 2048;
constexpr size_t O_KVS1 = O_KVP1 + (size_t)8 * 512 * 2048;
constexpr size_t O_KVP2 = O_KVS1 + (size_t)32 * 8 * 2048;
constexpr size_t O_KVS2 = O_KVP2 + (size_t)8 * 2048 * 2048;

struct Params { const float* in[21]; float* out; unsigned char* ws; };
enum { I_XP = 0, I_XS, I_SD, I_SC, I_C128, I_C512, I_C2048, I_CP, I_CS, I_NG, I_ADAW, I_ADAB, I_AWIN, I_ACONV, I_ALOG, I_ADT, I_AOG, I_AWOUT, I_BWIN, I_BWOUT, I_FNG };

DI int TID() { int t = (int)threadIdx.x; asm volatile("" : "+v"(t)); return t; }
DI unsigned pk2(float a, float b) { f32x2 v = {a, b}; bf16x2_t r = __builtin_convertvector(v, bf16x2_t); return __builtin_bit_cast(unsigned, r); }
DI float bflo(unsigned u) { return __uint_as_float(u << 16); }
DI float bfhi(unsigned u) { return __uint_as_float(u & 0xffff0000u); }

DI float wave_max(float v) { for (int o = 32; o > 0; o >>= 1) v = fmaxf(v, __shfl_xor(v, o)); return v; }
template <int CTRL> DI float dpp_f(float v) { return __builtin_bit_cast(float, __builtin_amdgcn_update_dpp(0, __builtin_bit_cast(int, v), CTRL, 0xf, 0xf, true)); }
DI float row16_sum(float v) { v += dpp_f<0xB1>(v); v += dpp_f<0x4E>(v); v += dpp_f<0x141>(v); v += dpp_f<0x140>(v); return v; }
DI float wave_sum(float v) {
    v = row16_sum(v);
    const int iv = __builtin_bit_cast(int, v);
    const float r0 = __builtin_bit_cast(float, __builtin_amdgcn_readlane(iv, 0)), r1 = __builtin_bit_cast(float, __builtin_amdgcn_readlane(iv, 16));
    const float r2 = __builtin_bit_cast(float, __builtin_amdgcn_readlane(iv, 32)), r3 = __builtin_bit_cast(float, __builtin_amdgcn_readlane(iv, 48));
    return (r0 + r1) + (r2 + r3);
}
DI float siluf(float x) { return x * __builtin_amdgcn_rcpf(1.f + __expf(-x)); }
DI int batch_of(int row) { return row < MP ? (row >> 11) : 8 + ((row - MP) >> 3); }
DI f32x4 mfma16(bf16x8 a, bf16x8 b, f32x4 c) { return __builtin_amdgcn_mfma_f32_16x16x32_bf16(a, b, c, 0, 0, 0); }
DI void lds_sync() { asm volatile("s_waitcnt lgkmcnt(0)" ::: "memory"); __builtin_amdgcn_s_barrier(); asm volatile("" ::: "memory"); }
DI bf16x8 lds_ld8(const LAS unsigned char* p) { return *(const LAS bf16x8*)p; }


DI void pin16x2(float (&a)[16], float (&b)[16]) {
    f32x4 p0 = {a[0], a[1], a[2], a[3]}, p1 = {a[4], a[5], a[6], a[7]}, p2 = {a[8], a[9], a[10], a[11]}, p3 = {a[12], a[13], a[14], a[15]};
    f32x4 q0 = {b[0], b[1], b[2], b[3]}, q1 = {b[4], b[5], b[6], b[7]}, q2 = {b[8], b[9], b[10], b[11]}, q3 = {b[12], b[13], b[14], b[15]};
    asm volatile("" : "+v"(p0), "+v"(p1), "+v"(p2), "+v"(p3), "+v"(q0), "+v"(q1), "+v"(q2), "+v"(q3));
#pragma unroll
    for (int j = 0; j < 4; ++j) { a[j] = p0[j]; a[4 + j] = p1[j]; a[8 + j] = p2[j]; a[12 + j] = p3[j]; b[j] = q0[j]; b[4 + j] = q1[j]; b[8 + j] = q2[j]; b[12 + j] = q3[j]; }
}
DI void pin16x4(float (&a)[16], float (&b)[16], float (&c)[16], float (&d)[16]) {
    f32x4 p[16];
#pragma unroll
    for (int j = 0; j < 4; ++j) { p[j] = (f32x4){a[4 * j], a[4 * j + 1], a[4 * j + 2], a[4 * j + 3]}; p[4 + j] = (f32x4){b[4 * j], b[4 * j + 1], b[4 * j + 2], b[4 * j + 3]};
                                  p[8 + j] = (f32x4){c[4 * j], c[4 * j + 1], c[4 * j + 2], c[4 * j + 3]}; p[12 + j] = (f32x4){d[4 * j], d[4 * j + 1], d[4 * j + 2], d[4 * j + 3]}; }
    asm volatile("" : "+v"(p[0]), "+v"(p[1]), "+v"(p[2]), "+v"(p[3]), "+v"(p[4]), "+v"(p[5]), "+v"(p[6]), "+v"(p[7]), "+v"(p[8]), "+v"(p[9]), "+v"(p[10]), "+v"(p[11]), "+v"(p[12]), "+v"(p[13]), "+v"(p[14]), "+v"(p[15]));
#pragma unroll
    for (int j = 0; j < 4; ++j)
#pragma unroll
        for (int e = 0; e < 4; ++e) { a[4 * j + e] = p[j][e]; b[4 * j + e] = p[4 + j][e]; c[4 * j + e] = p[8 + j][e]; d[4 * j + e] = p[12 + j][e]; }
}
template <class T> DI void pin4x4x4x4(T (&a)[4], T (&b)[4], T (&c)[4], T (&d)[4]) {
    asm volatile("" : "+v"(a[0]), "+v"(a[1]), "+v"(a[2]), "+v"(a[3]), "+v"(b[0]), "+v"(b[1]), "+v"(b[2]), "+v"(b[3]), "+v"(c[0]), "+v"(c[1]), "+v"(c[2]), "+v"(c[3]), "+v"(d[0]), "+v"(d[1]), "+v"(d[2]), "+v"(d[3]));
}
template <class T> DI void pin4(T (&a)[4]) { asm volatile("" : "+v"(a[0]), "+v"(a[1]), "+v"(a[2]), "+v"(a[3])); }
template <class T> DI void pin8(T (&a)[8]) { asm volatile("" : "+v"(a[0]), "+v"(a[1]), "+v"(a[2]), "+v"(a[3]), "+v"(a[4]), "+v"(a[5]), "+v"(a[6]), "+v"(a[7])); }
template <class T, class U> DI void pin4x4(T (&a)[4], U (&b)[4]) { asm volatile("" : "+v"(a[0]), "+v"(a[1]), "+v"(a[2]), "+v"(a[3]), "+v"(b[0]), "+v"(b[1]), "+v"(b[2]), "+v"(b[3])); }
template <class T, class U> DI void pin8x8(T (&a)[8], U (&b)[8]) { asm volatile("" : "+v"(a[0]), "+v"(a[1]), "+v"(a[2]), "+v"(a[3]), "+v"(a[4]), "+v"(a[5]), "+v"(a[6]), "+v"(a[7]),
                                                                                      "+v"(b[0]), "+v"(b[1]), "+v"(b[2]), "+v"(b[3]), "+v"(b[4]), "+v"(b[5]), "+v"(b[6]), "+v"(b[7])); }

namespace pg8 {
constexpr int BM = 256, BK = 64, HALF = 128, HTB = HALF * BK * 2, STAGE_BYTES = 8 * HTB, NXCD = 8, WGM = 8;
DI int lds_byte(int r, int c) { const int st = (r >> 4) * 2 + (c >> 5), rr = r & 15, cc = c & 31, ob = rr * 64 + cc * 2; return st * 1024 + (ob ^ (((ob >> 9) & 1) << 5)); }
DI void stage_rc(int b, int& R, int& C) { const int st = b / 1024, sb = b % 1024, swz = sb ^ (((sb >> 9) & 1) << 5); R = (st >> 1) * 16 + swz / 64; C = (st & 1) * 32 + (swz % 64) / 2; }
DI int perm32(int rho) { const int n = rho >> 4, i = rho & 15; return 8 * (i >> 2) + 4 * n + (i & 3); }
struct Unit { int pm, pn; };
struct Gemm { const bf16_t* A; const bf16_t* Bt; int M, N, K; };
struct StaticOrder {
    int nM, nN, nwg, G, c;
    DI void init(int M, int N, int G_, int c_) { nM = M / BM; nN = N / BM; nwg = nM * nN; G = G_; c = c_; }
    DI bool next(int i, Unit& u) const {
        const long L = (long)i * G + c; if (L >= nwg) return false;
        int wgid = (int)L; { const int q = nwg / NXCD, r = nwg % NXCD, xcd = wgid % NXCD, off = wgid / NXCD; wgid = (xcd < r ? xcd * (q + 1) : r * (q + 1) + (xcd - r) * q) + off; }
        const int nig = WGM * nN, gid = wgid / nig, fm = gid * WGM, gsz = (nM - fm) < WGM ? (nM - fm) : WGM;
        u.pm = fm + ((wgid % nig) % gsz); u.pn = (wgid % nig) / gsz; return true;
    }
};

template <class Epi>
DI void gemm_phase(LAS unsigned char* lds, const Gemm g, const StaticOrder& S, const Epi& E) {
    const int tid = TID(), wid = __builtin_amdgcn_readfirstlane(tid >> 6), lane = tid & 63, wr = wid >> 2, wc = wid & 3, fr = lane & 15, fq = lane >> 4;
    const int K = g.K, nt = K / BK;
    unsigned voffA[2], voffB[2];
#pragma unroll
    for (int i = 0; i < 2; ++i) { int R, C; stage_rc(tid * 16 + i * 8192, R, C); const int Rb = (R & ~31) + perm32(R & 31);
        voffA[i] = (unsigned)(R * K + C) * 2u; voffB[i] = (unsigned)(Rb * K + C) * 2u; }
    const size_t kstep = (size_t)(BK * 2);
    const size_t hstep = (size_t)HALF * K * 2;
    const size_t tstep = 2 * hstep;
    const unsigned ldsw = (unsigned)wid * 1024u;
    const int aoff = lds_byte(wr * 64 + fr, fq * 8), boff = lds_byte(wc * 32 + fr, fq * 8);
#define PG8_SA(b, h) (((b) * 2 + (h)) * HTB)
#define PG8_SB(b, h) ((4 + (b) * 2 + (h)) * HTB)
#define PG8_STAGE(bufoff, gbase, voff) do { _Pragma("unroll") for (int _i = 0; _i < 2; ++_i) \
        __builtin_amdgcn_global_load_lds((const unsigned*)((const char*)(gbase) + (voff)[_i]), (LAS unsigned*)(lds + (bufoff) + ldsw + _i * 8192), 16, 0, 0); } while (0)
#define PG8_LDA(dst, b, h) do { _Pragma("unroll") for (int m = 0; m < 4; ++m) _Pragma("unroll") for (int k = 0; k < 2; ++k) dst[m][k] = *(const LAS bf16x8*)(lds + PG8_SA(b, h) + aoff + m * 2048 + k * 1024); } while (0)
#define PG8_LDB(dst, b, h) do { _Pragma("unroll") for (int n = 0; n < 2; ++n) _Pragma("unroll") for (int k = 0; k < 2; ++k) dst[n][k] = *(const LAS bf16x8*)(lds + PG8_SB(b, h) + boff + n * 2048 + k * 1024); } while (0)
#define PG8_MMA(ai, bj, At, Bt) do { __builtin_amdgcn_s_setprio(1); _Pragma("unroll") for (int m = 0; m < 4; ++m) _Pragma("unroll") for (int n = 0; n < 2; ++n) _Pragma("unroll") for (int k = 0; k < 2; ++k) \
        acc[ai][bj][m][n] = __builtin_amdgcn_mfma_f32_16x16x32_bf16(Bt[n][k], At[m][k], acc[ai][bj][m][n], 0, 0, 0); __builtin_amdgcn_s_setprio(0); } while (0)
#define PG8_WAIT_V(n) asm volatile("s_waitcnt vmcnt(" #n ")" ::: "memory")
#define PG8_WAIT_L(n) asm volatile("s_waitcnt lgkmcnt(" #n ")" ::: "memory")
#define PG8_BAR __builtin_amdgcn_s_barrier()
#define PG8_SCHED __builtin_amdgcn_sched_barrier(0)
    Unit cur, nxt; int ui = 0;
    if (!S.next(0, cur)) return;
    f32x4 acc[2][2][4][2];
#pragma unroll
    for (int a = 0; a < 2; ++a)
#pragma unroll
        for (int b = 0; b < 2; ++b)
#pragma unroll
            for (int m = 0; m < 4; ++m)
#pragma unroll
                for (int n = 0; n < 2; ++n) acc[a][b][m][n] = (f32x4){0.f, 0.f, 0.f, 0.f};
    bf16x8 At[4][2], B0[2][2], B1[2][2];
    const char* cA = (const char*)g.A + (size_t)cur.pm * tstep; const char* cB = (const char*)g.Bt + (size_t)cur.pn * tstep;
    PG8_STAGE(PG8_SB(0, 0), cB, voffB); PG8_STAGE(PG8_SA(0, 0), cA, voffA); PG8_STAGE(PG8_SB(0, 1), cB + hstep, voffB); PG8_STAGE(PG8_SA(0, 1), cA + hstep, voffA);
    if (wr == 1) PG8_BAR;
    PG8_WAIT_V(4); PG8_BAR;
    PG8_STAGE(PG8_SB(1, 0), cB + kstep, voffB); PG8_STAGE(PG8_SA(1, 0), cA + kstep, voffA); PG8_STAGE(PG8_SB(1, 1), cB + hstep + kstep, voffB);
    PG8_WAIT_V(6); PG8_BAR;
    for (;;) {
        const bool has_next = S.next(ui + 1, nxt);
        const char* nA = has_next ? (const char*)g.A + (size_t)nxt.pm * tstep : cA; const char* nB = has_next ? (const char*)g.Bt + (size_t)nxt.pn * tstep : cB;
        for (int t = 0; t < nt; t += 2) {
            const bool last = (t == nt - 2);
            const char* a1 = cA + (size_t)(t + 1) * kstep;
            const char* a2 = last ? nA : cA + (size_t)(t + 2) * kstep; const char* b2 = last ? nB : cB + (size_t)(t + 2) * kstep;
            const char* a3 = a2 + kstep; const char* b3 = b2 + kstep;
            PG8_LDB(B0, 0, 0); PG8_SCHED; PG8_LDA(At, 0, 0); PG8_STAGE(PG8_SA(1, 1), a1 + hstep, voffA);
            PG8_WAIT_L(8); PG8_BAR; PG8_WAIT_L(0); PG8_MMA(0, 0, At, B0); PG8_BAR; PG8_SCHED;
            PG8_LDB(B1, 0, 1); PG8_STAGE(PG8_SB(0, 0), b2, voffB);
            PG8_BAR; PG8_WAIT_L(0); PG8_MMA(0, 1, At, B1); PG8_BAR;
            PG8_LDA(At, 0, 1); PG8_STAGE(PG8_SA(0, 0), a2, voffA);
            PG8_BAR; PG8_WAIT_L(0); PG8_MMA(1, 0, At, B0); PG8_BAR; PG8_SCHED;
            PG8_STAGE(PG8_SB(0, 1), b2 + hstep, voffB);
            PG8_WAIT_V(6); PG8_BAR; PG8_MMA(1, 1, At, B1); PG8_BAR;
            PG8_LDB(B0, 1, 0); PG8_SCHED; PG8_LDA(At, 1, 0); PG8_STAGE(PG8_SA(0, 1), a2 + hstep, voffA);
            PG8_WAIT_L(8); PG8_BAR; PG8_WAIT_L(0); PG8_MMA(0, 0, At, B0); PG8_BAR; PG8_SCHED;
            PG8_LDB(B1, 1, 1); PG8_STAGE(PG8_SB(1, 0), b3, voffB);
            PG8_BAR; PG8_WAIT_L(0); PG8_MMA(0, 1, At, B1); PG8_BAR;
            PG8_LDA(At, 1, 1); PG8_STAGE(PG8_SA(1, 0), a3, voffA);
            PG8_BAR; PG8_WAIT_L(0); PG8_MMA(1, 0, At, B0); PG8_BAR; PG8_SCHED;
            PG8_STAGE(PG8_SB(1, 1), b3 + hstep, voffB);
            PG8_WAIT_V(6); PG8_BAR; PG8_MMA(1, 1, At, B1); PG8_BAR;
        }
        E(acc, cur, wr, wc, fr, fq);
        if (!has_next) break;
#pragma unroll
        for (int a = 0; a < 2; ++a)
#pragma unroll
            for (int b = 0; b < 2; ++b)
#pragma unroll
                for (int m = 0; m < 4; ++m)
#pragma unroll
                    for (int n = 0; n < 2; ++n) acc[a][b][m][n] = (f32x4){0.f, 0.f, 0.f, 0.f};
        cur = nxt; cA = nA; cB = nB; ++ui;
    }
    PG8_WAIT_V(0);
    if (wr == 0) PG8_BAR;
    PG8_BAR;
#undef PG8_SA
#undef PG8_SB
#undef PG8_STAGE
#undef PG8_LDA
#undef PG8_LDB
#undef PG8_MMA
#undef PG8_WAIT_V
#undef PG8_WAIT_L
#undef PG8_BAR
#undef PG8_SCHED
}
}

template <class F> struct Epi8 {
    F f;
    DI void operator()(const f32x4 (&acc)[2][2][4][2], const pg8::Unit& u, int wr, int wc, int fr, int fq) const {
        const int row0 = u.pm * 256 + wr * 64 + fr, col0 = u.pn * 256 + wc * 32 + 8 * fq;
        if constexpr (F::HAS_TILE) { f.tile(acc, row0, col0); return; }
#pragma unroll
        for (int ai = 0; ai < 2; ++ai)
#pragma unroll
            for (int m = 0; m < 4; ++m)
#pragma unroll
                for (int bj = 0; bj < 2; ++bj) f.store8(row0 + ai * 128 + m * 16, col0 + bj * 128, acc[ai][bj][m][0], acc[ai][bj][m][1]);
    }
};

template <class F> DI void small_gemm(const bf16_t* A, const bf16_t* Wt, int N, int rowbase, const F& f) {
    const int lane = TID() & 63, wid = TID() >> 6, r16 = lane & 15, fq = lane >> 4;
    const int ntile = 16 * (N / 32), nw = gridDim.x * 8;
    for (int t = blockIdx.x * 8 + wid; t < ntile; t += nw) {
        const int rt = t & 15, ct = t >> 4;
        const bf16_t* ap = A + (size_t)(rt * 16 + r16) * 1024 + fq * 8;
        const bf16_t* b0 = Wt + (size_t)(ct * 32 + pg8::perm32(r16)) * 1024 + fq * 8;
        const bf16_t* b1 = Wt + (size_t)(ct * 32 + pg8::perm32(16 + r16)) * 1024 + fq * 8;
        f32x4 acc0 = {0.f, 0.f, 0.f, 0.f}, acc1 = {0.f, 0.f, 0.f, 0.f};
#pragma unroll 1
        for (int kb = 0; kb < 4; ++kb) {
            bf16x8 a[8], x0[8], x1[8];
#pragma unroll
            for (int u = 0; u < 8; ++u) { const int ko = (kb * 8 + u) * 32; a[u] = *(const bf16x8*)(ap + ko); x0[u] = *(const bf16x8*)(b0 + ko); x1[u] = *(const bf16x8*)(b1 + ko); }
            asm volatile("" : "+v"(a[0]), "+v"(x0[0]), "+v"(x1[0]), "+v"(a[1]), "+v"(x0[1]), "+v"(x1[1]), "+v"(a[2]), "+v"(x0[2]), "+v"(x1[2]), "+v"(a[3]), "+v"(x0[3]), "+v"(x1[3]), "+v"(a[4]), "+v"(x0[4]), "+v"(x1[4]), "+v"(a[5]), "+v"(x0[5]), "+v"(x1[5]), "+v"(a[6]), "+v"(x0[6]), "+v"(x1[6]), "+v"(a[7]), "+v"(x0[7]), "+v"(x1[7]));
#pragma unroll
            for (int u = 0; u < 8; ++u) { acc0 = mfma16(x0[u], a[u], acc0); acc1 = mfma16(x1[u], a[u], acc1); }
        }
        f.store8(rowbase + rt * 16 + r16, ct * 32 + 8 * fq, acc0, acc1);
    }
}

template <class F> DI void gemm_all(LAS unsigned char* lds, const bf16_t* A, const bf16_t* Wt, int N, const F& f) {
    pg8::Gemm g{A, Wt, MP, N, 1024}; pg8::StaticOrder S; S.init(MP, N, (int)gridDim.x, (int)blockIdx.x); Epi8<F> E{f};
    pg8::gemm_phase(lds, g, S, E);
    small_gemm(A + (size_t)MP * 1024, Wt, N, MP, f);
}

DI void st_bf16x8(bf16_t* p, f32x4 v0, f32x4 v1) { u32x4 w; w.x = pk2(v0[0], v0[1]); w.y = pk2(v0[2], v0[3]); w.z = pk2(v1[0], v1[1]); w.w = pk2(v1[2], v1[3]); *(u32x4*)p = w; }

struct EpiA {
    static constexpr bool HAS_TILE = true;
    bf16_t* P0; float* out;
    DI void tile(const f32x4 (&acc)[2][2][4][2], int row0, int col0) const {
        const int ucol = col0 & ~255, urow = row0 & ~255;
        const bool tail = ucol < 3072 && (urow & 2047) == 1792;
#pragma unroll
        for (int ai = 0; ai < 2; ++ai)
#pragma unroll
            for (int m = 0; m < 4; ++m) {
                const int row = row0 + ai * 128 + m * 16, s = row & 2047;
#pragma unroll
                for (int bj = 0; bj < 2; ++bj) {
                    const f32x4 v0 = acc[ai][bj][m][0], v1 = acc[ai][bj][m][1];
                    if (tail && s >= 2045) { float* o = out + O_CP + (size_t)((row >> 11) * 3 + (s - 2045)) * 3072 + col0 + bj * 128; *(f32x4*)o = v0; *(f32x4*)(o + 4) = v1; }
                    st_bf16x8(P0 + (size_t)row * 4096 + col0 + bj * 128, v0, v1);
                }
            }
    }
    DI void store8(int row, int col, f32x4 v0, f32x4 v1) const {
        st_bf16x8(P0 + (size_t)row * 4096 + col, v0, v1);
        if (col < 3072) {
            float* o = nullptr;
            if (row < MP) { const int s = row & 2047; if (s >= 2045) o = out + O_CP + (size_t)((row >> 11) * 3 + (s - 2045)) * 3072 + col; }
            else { const int r = row - MP, l = r & 7; if (l >= 5) o = out + O_CS + (size_t)((r >> 3) * 3 + (l - 5)) * 3072 + col; }
            if (o) { *(f32x4*)o = v0; *(f32x4*)(o + 4) = v1; }
        }
    }
};
DI void ld8_as_f32(const float* p, f32x4& a, f32x4& b) { a = *(const f32x4*)p; b = *(const f32x4*)(p + 4); }
DI void ld8_as_f32(const bf16_t* p, f32x4& a, f32x4& b) { const u32x4 w = *(const u32x4*)p; a = (f32x4){bflo(w.x), bfhi(w.x), bflo(w.y), bfhi(w.y)}; b = (f32x4){bflo(w.z), bfhi(w.z), bflo(w.w), bfhi(w.w)}; }
DI void st8_from_f32(float* p, f32x4 a, f32x4 b) { *(f32x4*)p = a; *(f32x4*)(p + 4) = b; }
DI void st8_from_f32(bf16_t* p, f32x4 a, f32x4 b) { st_bf16x8(p, a, b); }
template <class TI, class TO> struct EpiRes {
    static constexpr bool HAS_TILE = true;
    const TI* xp; const TI* xs; const float* mod; TO* dst;
    DI void tile(const f32x4 (&acc)[2][2][4][2], int row0, int col0) const {
        const float* gt = mod + (size_t)(row0 >> 11) * 3072 + 2048 + col0;
        f32x4 g[2][2];
#pragma unroll
        for (int bj = 0; bj < 2; ++bj) { g[bj][0] = *(const f32x4*)(gt + bj * 128); g[bj][1] = *(const f32x4*)(gt + bj * 128 + 4); }
#pragma unroll
        for (int ai = 0; ai < 2; ++ai) {
            f32x4 xv[16];
            if constexpr (sizeof(TI) == 2) {
                u32x4 xr[8];
#pragma unroll
                for (int m = 0; m < 4; ++m)
#pragma unroll
                    for (int bj = 0; bj < 2; ++bj) xr[m * 2 + bj] = *(const u32x4*)(xp + (size_t)(row0 + ai * 128 + m * 16) * 1024 + col0 + bj * 128);
                pin8(xr);
#pragma unroll
                for (int q = 0; q < 8; ++q) { const u32x4 w = xr[q]; xv[2 * q] = (f32x4){bflo(w.x), bfhi(w.x), bflo(w.y), bfhi(w.y)}; xv[2 * q + 1] = (f32x4){bflo(w.z), bfhi(w.z), bflo(w.w), bfhi(w.w)}; }
            } else {
#pragma unroll
                for (int m = 0; m < 4; ++m) { const TI* x = xp + (size_t)(row0 + ai * 128 + m * 16) * 1024 + col0;
#pragma unroll
                    for (int bj = 0; bj < 2; ++bj) ld8_as_f32(x + bj * 128, xv[m * 4 + bj * 2], xv[m * 4 + bj * 2 + 1]); }
                asm volatile("" : "+v"(xv[0]), "+v"(xv[1]), "+v"(xv[2]), "+v"(xv[3]), "+v"(xv[4]), "+v"(xv[5]), "+v"(xv[6]), "+v"(xv[7]), "+v"(xv[8]), "+v"(xv[9]), "+v"(xv[10]), "+v"(xv[11]), "+v"(xv[12]), "+v"(xv[13]), "+v"(xv[14]), "+v"(xv[15]));
            }
#pragma unroll
            for (int m = 0; m < 4; ++m) { TO* d = dst + (size_t)(row0 + ai * 128 + m * 16) * 1024 + col0;
#pragma unroll
                for (int bj = 0; bj < 2; ++bj) st8_from_f32(d + bj * 128, xv[m * 4 + bj * 2] + g[bj][0] * acc[ai][bj][m][0], xv[m * 4 + bj * 2 + 1] + g[bj][1] * acc[ai][bj][m][1]); }
        }
    }
    DI void store8(int row, int col, f32x4 v0, f32x4 v1) const {
        const TI* x = (row < MP ? xp + (size_t)row * 1024 : xs + (size_t)(row - MP) * 1024) + col;
        const float* gt = mod + (size_t)batch_of(row) * 3072 + 2048 + col;
        f32x4 x0, x1; ld8_as_f32(x, x0, x1);
        const f32x4 g0 = *(const f32x4*)gt, g1 = *(const f32x4*)(gt + 4);
        st8_from_f32(dst + (size_t)row * 1024 + col, x0 + g0 * v0, x1 + g1 * v1);
    }
};
struct EpiB {
    static constexpr bool HAS_TILE = true;
    bf16_t* P1; float* out;
    DI void tile(const f32x4 (&acc)[2][2][4][2], int row0, int col0) const {
        const int ucol = col0 & ~255, urow = row0 & ~255;
        const bool isq = ucol < 3072, iskv = ucol >= 3072 && ucol < 9216;
        const int cc = ucol - 3072, kv = cc >= 3072 ? 1 : 0, g = ((cc - kv * 3072) >> 10), W = g == 0 ? 128 : (g == 1 ? 512 : 2048);
        const int b = urow >> 11, s0 = urow & 2047;
        const bool any_out = iskv && (s0 + 256 > 2048 - W);
        const size_t obase = (g == 0 ? O_KVP0 : (g == 1 ? O_KVP1 : O_KVP2)) + ((size_t)b * W * 2 + kv) * 1024 + ((col0 - 3072 - kv * 3072) & 1023);
        const float sc = isq ? QSCALE : 1.f;
#pragma unroll
        for (int ai = 0; ai < 2; ++ai)
#pragma unroll
            for (int m = 0; m < 4; ++m) {
                const int row = row0 + ai * 128 + m * 16, s = row & 2047;
#pragma unroll
                for (int bj = 0; bj < 2; ++bj) {
                    const f32x4 v0 = acc[ai][bj][m][0], v1 = acc[ai][bj][m][1];
                    if (any_out && s >= 2048 - W) { float* o = out + obase + (size_t)(s - (2048 - W)) * 2048 + bj * 128; *(f32x4*)o = v0; *(f32x4*)(o + 4) = v1; }
                    st_bf16x8(P1 + (size_t)row * 10240 + col0 + bj * 128, v0 * sc, v1 * sc);
                }
            }
    }
    DI void store8(int row, int col, f32x4 v0, f32x4 v1) const {
        if (col >= 3072 && col < 9216) {
            const int cc = col - 3072, kv = cc / 3072, g = (cc - kv * 3072) >> 10, he = cc & 1023;
            float* o = nullptr;
            if (row < MP) {
                const int b = row >> 11, s = row & 2047, W = g == 0 ? 128 : (g == 1 ? 512 : 2048);
                const size_t base = g == 0 ? O_KVP0 : (g == 1 ? O_KVP1 : O_KVP2);
                if (s >= 2048 - W) o = out + base + ((size_t)(b * W + (s - (2048 - W))) * 2 + kv) * 1024 + he;
            } else {
                const size_t base = g == 0 ? O_KVS0 : (g == 1 ? O_KVS1 : O_KVS2);
                o = out + base + ((size_t)(row - MP) * 2 + kv) * 1024 + he;
            }
            if (o) { *(f32x4*)o = v0; *(f32x4*)(o + 4) = v1; }
        }
        if (col < 3072) { v0 *= QSCALE; v1 *= QSCALE; }
        st_bf16x8(P1 + (size_t)row * 10240 + col, v0, v1);
    }
};

DI void ada_item(const Params& p, LAS unsigned char* lds, int it) {
    const int tid = TID(), l = it / 96, col0 = (it % 96) * 32, col = tid & 31, ks = tid >> 5;
    LAS float* cs = (LAS float*)lds;
    const float* aw = p.in[I_ADAW] + (size_t)l * 1024 * 3072;
    float acc[40];
#pragma unroll
    for (int b = 0; b < 40; ++b) acc[b] = 0.f;
    for (int half = 0; half < 2; ++half) {
        __syncthreads();
        for (int idx = tid; idx < 40 * 512; idx += 512) {
            const int b = idx % 40, kk = idx / 40;
            const float c = b < 8 ? p.in[I_CP][b * 1024 + half * 512 + kk] : p.in[I_CS][(b - 8) * 1024 + half * 512 + kk];
            cs[kk * 40 + b] = siluf(c);
        }
        __syncthreads();
        float wv[32];
#pragma unroll
        for (int kk = 0; kk < 32; ++kk) wv[kk] = aw[(size_t)(half * 512 + ks * 32 + kk) * 3072 + col0 + col];
        { float (&w0)[16] = *reinterpret_cast<float (*)[16]>(&wv[0]); float (&w1)[16] = *reinterpret_cast<float (*)[16]>(&wv[16]); pin16x2(w0, w1); }
#pragma unroll
        for (int kk = 0; kk < 32; ++kk) {
            const int k = ks * 32 + kk;
            const float w = wv[kk];
            asm volatile("" ::: "memory");
#pragma unroll
            for (int b4 = 0; b4 < 10; ++b4) {
                const f32x4 c4 = *(const LAS f32x4*)(cs + k * 40 + b4 * 4);
                acc[b4 * 4 + 0] += c4[0] * w; acc[b4 * 4 + 1] += c4[1] * w; acc[b4 * 4 + 2] += c4[2] * w; acc[b4 * 4 + 3] += c4[3] * w;
            }
        }
    }
    __syncthreads();
    LAS float* red = (LAS float*)lds;
#pragma unroll
    for (int b = 0; b < 40; ++b) red[(ks * 40 + b) * 32 + col] = acc[b];
    __syncthreads();
    float* MOD = (float*)(p.ws + WS_MOD);
    for (int idx = tid; idx < 1280; idx += 512) {
        const int b = idx >> 5, c = idx & 31;
        float s = p.in[I_ADAB][l * 3072 + col0 + c];
#pragma unroll
        for (int k16 = 0; k16 < 16; ++k16) s += red[(k16 * 40 + b) * 32 + c];
        MOD[(size_t)(l * 40 + b) * 3072 + col0 + c] = s;
    }
}
struct TileRef { const float* src; bf16_t* dst; int pitch, k0, n0; };
DI TileRef tile_ref(const Params& p, int t) {
    TileRef r; int tt;
    if (t < 512) { r.src = p.in[I_AWIN]; r.dst = (bf16_t*)(p.ws + WS_WTA); r.pitch = 4112; tt = t; }
    else if (t < 640) { r.src = p.in[I_AWOUT]; r.dst = (bf16_t*)(p.ws + WS_WTAO); r.pitch = 1024; tt = t - 512; }
    else if (t < 1920) { r.src = p.in[I_BWIN]; r.dst = (bf16_t*)(p.ws + WS_WTB); r.pitch = 10240; tt = t - 640; }
    else { r.src = p.in[I_BWOUT]; r.dst = (bf16_t*)(p.ws + WS_WTBO); r.pitch = 1024; tt = t - 1920; }
    r.k0 = (tt & 15) * 64; r.n0 = (tt >> 4) * 128; return r;
}
DI void tile_load(const TileRef& r, int tid, f32x4 (&v)[4]) {
#pragma unroll
    for (int i = 0; i < 4; ++i) { const int kk = (tid >> 5) + 16 * i, nn = (tid & 31) * 4; v[i] = *(const f32x4*)(r.src + (size_t)(r.k0 + kk) * r.pitch + r.n0 + nn); }
}
DI void phase_prep(const Params& p, LAS unsigned char* lds) {
    const int bid = blockIdx.x, G = gridDim.x;
    for (int it = bid; it < 192; it += G) ada_item(p, lds, it);
    int t, tstep, tend;
    if (G == 256) { if (bid < 192) { t = bid * 2; tstep = 1; tend = t + 2; } else { t = 384 + (bid - 192); tstep = 64; tend = 640; } }
    else { t = bid; tstep = G; tend = 640; }
    const int tid = TID();
    LAS float* T = (LAS float*)lds;
    f32x4 cur[4], nxt[4];
    TileRef rc, rn;
    if (t < tend) { rc = tile_ref(p, t); tile_load(rc, tid, cur); }
    for (; t < tend; t += tstep) {
        const int tn = t + tstep;
        if (tn < tend) { rn = tile_ref(p, tn); tile_load(rn, tid, nxt); }
        lds_sync();
#pragma unroll
        for (int i = 0; i < 4; ++i) { const int kk = (tid >> 5) + 16 * i, nn = (tid & 31) * 4;
            T[kk * 129 + nn] = cur[i][0]; T[kk * 129 + nn + 1] = cur[i][1]; T[kk * 129 + nn + 2] = cur[i][2]; T[kk * 129 + nn + 3] = cur[i][3]; }
        lds_sync();
#pragma unroll
        for (int q = 0; q < 2; ++q) {
            const int task = tid + 512 * q, nn = task >> 3, kc = task & 7;
            u32x4 w;
            w.x = pk2(T[(kc * 8 + 0) * 129 + nn], T[(kc * 8 + 1) * 129 + nn]); w.y = pk2(T[(kc * 8 + 2) * 129 + nn], T[(kc * 8 + 3) * 129 + nn]);
            w.z = pk2(T[(kc * 8 + 4) * 129 + nn], T[(kc * 8 + 5) * 129 + nn]); w.w = pk2(T[(kc * 8 + 6) * 129 + nn], T[(kc * 8 + 7) * 129 + nn]);
            *(u32x4*)(rc.dst + (size_t)(rc.n0 + nn) * 1024 + rc.k0 + kc * 8) = w;
        }
#pragma unroll
        for (int i = 0; i < 4; ++i) cur[i] = nxt[i];
        rc = rn;
    }
}

template <bool AB> DI void phase_norm(const Params& p, LAS unsigned char* lds, const float* xp, const float* xs, int layer) {
    const int tid = TID(), lane = tid & 63, wid = tid >> 6;
    LAS float* wab = (LAS float*)lds;
    if (AB) {
        for (int idx = tid; idx < 16384; idx += 512) { const int k = idx >> 4, j = idx & 15; wab[k * 20 + j] = p.in[I_AWIN][(size_t)k * 4112 + 4096 + j]; }
        __syncthreads();
    }
    const float* MODl = (const float*)(p.ws + WS_MOD) + (size_t)layer * 40 * 3072;
    const float* ng = p.in[I_NG] + layer * 1024;
    bf16_t* ACT = (bf16_t*)(p.ws + WS_ACT);
    float* GB = (float*)(p.ws + WS_GB);
    const int nw = gridDim.x * 8;
    float gsv[16], shv[16];
    auto ld_mod = [&](int b) {
        const float* mb = MODl + (size_t)b * 3072;
        float sc[16], g16[16];
#pragma unroll
        for (int i = 0; i < 16; ++i) { const int c = lane + 64 * i; sc[i] = mb[1024 + c]; shv[i] = mb[c]; g16[i] = ng[c]; }
#pragma unroll
        for (int i = 0; i < 16; ++i) gsv[i] = g16[i] * (1.f + sc[i]);
    };
    auto ld_row = [&](int row, float (&v)[16]) {
        const float* x = row < MP ? xp + (size_t)row * 1024 : xs + (size_t)(row - MP) * 1024;
#pragma unroll
        for (int i = 0; i < 16; ++i) v[i] = x[lane + 64 * i];
    };
    auto do_row = [&](int row, float (&v)[16]) {
        float ss = 0.f;
#pragma unroll
        for (int i = 0; i < 16; ++i) ss += v[i] * v[i];
        ss = wave_sum(ss);
        const float rstd = rsqrtf(ss * (1.f / 1024.f) + EPS);
#pragma unroll
        for (int i = 0; i < 16; ++i) {
            const int c = lane + 64 * i;
            v[i] = v[i] * rstd * gsv[i] + shv[i];
            ACT[(size_t)row * 1024 + c] = (bf16_t)(pk2(v[i], 0.f) & 0xffffu);
        }
        if (AB) {
            float pa[16];
#pragma unroll
            for (int j = 0; j < 16; ++j) pa[j] = 0.f;
#pragma unroll
            for (int i = 0; i < 16; ++i) {
                const int c = lane + 64 * i;
                asm volatile("" ::: "memory");
#pragma unroll
                for (int q = 0; q < 4; ++q) { const f32x4 w = *(const LAS f32x4*)(wab + c * 20 + q * 4); pa[q * 4] += v[i] * w[0]; pa[q * 4 + 1] += v[i] * w[1]; pa[q * 4 + 2] += v[i] * w[2]; pa[q * 4 + 3] += v[i] * w[3]; }
            }
            float mine = 0.f;
#pragma unroll
            for (int j = 0; j < 16; ++j) { const float sm = wave_sum(pa[j]); if (lane == j) mine = sm; }
            if (lane < 16) {
                float r;
                if (lane < 8) { const float a = mine + p.in[I_ADT][lane]; const float sp = a > 20.f ? a : log1pf(__expf(a)); r = -__expf(p.in[I_ALOG][lane]) * sp; }
                else r = 1.f / (1.f + __expf(-mine));
                GB[(size_t)row * 16 + lane] = r;
            }
        }
    };
    for (int chunk = blockIdx.x * 8 + wid; chunk < MP / 8; chunk += nw) {
        const int r0 = chunk * 8;
        ld_mod(r0 >> 11);
#pragma unroll 1
        for (int h4 = 0; h4 < 2; ++h4) {
            float va[16], vb[16], vc[16], vd[16];
            const int r = r0 + 4 * h4;
            ld_row(r, va); ld_row(r + 1, vb); ld_row(r + 2, vc); ld_row(r + 3, vd);
            pin16x4(va, vb, vc, vd);
            do_row(r, va); do_row(r + 1, vb); do_row(r + 2, vc); do_row(r + 3, vd);
        }
    }
    for (int r = blockIdx.x * 8 + wid; r < MS; r += nw) {
        float va[16];
        ld_mod(8 + (r >> 3));
        ld_row(MP + r, va);
        do_row(MP + r, va);
    }
}

DI void phase_norm1(const Params& p) {
    const int lane = TID() & 63, wid = TID() >> 6;
    const float* MODl = (const float*)(p.ws + WS_MOD) + (size_t)40 * 3072;
    const float* ng = p.in[I_NG] + 1024;
    const bf16_t* X1 = (const bf16_t*)(p.ws + WS_X1);
    bf16_t* ACT = (bf16_t*)(p.ws + WS_ACT);
    const int nw = gridDim.x * 8;
    float gsv[16], shv[16];
    auto ld_mod = [&](int b) {
        const float* mb = MODl + (size_t)b * 3072 + lane * 16;
#pragma unroll
        for (int q = 0; q < 4; ++q) { const f32x4 sc = *(const f32x4*)(mb + 1024 + q * 4), sh = *(const f32x4*)(mb + q * 4), g = *(const f32x4*)(ng + lane * 16 + q * 4);
#pragma unroll
            for (int e = 0; e < 4; ++e) { gsv[q * 4 + e] = g[e] * (1.f + sc[e]); shv[q * 4 + e] = sh[e]; } }
    };
    auto do_row = [&](int row, u32x4 a, u32x4 b) {
        float v[16] = {bflo(a.x), bfhi(a.x), bflo(a.y), bfhi(a.y), bflo(a.z), bfhi(a.z), bflo(a.w), bfhi(a.w), bflo(b.x), bfhi(b.x), bflo(b.y), bfhi(b.y), bflo(b.z), bfhi(b.z), bflo(b.w), bfhi(b.w)};
        float ss = 0.f;
#pragma unroll
        for (int i = 0; i < 16; ++i) ss += v[i] * v[i];
        ss = wave_sum(ss);
        const float rstd = rsqrtf(ss * (1.f / 1024.f) + EPS);
#pragma unroll
        for (int i = 0; i < 16; ++i) v[i] = v[i] * rstd * gsv[i] + shv[i];
        u32x4 w0, w1;
        w0.x = pk2(v[0], v[1]); w0.y = pk2(v[2], v[3]); w0.z = pk2(v[4], v[5]); w0.w = pk2(v[6], v[7]);
        w1.x = pk2(v[8], v[9]); w1.y = pk2(v[10], v[11]); w1.z = pk2(v[12], v[13]); w1.w = pk2(v[14], v[15]);
        u32x4* d = (u32x4*)(ACT + (size_t)row * 1024 + lane * 16); d[0] = w0; d[1] = w1;
    };
    for (int chunk = blockIdx.x * 8 + wid; chunk < MP / 8; chunk += nw) {
        const int r0 = chunk * 8;
        ld_mod(r0 >> 11);
#pragma unroll 1
        for (int h4 = 0; h4 < 2; ++h4) {
            u32x4 r[8];
#pragma unroll
            for (int j = 0; j < 4; ++j) { const u32x4* src = (const u32x4*)(X1 + (size_t)(r0 + 4 * h4 + j) * 1024 + lane * 16); r[2 * j] = src[0]; r[2 * j + 1] = src[1]; }
            pin8(r);
#pragma unroll
            for (int j = 0; j < 4; ++j) do_row(r0 + 4 * h4 + j, r[2 * j], r[2 * j + 1]);
        }
    }
    for (int rr = blockIdx.x * 8 + wid; rr < MS; rr += nw) {
        ld_mod(8 + (rr >> 3));
        const u32x4* src = (const u32x4*)(X1 + (size_t)(MP + rr) * 1024 + lane * 16);
        const u32x4 a = src[0], b = src[1];
        do_row(MP + rr, a, b);
    }
}

constexpr int WT_TASKS = 5120 + 512;
DI void wt_task(const Params& p, int t, int lane) {
    const float* src; bf16_t* dst; int pitch;
    if (t < 5120) { src = p.in[I_BWIN]; dst = (bf16_t*)(p.ws + WS_WTB); pitch = 10240; }
    else { src = p.in[I_BWOUT]; dst = (bf16_t*)(p.ws + WS_WTBO); pitch = 1024; t -= 5120; }
    const int k0 = (t & 31) * 32, n = (t >> 5) * 64 + lane;
    const float* sp = src + (size_t)k0 * pitch + n;
    f32x4 v[8];
#pragma unroll
    for (int q = 0; q < 8; ++q) { v[q][0] = sp[(size_t)(4 * q) * pitch]; v[q][1] = sp[(size_t)(4 * q + 1) * pitch]; v[q][2] = sp[(size_t)(4 * q + 2) * pitch]; v[q][3] = sp[(size_t)(4 * q + 3) * pitch]; }
    pin8(v);
    u32x4* dp = (u32x4*)(dst + (size_t)n * 1024 + k0);
#pragma unroll
    for (int q = 0; q < 4; ++q) { u32x4 w; w.x = pk2(v[2 * q][0], v[2 * q][1]); w.y = pk2(v[2 * q][2], v[2 * q][3]); w.z = pk2(v[2 * q + 1][0], v[2 * q + 1][1]); w.w = pk2(v[2 * q + 1][2], v[2 * q + 1][3]); dp[q] = w; }
}

constexpr int PQ = 0, PK = 17408, PT = 34816, PR = 53248, PN = 118784, PG = 136192;
DI void prep_item(const Params& p, LAS unsigned char* lds, int ci) {
    const int tid = TID(), lane = tid & 63, wid = tid >> 6;
    const bf16_t* P0 = (const bf16_t*)(p.ws + WS_P0);
    const float* GB = (const float*)(p.ws + WS_GB);
    int h, row0, nvalid, nprev; const float* sconv = nullptr;
    if (ci < 2048) { const int bh = ci >> 5, n = ci & 31; h = bh & 7; row0 = (bh >> 3) * 2048 + n * 64; nvalid = 64; nprev = n * 64; }
    else { const int sb = (ci - 2048) >> 3; h = (ci - 2048) & 7; row0 = MP + sb * 8; nvalid = 8; nprev = 0; sconv = p.in[I_SC] + (size_t)sb * 3 * 3072; }
    LAS float* sg = (LAS float*)(lds + PG);
    LAS float* cw = (LAS float*)(lds + PG + 1024);
    const int i = tid >> 3, sub = tid & 7;
    lds_sync();
    u32x4 raw[4][3][2];
#pragma unroll
    for (int t = 0; t < 4; ++t) {
        const int rel = i - 3 + t;
#pragma unroll
        for (int sct = 0; sct < 3; ++sct) {
            const int ch = sct * 1024 + h * 128 + sub * 16;
            raw[t][sct][0] = (u32x4){0u, 0u, 0u, 0u}; raw[t][sct][1] = (u32x4){0u, 0u, 0u, 0u};
            if (i < nvalid) {
                if (rel >= 0 || nprev > 0) {
                    const u32x4* src = (const u32x4*)(P0 + (size_t)(row0 + rel) * 4096 + ch);
                    raw[t][sct][0] = src[0]; raw[t][sct][1] = src[1];
                } else if (sconv) {
                    const f32x4* src = (const f32x4*)(sconv + (size_t)(3 + rel) * 3072 + ch);
                    const f32x4 a = src[0], b = src[1], c = src[2], d = src[3];
                    raw[t][sct][0] = (u32x4){pk2(a[0], a[1]), pk2(a[2], a[3]), pk2(b[0], b[1]), pk2(b[2], b[3])};
                    raw[t][sct][1] = (u32x4){pk2(c[0], c[1]), pk2(c[2], c[3]), pk2(d[0], d[1]), pk2(d[2], d[3])};
                }
            }
        }
    }
    for (int idx = tid; idx < 1536; idx += 512) { const int t = idx / 384, rem = idx - t * 384, sct = rem >> 7, c = rem & 127; cw[idx] = p.in[I_ACONV][(size_t)t * 3072 + sct * 1024 + h * 128 + c]; }
    if (wid == 0) {
        float g = lane < nvalid ? GB[(size_t)(row0 + lane) * 16 + h] : 0.f;
        const float be = lane < nvalid ? GB[(size_t)(row0 + lane) * 16 + 8 + h] : 0.f;
#pragma unroll
        for (int o = 1; o < 64; o <<= 1) { const float t = __shfl_up(g, o); if (lane >= o) g += t; }
        sg[lane] = g; sg[64 + lane] = be; sg[128 + lane] = __expf(g);
        if (lane == 63) { sg[192] = g; ((float*)(p.ws + WS_GT))[ci] = __expf(g); }
    }
    asm volatile("" : "+v"(raw[0][0][0]), "+v"(raw[0][0][1]), "+v"(raw[0][1][0]), "+v"(raw[0][1][1]), "+v"(raw[0][2][0]), "+v"(raw[0][2][1]), "+v"(raw[1][0][0]), "+v"(raw[1][0][1]), "+v"(raw[1][1][0]), "+v"(raw[1][1][1]), "+v"(raw[1][2][0]), "+v"(raw[1][2][1]), "+v"(raw[2][0][0]), "+v"(raw[2][0][1]), "+v"(raw[2][1][0]), "+v"(raw[2][1][1]), "+v"(raw[2][2][0]), "+v"(raw[2][2][1]), "+v"(raw[3][0][0]), "+v"(raw[3][0][1]), "+v"(raw[3][1][0]), "+v"(raw[3][1][1]), "+v"(raw[3][2][0]), "+v"(raw[3][2][1]));
    lds_sync();
    {
        float y[3][16];
#pragma unroll
        for (int sct = 0; sct < 3; ++sct) {
#pragma unroll
            for (int j = 0; j < 16; ++j) y[sct][j] = 0.f;
#pragma unroll
            for (int t = 0; t < 4; ++t) {
                const u32x4 a = raw[t][sct][0], b = raw[t][sct][1];
                const float u[16] = {bflo(a.x), bfhi(a.x), bflo(a.y), bfhi(a.y), bflo(a.z), bfhi(a.z), bflo(a.w), bfhi(a.w),
                                     bflo(b.x), bfhi(b.x), bflo(b.y), bfhi(b.y), bflo(b.z), bfhi(b.z), bflo(b.w), bfhi(b.w)};
#pragma unroll
                for (int q = 0; q < 4; ++q) { const f32x4 w = *(const LAS f32x4*)(cw + (t * 3 + sct) * 128 + sub * 16 + q * 4);
                    y[sct][q * 4] += w[0] * u[q * 4]; y[sct][q * 4 + 1] += w[1] * u[q * 4 + 1]; y[sct][q * 4 + 2] += w[2] * u[q * 4 + 2]; y[sct][q * 4 + 3] += w[3] * u[q * 4 + 3]; }
            }
#pragma unroll
            for (int j = 0; j < 16; ++j) y[sct][j] = siluf(y[sct][j]);
        }
        float sq = 0.f, sk = 0.f;
#pragma unroll
        for (int j = 0; j < 16; ++j) { sq += y[0][j] * y[0][j]; sk += y[1][j] * y[1][j]; }
        sq += dpp_f<0xB1>(sq); sq += dpp_f<0x4E>(sq); sq += dpp_f<0x141>(sq);
        sk += dpp_f<0xB1>(sk); sk += dpp_f<0x4E>(sk); sk += dpp_f<0x141>(sk);
        const float rq = rsqrtf(sq + EPS) * 0.08838834764831845f, rk = rsqrtf(sk + EPS);
        const float gci = sg[i], bei = sg[64 + i], egi = sg[128 + i], ekd = __expf(sg[192] - gci);
        LAS float* R = (LAS float*)(lds + PR) + i * 256;
        u32x4 qa, qb, ka, kb, da, db;
        float qn[16], kn[16];
#pragma unroll
        for (int j = 0; j < 16; ++j) { qn[j] = y[0][j] * rq; kn[j] = y[1][j] * rk; }
        qa.x = pk2(qn[0], qn[1]); qa.y = pk2(qn[2], qn[3]); qa.z = pk2(qn[4], qn[5]); qa.w = pk2(qn[6], qn[7]);
        qb.x = pk2(qn[8], qn[9]); qb.y = pk2(qn[10], qn[11]); qb.z = pk2(qn[12], qn[13]); qb.w = pk2(qn[14], qn[15]);
        ka.x = pk2(kn[0], kn[1]); ka.y = pk2(kn[2], kn[3]); ka.z = pk2(kn[4], kn[5]); ka.w = pk2(kn[6], kn[7]);
        kb.x = pk2(kn[8], kn[9]); kb.y = pk2(kn[10], kn[11]); kb.z = pk2(kn[12], kn[13]); kb.w = pk2(kn[14], kn[15]);
        *(LAS u32x4*)(lds + PQ + i * 272 + sub * 32) = qa; *(LAS u32x4*)(lds + PQ + i * 272 + sub * 32 + 16) = qb;
        *(LAS u32x4*)(lds + PK + i * 272 + sub * 32) = ka; *(LAS u32x4*)(lds + PK + i * 272 + sub * 32 + 16) = kb;
        da.x = pk2(qn[0] * egi, qn[1] * egi); da.y = pk2(qn[2] * egi, qn[3] * egi); da.z = pk2(qn[4] * egi, qn[5] * egi); da.w = pk2(qn[6] * egi, qn[7] * egi);
        db.x = pk2(qn[8] * egi, qn[9] * egi); db.y = pk2(qn[10] * egi, qn[11] * egi); db.z = pk2(qn[12] * egi, qn[13] * egi); db.w = pk2(qn[14] * egi, qn[15] * egi);
        bf16_t* qd = (bf16_t*)(p.ws + WS_QD) + (size_t)ci * 8192 + i * 128 + sub * 16;
        *(u32x4*)qd = da; *(u32x4*)(qd + 8) = db;
        LAS bf16_t* T = (LAS bf16_t*)(lds + PT);
#pragma unroll
        for (int j = 0; j < 16; ++j) T[(sub * 16 + j) * 72 + i] = (bf16_t)(pk2(kn[j] * ekd, 0.f) & 0xffffu);
        const float kbs = bei * egi;
#pragma unroll
        for (int q = 0; q < 4; ++q) {
            *(LAS f32x4*)(R + sub * 16 + q * 4) = (f32x4){y[2][q * 4] * bei, y[2][q * 4 + 1] * bei, y[2][q * 4 + 2] * bei, y[2][q * 4 + 3] * bei};
            *(LAS f32x4*)(R + 128 + sub * 16 + q * 4) = (f32x4){kn[q * 4] * kbs, kn[q * 4 + 1] * kbs, kn[q * 4 + 2] * kbs, kn[q * 4 + 3] * kbs};
        }
    }
    lds_sync();
    {
        const int r16 = lane & 15, fq = lane >> 4;
        bf16_t* QK = (bf16_t*)(p.ws + WS_QK) + (size_t)ci * 4096;
        LAS float* Nm = (LAS float*)(lds + PN);
#pragma unroll
        for (int t = 0; t < 4; ++t) {
            const int id = wid * 4 + t, mat = id >> 4, ti = (id & 15) >> 2, tj = id & 3;
            f32x4 acc = {0.f, 0.f, 0.f, 0.f};
            if (tj <= ti) {
                const LAS unsigned char* xa = lds + PK + (tj * 16 + r16) * 272 + fq * 16;
                const LAS unsigned char* xb = lds + (mat ? PQ : PK) + (ti * 16 + r16) * 272 + fq * 16;
#pragma unroll
                for (int ks = 0; ks < 4; ++ks) acc = mfma16(lds_ld8(xa + ks * 64), lds_ld8(xb + ks * 64), acc);
            }
            const int i = ti * 16 + r16, j0 = tj * 16 + fq * 4;
            const float gi = sg[i], bi = sg[64 + i];
            f32x4 o;
#pragma unroll
            for (int r = 0; r < 4; ++r) {
                const int j = j0 + r;
                const bool ok = mat ? (j <= i) : (j < i);
                const float dec = ok ? __expf(gi - sg[j]) : 0.f;
                o[r] = ok ? acc[r] * dec * (mat ? 1.f : bi) : 0.f;
            }
            if (mat) { u32x2 w; w.x = pk2(o[0], o[1]); w.y = pk2(o[2], o[3]); *(u32x2*)(QK + i * 64 + j0) = w; }
            else *(LAS f32x4*)(Nm + i * 68 + j0) = o;
        }
    }
    lds_sync();
    if (tid < 256) {
        const LAS float* R = (const LAS float*)(lds + PR) + tid;
        int zv = 0; asm volatile("" : "+v"(zv));
        const LAS float* Nm = (const LAS float*)(lds + PN + zv);
        float x[64];
        f32x4 nb[2][16];
        x[0] = R[0];
        float rn = R[256];
        nb[1][0] = *(const LAS f32x4*)(Nm + 68);
#pragma unroll
        for (int i = 1; i < 64; ++i) {
            const float r = rn;
            if (i + 1 < 64) {
                rn = R[(i + 1) * 256];
#pragma unroll
                for (int j4 = 0; j4 < (i + 4) / 4; ++j4) nb[(i + 1) & 1][j4] = *(const LAS f32x4*)(Nm + (i + 1) * 68 + j4 * 4);
            }
            float a0 = 0.f, a1 = 0.f, a2 = 0.f, a3 = 0.f;
#pragma unroll
            for (int j4 = 0; j4 < (i + 3) / 4; ++j4) {
                const f32x4 nv = nb[i & 1][j4];
                if (j4 * 4 + 0 < i) a0 += nv[0] * x[j4 * 4 + 0];
                if (j4 * 4 + 1 < i) a1 += nv[1] * x[j4 * 4 + 1];
                if (j4 * 4 + 2 < i) a2 += nv[2] * x[j4 * 4 + 2];
                if (j4 * 4 + 3 < i) a3 += nv[3] * x[j4 * 4 + 3];
            }
            x[i] = r - ((a0 + a1) + (a2 + a3));
            asm volatile("" ::: "memory");
        }
        if (tid < 128) {
            u32x4* d = (u32x4*)((bf16_t*)(p.ws + WS_WV) + (size_t)ci * 8192 + tid * 64);
#pragma unroll
            for (int q = 0; q < 8; ++q) { u32x4 w; w.x = pk2(x[q * 8], x[q * 8 + 1]); w.y = pk2(x[q * 8 + 2], x[q * 8 + 3]); w.z = pk2(x[q * 8 + 4], x[q * 8 + 5]); w.w = pk2(x[q * 8 + 6], x[q * 8 + 7]); d[q] = w; }
        } else {
            bf16_t* d = (bf16_t*)(p.ws + WS_KC) + (size_t)ci * 8192 + (tid - 128);
#pragma unroll
            for (int i = 0; i < 64; ++i) d[i * 128] = (bf16_t)(pk2(x[i], 0.f) & 0xffffu);
        }
    } else {
        bf16_t* d = (bf16_t*)(p.ws + WS_KDT) + (size_t)ci * 8192;
#pragma unroll
        for (int q = 0; q < 4; ++q) { const int idx = (tid - 256) + q * 256, r = idx >> 3, c8 = idx & 7; *(u32x4*)(d + r * 64 + c8 * 8) = *(const LAS u32x4*)(lds + PT + r * 144 + c8 * 16); }
        const int wtask = ci * 4 + (wid - 4);
        if (wtask < WT_TASKS) wt_task(p, wtask, lane);
    }
}
DI void phase_dprep(const Params& p, LAS unsigned char* lds) { for (int ci = blockIdx.x; ci < NCH; ci += gridDim.x) prep_item(p, lds, ci); }

constexpr int SKC = 0, SQD = 17408, SKD = 34816, SQK = 53248, SST = 62464, SUT = 71168;
DI void scan_item(const Params& p, LAS unsigned char* lds, int item) {
    const int tid = TID(), lane = tid & 63, wid = tid >> 6, r16 = lane & 15, fq = lane >> 4;
    int ch0, nch, rowbase, h, dvs, nvalid; const float* S0 = nullptr; float* Sout;
    if (item < 256) { const int bh = item >> 2; dvs = item & 3; h = bh & 7; ch0 = bh * 32; nch = 32; rowbase = (bh >> 3) * 2048; nvalid = 64; Sout = p.out + O_DP + (size_t)bh * 16384; }
    else { const int it = item - 256, sbh = it >> 2; dvs = it & 3; h = sbh & 7; ch0 = 2048 + sbh; nch = 1; rowbase = MP + (sbh >> 3) * 8; nvalid = 8;
           S0 = p.in[I_SD] + (size_t)sbh * 16384; Sout = p.out + O_DS + (size_t)sbh * 16384; }
    const int dvoff = dvs * 32;
    const int dk0 = wid * 16;
    f32x4 accS[2];
#pragma unroll
    for (int vt = 0; vt < 2; ++vt)
#pragma unroll
        for (int r = 0; r < 4; ++r) accS[vt][r] = S0 ? S0[(size_t)(dk0 + 4 * fq + r) * 128 + dvoff + vt * 16 + r16] : 0.f;
    const bf16_t* gKC = (const bf16_t*)(p.ws + WS_KC); const bf16_t* gQD = (const bf16_t*)(p.ws + WS_QD);
    const bf16_t* gKD = (const bf16_t*)(p.ws + WS_KDT); const bf16_t* gQK = (const bf16_t*)(p.ws + WS_QK);
    const bf16_t* gWV = (const bf16_t*)(p.ws + WS_WV); const float* gGT = (const float*)(p.ws + WS_GT);
    bf16_t* O0 = (bf16_t*)(p.ws + WS_O0);
    u32x4 st[7];
    auto issue = [&](int ci) {
        const u32x4* a = (const u32x4*)(gKC + (size_t)ci * 8192); const u32x4* b = (const u32x4*)(gQD + (size_t)ci * 8192);
        const u32x4* c = (const u32x4*)(gKD + (size_t)ci * 8192); const u32x4* d = (const u32x4*)(gQK + (size_t)ci * 4096);
        st[0] = a[tid]; st[1] = a[tid + 512]; st[2] = b[tid]; st[3] = b[tid + 512]; st[4] = c[tid]; st[5] = c[tid + 512]; st[6] = d[tid];
    };
    auto commit = [&]() {
#pragma unroll
        for (int l = 0; l < 2; ++l) { const int idx = tid + 512 * l;
            *(LAS u32x4*)(lds + SKC + (idx >> 4) * 272 + (idx & 15) * 16) = st[l];
            *(LAS u32x4*)(lds + SQD + (idx >> 4) * 272 + (idx & 15) * 16) = st[2 + l];
            *(LAS u32x4*)(lds + SKD + (idx >> 3) * 144 + (idx & 7) * 16) = st[4 + l]; }
        *(LAS u32x4*)(lds + SQK + (tid >> 3) * 144 + (tid & 7) * 16) = st[6];
    };
    auto put_St = [&]() {
#pragma unroll
        for (int vt = 0; vt < 2; ++vt) { u32x2 w; w.x = pk2(accS[vt][0], accS[vt][1]); w.y = pk2(accS[vt][2], accS[vt][3]);
            *(LAS u32x2*)(lds + SST + (vt * 16 + r16) * 272 + (dk0 + 4 * fq) * 2) = w; }
    };
    lds_sync();
    issue(ch0); put_St(); commit();
    lds_sync();
    const int c0 = (wid & 3) * 16, v0 = (wid >> 2) * 16;
    u32x2 wv_n = *(const u32x2*)(gWV + (size_t)ch0 * 8192 + (dvoff + v0 + r16) * 64 + c0 + 4 * fq);
    float gtot_n = gGT[ch0];
    for (int n = 0; n < nch; ++n) {
        const int ci = ch0 + n;
        const u32x2 wv = wv_n; const float gtot = gtot_n;
        if (n + 1 < nch) { issue(ci + 1); wv_n = *(const u32x2*)(gWV + (size_t)(ci + 1) * 8192 + (dvoff + v0 + r16) * 64 + c0 + 4 * fq); gtot_n = gGT[ci + 1]; }
        f32x4 a1 = {0.f, 0.f, 0.f, 0.f};
        { bf16x8 fa[4], fb[4];
#pragma unroll
          for (int ks = 0; ks < 4; ++ks) { fa[ks] = lds_ld8(lds + SKC + (c0 + r16) * 272 + ks * 64 + fq * 16); fb[ks] = lds_ld8(lds + SST + (v0 + r16) * 272 + ks * 64 + fq * 16); }
          pin4x4(fa, fb);
#pragma unroll
          for (int ks = 0; ks < 4; ++ks) a1 = mfma16(fa[ks], fb[ks], a1); }
        { u32x2 w; w.x = pk2(bflo(wv.x) - a1[0], bfhi(wv.x) - a1[1]); w.y = pk2(bflo(wv.y) - a1[2], bfhi(wv.y) - a1[3]);
          *(LAS u32x2*)(lds + SUT + (v0 + r16) * 144 + (c0 + 4 * fq) * 2) = w; }
        lds_sync();
        f32x4 a2 = {0.f, 0.f, 0.f, 0.f};
        bf16x8 ga[8], gb[8];
#pragma unroll
        for (int ks = 0; ks < 4; ++ks) { ga[ks] = lds_ld8(lds + SST + (v0 + r16) * 272 + ks * 64 + fq * 16); gb[ks] = lds_ld8(lds + SQD + (c0 + r16) * 272 + ks * 64 + fq * 16); }
#pragma unroll
        for (int ks = 0; ks < 2; ++ks) { ga[4 + ks] = lds_ld8(lds + SUT + (v0 + r16) * 144 + ks * 64 + fq * 16); gb[4 + ks] = lds_ld8(lds + SQK + (c0 + r16) * 144 + ks * 64 + fq * 16); }
#pragma unroll
        for (int ks = 0; ks < 2; ++ks) { ga[6 + ks] = lds_ld8(lds + SKD + (dk0 + r16) * 144 + ks * 64 + fq * 16); gb[6 + ks] = lds_ld8(lds + SUT + ((1 - (wid >> 2)) * 16 + r16) * 144 + ks * 64 + fq * 16); }
        pin8x8(ga, gb);
#pragma unroll
        for (int ks = 0; ks < 6; ++ks) a2 = mfma16(ga[ks], gb[ks], a2);
        if (c0 + r16 < nvalid) { u32x2 w; w.x = pk2(a2[0], a2[1]); w.y = pk2(a2[2], a2[3]);
            *(u32x2*)(O0 + (size_t)(rowbase + n * 64 + c0 + r16) * 1024 + h * 128 + dvoff + v0 + 4 * fq) = w; }
#pragma unroll
        for (int vt = 0; vt < 2; ++vt) {
            accS[vt] *= gtot;
            const bool own = (vt == (wid >> 2));
#pragma unroll
            for (int ks = 0; ks < 2; ++ks) accS[vt] = mfma16(ga[6 + ks], own ? ga[4 + ks] : gb[6 + ks], accS[vt]);
        }
        lds_sync();
        put_St();
        if (n + 1 < nch) commit();
        lds_sync();
    }
#pragma unroll
    for (int vt = 0; vt < 2; ++vt)
#pragma unroll
        for (int r = 0; r < 4; ++r) Sout[(size_t)(dk0 + 4 * fq + r) * 128 + dvoff + vt * 16 + r16] = accS[vt][r];
}
DI void phase_scan(const Params& p, LAS unsigned char* lds) {
    const int bid = blockIdx.x, G = gridDim.x;
    if (G == 256) {
        const int xcd = bid & 7, idx = bid >> 3, dvs = idx & 3, hx = xcd * 8 + (idx >> 2);
        scan_item(p, lds, hx * 4 + dvs);
        for (int i = 0; i < 4; ++i) scan_item(p, lds, 256 + (i * 64 + hx) * 4 + dvs);
    } else {
        for (int it = bid; it < 256 + 1024; it += G) scan_item(p, lds, it);
    }
}

DI void phase_gate0(const Params& p) {
    const int lane = TID() & 63, wid = TID() >> 6;
    const bf16_t* O0 = (const bf16_t*)(p.ws + WS_O0); const bf16_t* P0 = (const bf16_t*)(p.ws + WS_P0); bf16_t* ACT = (bf16_t*)(p.ws + WS_ACT);
    const float* og = p.in[I_AOG] + (lane & 7) * 16;
    const int nw = gridDim.x * 8;
    auto ld_row = [&](int row, u32x4 (&r)[4]) {
        const u32x4* so = (const u32x4*)(O0 + (size_t)row * 1024 + lane * 16); const u32x4* sz = (const u32x4*)(P0 + (size_t)row * 4096 + 3072 + lane * 16);
        r[0] = so[0]; r[1] = so[1]; r[2] = sz[0]; r[3] = sz[1];
    };
    auto do_row = [&](int row, const u32x4 (&r)[4]) {
        float o[16], z[16];
#pragma unroll
        for (int q = 0; q < 2; ++q) { const u32x4 a = r[q], b = r[2 + q];
            o[q * 8] = bflo(a.x); o[q * 8 + 1] = bfhi(a.x); o[q * 8 + 2] = bflo(a.y); o[q * 8 + 3] = bfhi(a.y); o[q * 8 + 4] = bflo(a.z); o[q * 8 + 5] = bfhi(a.z); o[q * 8 + 6] = bflo(a.w); o[q * 8 + 7] = bfhi(a.w);
            z[q * 8] = bflo(b.x); z[q * 8 + 1] = bfhi(b.x); z[q * 8 + 2] = bflo(b.y); z[q * 8 + 3] = bfhi(b.y); z[q * 8 + 4] = bflo(b.z); z[q * 8 + 5] = bfhi(b.z); z[q * 8 + 6] = bflo(b.w); z[q * 8 + 7] = bfhi(b.w); }
        float ss = 0.f;
#pragma unroll
        for (int j = 0; j < 16; ++j) ss += o[j] * o[j];
        ss += dpp_f<0xB1>(ss); ss += dpp_f<0x4E>(ss); ss += dpp_f<0x141>(ss);
        const float rstd = rsqrtf(ss * (1.f / 128.f) + EPS);
        float rr[16];
#pragma unroll
        for (int j = 0; j < 16; ++j) rr[j] = o[j] * rstd * og[j] * siluf(z[j]);
        u32x4 w0, w1;
        w0.x = pk2(rr[0], rr[1]); w0.y = pk2(rr[2], rr[3]); w0.z = pk2(rr[4], rr[5]); w0.w = pk2(rr[6], rr[7]);
        w1.x = pk2(rr[8], rr[9]); w1.y = pk2(rr[10], rr[11]); w1.z = pk2(rr[12], rr[13]); w1.w = pk2(rr[14], rr[15]);
        u32x4* d = (u32x4*)(ACT + (size_t)row * 1024 + lane * 16); d[0] = w0; d[1] = w1;
    };
    for (int row = blockIdx.x * 8 + wid; row < MT; row += 4 * nw) {
        u32x4 ra[4], rb[4], rc[4], rd[4];
        const int r1 = row + nw, r2 = row + 2 * nw, r3 = row + 3 * nw;
        if (r3 < MT) { ld_row(row, ra); ld_row(r1, rb); ld_row(r2, rc); ld_row(r3, rd); pin4x4x4x4(ra, rb, rc, rd); do_row(row, ra); do_row(r1, rb); do_row(r2, rc); do_row(r3, rd); }
        else { ld_row(row, ra); do_row(row, ra); if (r1 < MT) { ld_row(r1, rb); do_row(r1, rb); } if (r2 < MT) { ld_row(r2, rc); do_row(r2, rc); } }
    }
}

constexpr int AK = 0, AV = 73984;
struct AttnPre { u32x4 k[8]; u32x4 v[8]; bf16x8 q[4]; };
struct AttnIt { int g, b, h, r, j0, d, Sd; };
DI AttnIt attn_decode(int item) {
    AttnIt a; const int x = item & 15; a.h = (item >> 4) & 7; a.b = (item >> 7) & 7; a.g = item >> 10;
    const int dshift = a.g * 2; a.d = 1 << dshift; a.Sd = 2048 >> dshift; const int nqb = a.Sd >> 7;
    a.r = x / nqb; a.j0 = (x % nqb) * 128; return a;
}
DI void attn_issue(const Params& p, int item, AttnPre& pre) {
    const int tid = TID(), lane = tid & 63, wid = tid >> 6, r16 = lane & 15, fq = lane >> 4;
    const AttnIt a = attn_decode(item);
    const bf16_t* base = (const bf16_t*)(p.ws + WS_P1) + (size_t)a.b * 2048 * 10240 + a.g * 1024 + a.h * 128;
    const size_t rstride = (size_t)a.d * 10240;
    const bf16_t* kbase = base + (long)((a.j0 - 128) * a.d + a.r) * 10240;
    const int kg = tid >> 4, ec = tid & 15;
    if (a.j0 != 0) {
#pragma unroll
        for (int k = 0; k < 8; ++k) { const int idx = tid + 512 * k; pre.k[k] = *(const u32x4*)(kbase + (size_t)(idx >> 4) * rstride + 3072 + (idx & 15) * 8); }
#pragma unroll
        for (int i = 0; i < 8; ++i) pre.v[i] = *(const u32x4*)(kbase + (size_t)(kg * 8 + i) * rstride + 6144 + ec * 8);
    } else {
#pragma unroll
        for (int k = 0; k < 4; ++k) pre.k[k] = (u32x4){0u, 0u, 0u, 0u};
#pragma unroll
        for (int k = 4; k < 8; ++k) { const int idx = tid + 512 * k; pre.k[k] = *(const u32x4*)(kbase + (size_t)(idx >> 4) * rstride + 3072 + (idx & 15) * 8); }
#pragma unroll
        for (int i = 0; i < 8; ++i) { pre.v[i] = (u32x4){0u, 0u, 0u, 0u}; if (tid >= 256) pre.v[i] = *(const u32x4*)(kbase + (size_t)(kg * 8 + i) * rstride + 6144 + ec * 8); }
    }
    const int qtok = (a.j0 + 16 * wid + r16) * a.d + a.r;
#pragma unroll
    for (int ks = 0; ks < 4; ++ks) pre.q[ks] = *(const bf16x8*)(base + (size_t)qtok * 10240 + ks * 32 + fq * 8);
}
DI void st_f32x8_from_bf16(float* d, u32x4 w) {
    *(f32x4*)d = (f32x4){bflo(w.x), bfhi(w.x), bflo(w.y), bfhi(w.y)}; *(f32x4*)(d + 4) = (f32x4){bflo(w.z), bfhi(w.z), bflo(w.w), bfhi(w.w)};
}
DI void attn_commit(LAS unsigned char* lds, const AttnPre& pre, const Params& p, int item) {
    const int tid = TID();
    const AttnIt a = attn_decode(item);
#pragma unroll
    for (int k = 0; k < 8; ++k) { const int idx = tid + 512 * k; *(LAS u32x4*)(lds + AK + (idx >> 4) * 272 + (idx & 15) * 16) = pre.k[k]; }
    const int kg = tid >> 4, ec = tid & 15;
#pragma unroll
    for (int e2 = 0; e2 < 4; ++e2) {
        u32x4 lo, hi;
#pragma unroll
        for (int pq = 0; pq < 4; ++pq) { const unsigned x0 = pre.v[2 * pq][e2], x1 = pre.v[2 * pq + 1][e2]; lo[pq] = (x0 & 0xffffu) | (x1 << 16); hi[pq] = (x0 >> 16) | (x1 & 0xffff0000u); }
        *(LAS u32x4*)(lds + AV + (ec * 8 + 2 * e2) * 560 + kg * 16) = lo;
        *(LAS u32x4*)(lds + AV + (ec * 8 + 2 * e2 + 1) * 560 + kg * 16) = hi;
    }
}
DI void attn_compute(const Params& p, LAS unsigned char* lds, int item, const bf16x8 (&qf)[4]) {
    const int tid = TID(), lane = tid & 63, wid = tid >> 6, r16 = lane & 15, fq = lane >> 4;
    const AttnIt a = attn_decode(item);
    const int g = a.g, b = a.b, h = a.h;
    const int qj = a.j0 + 16 * wid + r16, qtok = qj * a.d + a.r;
    f32x4 s[10];
    const LAS unsigned char* kbase = lds + AK + (16 * wid + r16) * 272 + fq * 16;
#pragma unroll
    for (int T2 = 0; T2 < 5; ++T2) {
        bf16x8 kf[8];
#pragma unroll
        for (int u = 0; u < 8; ++u) { const int T = 2 * T2 + (u >> 2); kf[u] = lds_ld8(kbase + (T < 9 ? T : 8) * (16 * 272) + (u & 3) * 64); }
        pin8(kf);
#pragma unroll
        for (int u = 0; u < 8; ++u) { const int T = 2 * T2 + (u >> 2); if (T < 9) { if ((u & 3) == 0) s[T] = (f32x4){0.f, 0.f, 0.f, 0.f}; s[T] = mfma16(kf[u], qf[u & 3], s[T]); } }
    }
#pragma unroll
    for (int rr = 0; rr < 4; ++rr) {
        if (r16 - 4 * fq - rr > 0) s[0][rr] = -INFINITY;
        if (r16 - 4 * fq - rr < 0) s[8][rr] = -INFINITY;
    }
    if (a.j0 == 0) {
#pragma unroll
        for (int T = 0; T < 9; ++T)
#pragma unroll
            for (int rr = 0; rr < 4; ++rr) { const int rel = 128 + r16 - 16 * T - 4 * fq - rr; if (qj - rel < 0) s[T][rr] = -INFINITY; }
    }
    float m = -INFINITY;
#pragma unroll
    for (int T = 0; T < 9; ++T) m = fmaxf(m, fmaxf(fmaxf(s[T][0], s[T][1]), fmaxf(s[T][2], s[T][3])));
    m = fmaxf(m, __shfl_xor(m, 16)); m = fmaxf(m, __shfl_xor(m, 32));
    float l = 0.f;
#pragma unroll
    for (int T = 0; T < 9; ++T)
#pragma unroll
        for (int rr = 0; rr < 4; ++rr) { const float pv = __builtin_amdgcn_exp2f(s[T][rr] - m); s[T][rr] = pv; l += pv; }
    s[9] = (f32x4){0.f, 0.f, 0.f, 0.f};
    l += __shfl_xor(l, 16); l += __shfl_xor(l, 32);
    f32x4 o[8];
#pragma unroll
    for (int et = 0; et < 8; ++et) o[et] = (f32x4){0.f, 0.f, 0.f, 0.f};
    const LAS unsigned char* vbase = lds + AV + r16 * 560 + (16 * wid + 4 * fq) * 2;
#pragma unroll
    for (int tp = 0; tp < 5; ++tp) {
        u32x4 pb; pb.x = pk2(s[2 * tp][0], s[2 * tp][1]); pb.y = pk2(s[2 * tp][2], s[2 * tp][3]); pb.z = pk2(s[2 * tp + 1][0], s[2 * tp + 1][1]); pb.w = pk2(s[2 * tp + 1][2], s[2 * tp + 1][3]);
        const bf16x8 pf = __builtin_bit_cast(bf16x8, pb);
        u32x4 vv[8];
#pragma unroll
        for (int et = 0; et < 8; ++et) {
            const LAS unsigned char* vp = vbase + et * (16 * 560) + tp * 64;
            const u32x2 va = *(const LAS u32x2*)vp, vb = *(const LAS u32x2*)(vp + 32);
            vv[et] = (u32x4){va.x, va.y, vb.x, vb.y};
        }
        pin8(vv);
#pragma unroll
        for (int et = 0; et < 8; ++et) o[et] = mfma16(__builtin_bit_cast(bf16x8, vv[et]), pf, o[et]);
    }
    const float il = 1.f / l;
    const size_t orow = (size_t)b * 2048 + qtok;
    bf16_t* og = (bf16_t*)(p.ws + WS_OG) + ((size_t)g * MT + orow) * 1024 + h * 128;
#pragma unroll
    for (int et = 0; et < 8; ++et) { u32x2 w; w.x = pk2(o[et][0] * il, o[et][1] * il); w.y = pk2(o[et][2] * il, o[et][3] * il); *(u32x2*)(og + 16 * et + 4 * fq) = w; }
    if (fq == 0) ((float*)(p.ws + WS_LSE))[((size_t)g * MT + orow) * 8 + h] = 0.6931471805599453f * (m + log2f(l));
}
DI void attn_prompt_all(const Params& p, LAS unsigned char* lds) {
    const int tid = TID();
    lds_sync();
    if (tid < 256) *(LAS u32x4*)(lds + AK + (256 + (tid >> 4)) * 272 + (tid & 15) * 16) = (u32x4){0u, 0u, 0u, 0u};
    else { const int t2 = tid - 256; *(LAS u32x4*)(lds + AV + (t2 >> 1) * 560 + (256 + (t2 & 1) * 8) * 2) = (u32x4){0u, 0u, 0u, 0u}; }
    AttnPre pre;
    const int bid = blockIdx.x, G = gridDim.x, nround = G == 256 ? 12 : (3072 - bid + G - 1) / G;
    auto item_of = [&](int i) { return G == 256 ? ((i * 16 + (bid & 7) * 2 + (bid >> 7)) * 16 + ((bid >> 3) & 15)) : bid + i * G; };
    if (nround > 0) attn_issue(p, item_of(0), pre);
    for (int i = 0; i < nround; ++i) {
        const int it = item_of(i);
        lds_sync();
        attn_commit(lds, pre, p, it);
        bf16x8 qf[4];
#pragma unroll
        for (int ks = 0; ks < 4; ++ks) qf[ks] = pre.q[ks];
        if (i + 1 < nround) attn_issue(p, item_of(i + 1), pre);
        lds_sync();
        attn_compute(p, lds, it, qf);
    }
    lds_sync();
}
DI void attn_sample_item(const Params& p, LAS unsigned char* lds, int witem) {
    const int lane = TID() & 63, wid = TID() >> 6;
    const int h = witem & 7, l = (witem >> 3) & 7, bg = witem >> 6, g = bg % 3, b = bg / 3;
    const int d = 1 << (2 * g), Lbuf = 128 << (2 * g);
    const float* cache = p.in[I_C128 + g] + (size_t)b * Lbuf * 2048;
    const float* fresh = p.out + (g == 0 ? O_KVS0 : (g == 1 ? O_KVS1 : O_KVS2)) + (size_t)b * 8 * 2048;
    const int row = MP + b * 8 + l;
    const bf16_t* qp = (const bf16_t*)(p.ws + WS_P1) + (size_t)row * 10240 + g * 1024 + h * 128;
    LAS float* sc = (LAS float*)lds + wid * 136;
    const int sub = lane & 15, kq = lane >> 4;
    float q[8];
    { const u32x2 a = *(const u32x2*)(qp + sub * 4), c = *(const u32x2*)(qp + 64 + sub * 4);
      q[0] = bflo(a.x); q[1] = bfhi(a.x); q[2] = bflo(a.y); q[3] = bfhi(a.y); q[4] = bflo(c.x); q[5] = bfhi(c.x); q[6] = bflo(c.y); q[7] = bfhi(c.y); }
#pragma unroll 1
    for (int bt = 0; bt < 4; ++bt) {
        f32x4 ka[8], kb[8];
#pragma unroll
        for (int u = 0; u < 8; ++u) {
            const int mk = (bt * 8 + u) * 4 + kq, idx = Lbuf + l - d * mk;
            const float* kr = (idx >= Lbuf ? fresh + (size_t)(idx - Lbuf) * 2048 : cache + (size_t)idx * 2048) + h * 128 + sub * 4;
            ka[u] = *(const f32x4*)kr; kb[u] = *(const f32x4*)(kr + 64);
        }
        asm volatile("" ::: "memory");
        float dots[8];
#pragma unroll
        for (int u = 0; u < 8; ++u) dots[u] = q[0] * ka[u][0] + q[1] * ka[u][1] + q[2] * ka[u][2] + q[3] * ka[u][3] + q[4] * kb[u][0] + q[5] * kb[u][1] + q[6] * kb[u][2] + q[7] * kb[u][3];
#pragma unroll
        for (int u = 0; u < 8; ++u) dots[u] = row16_sum(dots[u]);
#pragma unroll
        for (int u = 0; u < 8; ++u) sc[(bt * 8 + u) * 4 + kq] = dots[u];
    }
    {
        const int idx = Lbuf + l - d * 128;
        const float* kr = cache + (size_t)idx * 2048 + h * 128 + sub * 4;
        const f32x4 k0 = *(const f32x4*)kr, k1 = *(const f32x4*)(kr + 64);
        float dot = q[0] * k0[0] + q[1] * k0[1] + q[2] * k0[2] + q[3] * k0[3] + q[4] * k1[0] + q[5] * k1[1] + q[6] * k1[2] + q[7] * k1[3];
        dot = row16_sum(dot);
        sc[128 + kq] = dot;
    }
    __builtin_amdgcn_s_waitcnt(0xc07f);
    __builtin_amdgcn_wave_barrier();
    const float s0 = sc[lane], s1 = sc[64 + lane], s2 = lane == 0 ? sc[128] : -INFINITY;
    const float m = wave_max(fmaxf(fmaxf(s0, s1), s2));
    const float p0 = exp2f(s0 - m), p1 = exp2f(s1 - m), p2 = lane == 0 ? exp2f(s2 - m) : 0.f;
    const float lsum = wave_sum(p0 + p1 + p2);
    __builtin_amdgcn_wave_barrier();
    sc[lane] = p0; sc[64 + lane] = p1; if (lane == 0) sc[128] = p2;
    __builtin_amdgcn_s_waitcnt(0xc07f);
    __builtin_amdgcn_wave_barrier();
    const int half = lane >> 5, l32 = lane & 31;
    f32x4 o = {0.f, 0.f, 0.f, 0.f};
#pragma unroll 1
    for (int bt = 0; bt < 8; ++bt) {
        f32x4 vb[8]; float pw[8];
#pragma unroll
        for (int u = 0; u < 8; ++u) {
            const int mk = 2 * (bt * 8 + u) + half, idx = Lbuf + l - d * mk;
            const float* vr = (idx >= Lbuf ? fresh + (size_t)(idx - Lbuf) * 2048 : cache + (size_t)idx * 2048) + 1024 + h * 128 + l32 * 4;
            vb[u] = *(const f32x4*)vr; pw[u] = sc[mk];
        }
        asm volatile("" ::: "memory");
#pragma unroll
        for (int u = 0; u < 8; ++u) o += pw[u] * vb[u];
    }
    { const int idx = Lbuf + l - d * 128;
      const f32x4 v = *(const f32x4*)(cache + (size_t)idx * 2048 + 1024 + h * 128 + l32 * 4); const float pw = half ? 0.f : sc[128];
      o += pw * v; }
    o[0] += __shfl_xor(o[0], 32); o[1] += __shfl_xor(o[1], 32); o[2] += __shfl_xor(o[2], 32); o[3] += __shfl_xor(o[3], 32);
    const float il = 1.f / lsum;
    if (half == 0) { u32x2 w; w.x = pk2(o[0] * il, o[1] * il); w.y = pk2(o[2] * il, o[3] * il);
        *(u32x2*)((bf16_t*)(p.ws + WS_OG) + ((size_t)g * MT + row) * 1024 + h * 128 + l32 * 4) = w; }
    if (lane == 0) ((float*)(p.ws + WS_LSE))[((size_t)g * MT + row) * 8 + h] = 0.6931471805599453f * (m + log2f(lsum));
    __builtin_amdgcn_wave_barrier();
}
DI void attn_sample_all(const Params& p, LAS unsigned char* lds) {
    const int bid = blockIdx.x, G = gridDim.x, wv = TID() >> 6;
    if (G == 256) { for (int i = 0; i < 3; ++i) { const int bg = i * 32 + (bid & 7) * 4 + (bid >> 6), l = (bid >> 3) & 7; attn_sample_item(p, lds, (bg * 8 + l) * 8 + wv); } }
    else for (int it = bid; it < 768; it += G) attn_sample_item(p, lds, it * 8 + wv);
}
DI void phase_attn(const Params& p, LAS unsigned char* lds) {
    if (blockIdx.x & 1) { attn_sample_all(p, lds); __syncthreads(); }
    attn_prompt_all(p, lds);
    if (!(blockIdx.x & 1)) attn_sample_all(p, lds);
}

DI void phase_gate1(const Params& p) {
    const int lane = TID() & 63, wid = TID() >> 6;
    const bf16_t* OG = (const bf16_t*)(p.ws + WS_OG); const bf16_t* P1 = (const bf16_t*)(p.ws + WS_P1); const float* LSE = (const float*)(p.ws + WS_LSE);
    bf16_t* ACT = (bf16_t*)(p.ws + WS_ACT);
    const int nw = gridDim.x * 8, hd = lane >> 3;
    auto ld_row = [&](int row, u32x4 (&r)[8], float (&ls)[3]) {
#pragma unroll
        for (int g = 0; g < 3; ++g) { const u32x4* so = (const u32x4*)(OG + ((size_t)g * MT + row) * 1024 + lane * 16); r[2 * g] = so[0]; r[2 * g + 1] = so[1]; ls[g] = LSE[((size_t)g * MT + row) * 8 + hd]; }
        const u32x4* sz = (const u32x4*)(P1 + (size_t)row * 10240 + 9216 + lane * 16); r[6] = sz[0]; r[7] = sz[1];
    };
    auto do_row = [&](int row, const u32x4 (&r)[8], const float (&ls)[3]) {
        const float mx = fmaxf(ls[0], fmaxf(ls[1], ls[2]));
        float w[3] = {__expf(ls[0] - mx), __expf(ls[1] - mx), __expf(ls[2] - mx)};
        const float iw = 1.f / (w[0] + w[1] + w[2]);
        float acc[16];
#pragma unroll
        for (int j = 0; j < 16; ++j) acc[j] = 0.f;
#pragma unroll
        for (int g = 0; g < 3; ++g) {
            const float wg = w[g] * iw;
#pragma unroll
            for (int q = 0; q < 2; ++q) { const u32x4 a = r[2 * g + q];
                acc[q * 8] += wg * bflo(a.x); acc[q * 8 + 1] += wg * bfhi(a.x); acc[q * 8 + 2] += wg * bflo(a.y); acc[q * 8 + 3] += wg * bfhi(a.y);
                acc[q * 8 + 4] += wg * bflo(a.z); acc[q * 8 + 5] += wg * bfhi(a.z); acc[q * 8 + 6] += wg * bflo(a.w); acc[q * 8 + 7] += wg * bfhi(a.w); }
        }
        float z[16];
#pragma unroll
        for (int q = 0; q < 2; ++q) { const u32x4 b = r[6 + q];
            z[q * 8] = bflo(b.x); z[q * 8 + 1] = bfhi(b.x); z[q * 8 + 2] = bflo(b.y); z[q * 8 + 3] = bfhi(b.y); z[q * 8 + 4] = bflo(b.z); z[q * 8 + 5] = bfhi(b.z); z[q * 8 + 6] = bflo(b.w); z[q * 8 + 7] = bfhi(b.w); }
        float rr[16];
#pragma unroll
        for (int j = 0; j < 16; ++j) rr[j] = acc[j] * siluf(z[j]);
        u32x4 w0, w1;
        w0.x = pk2(rr[0], rr[1]); w0.y = pk2(rr[2], rr[3]); w0.z = pk2(rr[4], rr[5]); w0.w = pk2(rr[6], rr[7]);
        w1.x = pk2(rr[8], rr[9]); w1.y = pk2(rr[10], rr[11]); w1.z = pk2(rr[12], rr[13]); w1.w = pk2(rr[14], rr[15]);
        u32x4* d = (u32x4*)(ACT + (size_t)row * 1024 + lane * 16); d[0] = w0; d[1] = w1;
    };
    for (int row = blockIdx.x * 8 + wid; row < MT; row += 2 * nw) {
        u32x4 ra[8], rb[8]; float la[3], lb[3];
        const int rowb = row + nw;
        ld_row(row, ra, la);
        if (rowb < MT) { ld_row(rowb, rb, lb); pin8x8(ra, rb); }
        do_row(row, ra, la);
        if (rowb < MT) do_row(rowb, rb, lb);
    }
}

DI void phase_final(const Params& p) {
    const int lane = TID() & 63, wid = TID() >> 6;
    const float* fg = p.in[I_FNG];
    const int nw = gridDim.x * 8;
    auto ld_row = [&](int row, f32x4 (&v)[4]) {
        const float* x = p.out + (size_t)row * 1024;
#pragma unroll
        for (int i = 0; i < 4; ++i) v[i] = *(const f32x4*)(x + lane * 4 + 256 * i);
    };
    f32x4 gg[4];
#pragma unroll
    for (int i = 0; i < 4; ++i) gg[i] = *(const f32x4*)(fg + lane * 4 + 256 * i);
    auto do_row = [&](int row, const f32x4 (&v)[4]) {
        float* x = p.out + (size_t)row * 1024;
        float ss = 0.f;
#pragma unroll
        for (int i = 0; i < 4; ++i) ss += v[i][0] * v[i][0] + v[i][1] * v[i][1] + v[i][2] * v[i][2] + v[i][3] * v[i][3];
        ss = wave_sum(ss);
        const float rstd = rsqrtf(ss * (1.f / 1024.f) + EPS);
#pragma unroll
        for (int i = 0; i < 4; ++i) *(f32x4*)(x + lane * 4 + 256 * i) = v[i] * rstd * gg[i];
    };
    for (int row = blockIdx.x * 8 + wid; row < MT; row += 4 * nw) {
        f32x4 va[4], vb[4], vc[4], vd[4];
        const int r1 = row + nw, r2 = row + 2 * nw, r3 = row + 3 * nw;
        if (r3 < MT) { ld_row(row, va); ld_row(r1, vb); ld_row(r2, vc); ld_row(r3, vd); pin4x4x4x4(va, vb, vc, vd); do_row(row, va); do_row(r1, vb); do_row(r2, vc); do_row(r3, vd); }
        else { ld_row(row, va); do_row(row, va); if (r1 < MT) { ld_row(r1, vb); do_row(r1, vb); } if (r2 < MT) { ld_row(r2, vc); do_row(r2, vc); } }
    }
}

#define XB_TMO      128
#define XB_XCNT(j)  (256  + 64 * (j))
#define XB_XSUB(j)  (1280 + 64 * (j))
#define XB_XGEN(j)  (2304 + 64 * (j))
#define XB_TOP      3328
#define XB_TOPGEN   3392
#define XCD_BAR_WORDS 3456
#define XB_SPIN_CAP (1u << 20)
DI unsigned xb_ld(unsigned* p)              { return __hip_atomic_load(p, __ATOMIC_RELAXED, __HIP_MEMORY_SCOPE_AGENT); }
DI unsigned xb_add(unsigned* p, unsigned v) { return __hip_atomic_fetch_add(p, v, __ATOMIC_RELAXED, __HIP_MEMORY_SCOPE_AGENT); }
DI unsigned xb_xcc_id() { return (unsigned)__builtin_amdgcn_s_getreg((3 << 11) | 20) & 0xFu; }
#define XB_SPIN(cond, bar) do { unsigned _sp = 0; while (cond) { __builtin_amdgcn_s_sleep(1); \
    if ((++_sp & 255u) == 0u) { if (xb_ld(&(bar)[XB_TMO])) break; if (_sp > XB_SPIN_CAP) { atomicAdd(&(bar)[XB_TMO], 1u); break; } } } } while (0)
struct XcdBarrier { unsigned* bar; unsigned x; volatile LAS unsigned* st; };
DI XcdBarrier xcd_barrier_post(unsigned* bar, volatile LAS unsigned* st) {
    XcdBarrier b; b.bar = bar; b.x = xb_xcc_id(); b.st = st;
    if (threadIdx.x == 0) (void)xb_add(&bar[XB_XCNT(b.x)], 1u);
    return b;
}
DI void xcd_barrier_complete(unsigned* bar, unsigned x, unsigned& nloc, unsigned& nx) {
    const unsigned G = gridDim.x * gridDim.y * gridDim.z;
    unsigned sum, cnt, mine, sp = 0u;
    for (;;) {
        sum = 0u; cnt = 0u; mine = 0u;
#pragma unroll
        for (unsigned j = 0; j < 16; ++j) { const unsigned c = xb_ld(&bar[XB_XCNT(j)]); sum += c; cnt += (c > 0u) ? 1u : 0u; mine = (j == x) ? c : mine; }
        if (sum == G) break;
        __builtin_amdgcn_s_sleep(1);
        if ((++sp & 255u) == 0u) { if (xb_ld(&bar[XB_TMO])) break; if (sp > XB_SPIN_CAP) { atomicAdd(&bar[XB_TMO], 1u); break; } }
    }
    nloc = mine > 0u ? mine : 1u; nx = cnt > 0u ? cnt : 1u;
}
DI void xcd_barrier(const XcdBarrier& b) {
    asm volatile("s_waitcnt vmcnt(0)" ::: "memory");
    __syncthreads();
    if (threadIdx.x == 0) {
        unsigned* bar = b.bar;
        __builtin_amdgcn_s_waitcnt(0);
        unsigned nloc = b.st[0], nx = b.st[1];
        if (nloc == 0u) { xcd_barrier_complete(bar, b.x, nloc, nx); b.st[0] = nloc; b.st[1] = nx; }
        const unsigned old = xb_add(&bar[XB_XSUB(b.x)], 1u);
        const unsigned gen = old / nloc;
        if (old + 1u == (gen + 1u) * nloc) {
            __builtin_amdgcn_fence(__ATOMIC_RELEASE, "agent");
            asm volatile("s_waitcnt vmcnt(0)" ::: "memory");
            const unsigned og = xb_add(&bar[XB_TOP], 1u);
            const unsigned tg = og / nx;
            if (og + 1u == (tg + 1u) * nx) xb_add(&bar[XB_TOPGEN], 1u);
            else XB_SPIN(xb_ld(&bar[XB_TOPGEN]) == tg, bar);
            __builtin_amdgcn_fence(__ATOMIC_ACQUIRE, "agent");
            xb_add(&bar[XB_XGEN(b.x)], 1u);
            asm volatile("s_waitcnt vmcnt(0)" ::: "memory");
        } else {
            XB_SPIN(xb_ld(&bar[XB_XGEN(b.x)]) == gen, bar);
            __builtin_amdgcn_fence(__ATOMIC_ACQUIRE, "agent");
            asm volatile("s_waitcnt vmcnt(0)" ::: "memory");
        }
    }
    __syncthreads();
}

#ifndef EXTRA_SYNCS
#define EXTRA_SYNCS 0
#endif

#ifndef DUP_MASK
#define DUP_MASK 0u
#endif
__global__ void __launch_bounds__(512, 2) hybrid_fwd(Params p) {
    extern __shared__ __attribute__((aligned(16))) unsigned char shm[];
    LAS unsigned char* lds = (LAS unsigned char*)shm;
    cg::grid_group grid = cg::this_grid();
    const float* MOD = (const float*)(p.ws + WS_MOD);
    bf16_t* ACT = (bf16_t*)(p.ws + WS_ACT);
    bf16_t* X1 = (bf16_t*)(p.ws + WS_X1);
    if (p.ws == nullptr) grid.sync();
    volatile LAS unsigned* xst = (volatile LAS unsigned*)(lds + LDS_BYTES - 16);
    if (threadIdx.x == 0) { xst[0] = 0u; xst[1] = 0u; }
    __syncthreads();
    const XcdBarrier xb = xcd_barrier_post((unsigned*)(p.ws + WS_BAR), xst);

    for (int rep = 0; rep < EXTRA_SYNCS; ++rep) xcd_barrier(xb);
    for (int rep = 0; rep < 1 + (int)((DUP_MASK >> 0) & 1u); ++rep) {
    phase_prep(p, lds);
    xcd_barrier(xb);
    }
    for (int rep = 0; rep < 1 + (int)((DUP_MASK >> 1) & 1u); ++rep) {
    phase_norm<true>(p, lds, p.in[I_XP], p.in[I_XS], 0);
    xcd_barrier(xb);
    }
    for (int rep = 0; rep < 1 + (int)((DUP_MASK >> 2) & 1u); ++rep) {
    { EpiA e{(bf16_t*)(p.ws + WS_P0), p.out}; gemm_all(lds, ACT, (const bf16_t*)(p.ws + WS_WTA), 4096, e); }
    xcd_barrier(xb);
    }
    for (int rep = 0; rep < 1 + (int)((DUP_MASK >> 3) & 1u); ++rep) {
    phase_dprep(p, lds);
    xcd_barrier(xb);
    }
    for (int rep = 0; rep < 1 + (int)((DUP_MASK >> 4) & 1u); ++rep) {
    phase_scan(p, lds);
    xcd_barrier(xb);
    }
    for (int rep = 0; rep < 1 + (int)((DUP_MASK >> 5) & 1u); ++rep) {
    phase_gate0(p);
    xcd_barrier(xb);
    }
    for (int rep = 0; rep < 1 + (int)((DUP_MASK >> 6) & 1u); ++rep) {
    { EpiRes<float, bf16_t> e{p.in[I_XP], p.in[I_XS], MOD, X1}; gemm_all(lds, ACT, (const bf16_t*)(p.ws + WS_WTAO), 1024, e); }
    xcd_barrier(xb);
    }
    for (int rep = 0; rep < 1 + (int)((DUP_MASK >> 7) & 1u); ++rep) {
    phase_norm1(p);
    xcd_barrier(xb);
    }
    for (int rep = 0; rep < 1 + (int)((DUP_MASK >> 8) & 1u); ++rep) {
    { EpiB e{(bf16_t*)(p.ws + WS_P1), p.out}; gemm_all(lds, ACT, (const bf16_t*)(p.ws + WS_WTB), 10240, e); }
    xcd_barrier(xb);
    }
    for (int rep = 0; rep < 1 + (int)((DUP_MASK >> 9) & 1u); ++rep) {
    phase_attn(p, lds);
    xcd_barrier(xb);
    }
    for (int rep = 0; rep < 1 + (int)((DUP_MASK >> 10) & 1u); ++rep) {
    phase_gate1(p);
    xcd_barrier(xb);
    }
    for (int rep = 0; rep < 1 + (int)((DUP_MASK >> 11) & 1u); ++rep) {
    { EpiRes<bf16_t, float> e{X1, X1 + (size_t)MP * 1024, MOD + 40 * 3072, p.out}; gemm_all(lds, ACT, (const bf16_t*)(p.ws + WS_WTBO), 1024, e); }
    xcd_barrier(xb);
    }
    phase_final(p);
}

extern "C" void kernel_launch(void* const* d_in, const int* in_sizes, int n_in, void* d_out, int out_size, void* d_ws, size_t ws_size, hipStream_t stream) {
    static int grid_blocks = 0;
    if (!grid_blocks) {
        if (n_in != 21 || ws_size < WS_END) { fprintf(stderr, "kernel_launch: unexpected inputs (n_in %d, ws %zu < %zu)\n", n_in, ws_size, (size_t)WS_END); grid_blocks = -1; return; }
        int dev = 0, cus = 0, per_cu = 0;
        hipGetDevice(&dev);
        hipDeviceGetAttribute(&cus, hipDeviceAttributeMultiprocessorCount, dev);
        if (hipFuncSetAttribute((const void*)hybrid_fwd, hipFuncAttributeMaxDynamicSharedMemorySize, LDS_BYTES) != hipSuccess) { fprintf(stderr, "kernel_launch: hipFuncSetAttribute failed\n"); }
        hipOccupancyMaxActiveBlocksPerMultiprocessor(&per_cu, (const void*)hybrid_fwd, 512, LDS_BYTES);
        per_cu = 1;
        grid_blocks = cus * per_cu;
    }
    if (grid_blocks < 0) return;
    Params p{};
    for (int i = 0; i < 21; ++i) p.in[i] = (const float*)d_in[i];
    p.out = (float*)d_out; p.ws = (unsigned char*)d_ws;
    if (hipMemsetAsync((unsigned char*)d_ws + WS_BAR, 0, XCD_BAR_WORDS * 4, stream) != hipSuccess) { fprintf(stderr, "kernel_launch: memset of barrier words failed\n"); return; }
    void* args[] = {&p};
    hipError_t e = hipLaunchCooperativeKernel((const void*)hybrid_fwd, dim3(grid_blocks), dim3(512), args, LDS_BYTES, stream);
    if (e != hipSuccess) fprintf(stderr, "cooperative launch failed: %s (grid %d)\n", hipGetErrorString(e), grid_blocks);
}
```

```cpp
#include <hip/hip_runtime.h>
#include <hip/hip_cooperative_groups.h>
#include <cstdio>
namespace cg = cooperative_groups;

#define LAS __attribute__((address_space(3)))
#define DI __device__ __forceinline__
typedef unsigned short bf16_t;
typedef short bf16x8 __attribute__((ext_vector_type(8)));
typedef short s16x4 __attribute__((ext_vector_type(4)));
typedef float f32x4 __attribute__((ext_vector_type(4)));
typedef float f32x2 __attribute__((ext_vector_type(2)));
typedef unsigned u32x4 __attribute__((ext_vector_type(4)));
typedef unsigned u32x2 __attribute__((ext_vector_type(2)));
typedef __bf16 bf16x2_t __attribute__((ext_vector_type(2)));

constexpr int DM = 1024, MP = 16384, MS = 256, MT = MP + MS;
constexpr int NCH = 2048 + 256;
constexpr float EPS = 1e-6f;
constexpr float QSCALE = 0.08838834764831845f * 1.4426950408889634f;
constexpr int LDS_BYTES = 151552;

constexpr size_t WS_WTA  = 0;
constexpr size_t WS_WTAO = WS_WTA  + (size_t)4096 * 1024 * 2;
constexpr size_t WS_WTB  = WS_WTAO + (size_t)1024 * 1024 * 2;
constexpr size_t WS_WTBO = WS_WTB  + (size_t)10240 * 1024 * 2;
constexpr size_t WS_MOD  = WS_WTBO + (size_t)1024 * 1024 * 2;
constexpr size_t WS_ACT  = WS_MOD  + (size_t)2 * 40 * 3072 * 4;
constexpr size_t WS_P0   = WS_ACT  + (size_t)MT * 1024 * 2;
constexpr size_t WS_GB   = WS_P0   + (size_t)MT * 4096 * 2;
constexpr size_t WS_WV   = WS_GB   + (size_t)MT * 16 * 4;
constexpr size_t WS_KC   = WS_WV   + (size_t)NCH * 8192 * 2;
constexpr size_t WS_QD   = WS_KC   + (size_t)NCH * 8192 * 2;
constexpr size_t WS_KDT  = WS_QD   + (size_t)NCH * 8192 * 2;
constexpr size_t WS_QK   = WS_KDT  + (size_t)NCH * 8192 * 2;
constexpr size_t WS_GT   = WS_QK   + (size_t)NCH * 4096 * 2;
constexpr size_t WS_O0   = WS_GT   + (size_t)NCH * 4;
constexpr size_t WS_X1   = WS_O0   + (size_t)MT * 1024 * 2;
constexpr size_t WS_P1   = WS_X1   + (size_t)MT * 1024 * 4;
constexpr size_t WS_OG   = WS_P0;
constexpr size_t WS_LSE  = WS_P1   + (size_t)MT * 10240 * 2;
constexpr size_t WS_BAR  = WS_LSE  + (size_t)3 * MT * 8 * 4;
constexpr size_t WS_END  = WS_BAR  + 16384;

constexpr size_t O_YP   = 0;
constexpr size_t O_YS   = O_YP + (size_t)MP * 1024;
constexpr size_t O_DP   = O_YS + (size_t)MS * 1024;
constexpr size_t O_DS   = O_DP + (size_t)8 * 8 * 128 * 128;
constexpr size_t O_CP   = O_DS + (size_t)32 * 8 * 128 * 128;
constexpr size_t O_CS   = O_CP + (size_t)8 * 3 * 3072;
constexpr size_t O_KVP0 = O_CS + (size_t)32 * 3 * 3072;
constexpr size_t O_KVS0 = O_KVP0 + (size_t)8 * 128 * 2048;
constexpr size_t O_KVP1 = O_KVS0 + (size_t)32 * 8 * 2048;
constexpr size_t O_KVS1 = O_KVP1 + (size_t)8 * 512 * 2048;
constexpr size_t O_KVP2 = O_KVS1 + (size_t)32 * 8 * 2048;
constexpr size_t O_KVS2 = O_KVP2 + (size_t)8 * 2048 * 2048;

struct Params { const float* in[21]; float* out; unsigned char* ws; };
enum { I_XP = 0, I_XS, I_SD, I_SC, I_C128, I_C512, I_C2048, I_CP, I_CS, I_NG, I_ADAW, I_ADAB, I_AWIN, I_ACONV, I_ALOG, I_ADT, I_AOG, I_AWOUT, I_BWIN, I_BWOUT, I_FNG };

DI int TID() { int t = (int)threadIdx.x; asm volatile("" : "+v"(t)); return t; }
DI unsigned pk2(float a, float b) { f32x2 v = {a, b}; bf16x2_t r = __builtin_convertvector(v, bf16x2_t); return __builtin_bit_cast(unsigned, r); }
DI float bflo(unsigned u) { return __uint_as_float(u << 16); }
DI float bfhi(unsigned u) { return __uint_as_float(u & 0xffff0000u); }

DI float wave_max(float v) { for (int o = 32; o > 0; o >>= 1) v = fmaxf(v, __shfl_xor(v, o)); return v; }
template <int CTRL> DI float dpp_f(float v) { return __builtin_bit_cast(float, __builtin_amdgcn_update_dpp(0, __builtin_bit_cast(int, v), CTRL, 0xf, 0xf, true)); }
DI float row16_sum(float v) { v += dpp_f<0xB1>(v); v += dpp_f<0x4E>(v); v += dpp_f<0x141>(v); v += dpp_f<0x140>(v); return v; }
DI float wave_sum(float v) {
    v = row16_sum(v);
    const int iv = __builtin_bit_cast(int, v);
    const float r0 = __builtin_bit_cast(float, __builtin_amdgcn_readlane(iv, 0)), r1 = __builtin_bit_cast(float, __builtin_amdgcn_readlane(iv, 16));
    const float r2 = __builtin_bit_cast(float, __builtin_amdgcn_readlane(iv, 32)), r3 = __builtin_bit_cast(float, __builtin_amdgcn_readlane(iv, 48));
    return (r0 + r1) + (r2 + r3);
}
DI float siluf(float x) { return x * __builtin_amdgcn_rcpf(1.f + __expf(-x)); }
DI int batch_of(int row) { return row < MP ? (row >> 11) : 8 + ((row - MP) >> 3); }
DI f32x4 mfma16(bf16x8 a, bf16x8 b, f32x4 c) { return __builtin_amdgcn_mfma_f32_16x16x32_bf16(a, b, c, 0, 0, 0); }
DI void lds_sync() { asm volatile("s_waitcnt lgkmcnt(0)" ::: "memory"); __builtin_amdgcn_s_barrier(); asm volatile("" ::: "memory"); }
DI bf16x8 lds_ld8(const LAS unsigned char* p) { return *(const LAS bf16x8*)p; }


DI void pin16x2(float (&a)[16], float (&b)[16]) {
    f32x4 p0 = {a[0], a[1], a[2], a[3]}, p1 = {a[4], a[5], a[6], a[7]}, p2 = {a[8], a[9], a[10], a[11]}, p3 = {a[12], a[13], a[14], a[15]};
    f32x4 q0 = {b[0], b[1], b[2], b[3]}, q1 = {b[4], b[5], b[6], b[7]}, q2 = {b[8], b[9], b[10], b[11]}, q3 = {b[12], b[13], b[14], b[15]};
    asm volatile("" : "+v"(p0), "+v"(p1), "+v"(p2), "+v"(p3), "+v"(q0), "+v"(q1), "+v"(q2), "+v"(q3));
#pragma unroll
    for (int j = 0; j < 4; ++j) { a[j] = p0[j]; a[4 + j] = p1[j]; a[8 + j] = p2[j]; a[12 + j] = p3[j]; b[j] = q0[j]; b[4 + j] = q1[j]; b[8 + j] = q2[j]; b[12 + j] = q3[j]; }
}
DI void pin16x4(float (&a)[16], float (&b)[16], float (&c)[16], float (&d)[16]) {
    f32x4 p[16];
#pragma unroll
    for (int j = 0; j < 4; ++j) { p[j] = (f32x4){a[4 * j], a[4 * j + 1], a[4 * j + 2], a[4 * j + 3]}; p[4 + j] = (f32x4){b[4 * j], b[4 * j + 1], b[4 * j + 2], b[4 * j + 3]};
                                  p[8 + j] = (f32x4){c[4 * j], c[4 * j + 1], c[4 * j + 2], c[4 * j + 3]}; p[12 + j] = (f32x4){d[4 * j], d[4 * j + 1], d[4 * j + 2], d[4 * j + 3]}; }
    asm volatile("" : "+v"(p[0]), "+v"(p[1]), "+v"(p[2]), "+v"(p[3]), "+v"(p[4]), "+v"(p[5]), "+v"(p[6]), "+v"(p[7]), "+v"(p[8]), "+v"(p[9]), "+v"(p[10]), "+v"(p[11]), "+v"(p[12]), "+v"(p[13]), "+v"(p[14]), "+v"(p[15]));
#pragma unroll
    for (int j = 0; j < 4; ++j)
#pragma unroll
        for (int e = 0; e < 4; ++e) { a[4 * j + e] = p[j][e]; b[4 * j + e] = p[4 + j][e]; c[4 * j + e] = p[8 + j][e]; d[4 * j + e] = p[12 + j][e]; }
}
template <class T> DI void pin4x4x4x4(T (&a)[4], T (&b)[4], T (&c)[4], T (&d)[4]) {
    asm volatile("" : "+v"(a[0]), "+v"(a[1]), "+v"(a[2]), "+v"(a[3]), "+v"(b[0]), "+v"(b[1]), "+v"(b[2]), "+v"(b[3]), "+v"(c[0]), "+v"(c[1]), "+v"(c[2]), "+v"(c[3]), "+v"(d[0]), "+v"(d[1]), "+v"(d[2]), "+v"(d[3]));
}
template <class T> DI void pin4(T (&a)[4]) { asm volatile("" : "+v"(a[0]), "+v"(a[1]), "+v"(a[2]), "+v"(a[3])); }
template <class T> DI void pin8(T (&a)[8]) { asm volatile("" : "+v"(a[0]), "+v"(a[1]), "+v"(a[2]), "+v"(a[3]), "+v"(a[4]), "+v"(a[5]), "+v"(a[6]), "+v"(a[7])); }
template <class T, class U> DI void pin4x4(T (&a)[4], U (&b)[4]) { asm volatile("" : "+v"(a[0]), "+v"(a[1]), "+v"(a[2]), "+v"(a[3]), "+v"(b[0]), "+v"(b[1]), "+v"(b[2]), "+v"(b[3])); }
template <class T, class U> DI void pin8x8(T (&a)[8], U (&b)[8]) { asm volatile("" : "+v"(a[0]), "+v"(a[1]), "+v"(a[2]), "+v"(a[3]), "+v"(a[4]), "+v"(a[5]), "+v"(a[6]), "+v"(a[7]),
                                                                                      "+v"(b[0]), "+v"(b[1]), "+v"(b[2]), "+v"(b[3]), "+v"(b[4]), "+v"(b[5]), "+v"(b[6]), "+v"(b[7])); }

namespace pg8 {
constexpr int BM = 256, BK = 64, HALF = 128, HTB = HALF * BK * 2, STAGE_BYTES = 8 * HTB, NXCD = 8, WGM = 8;
DI int lds_byte(int r, int c) { const int st = (r >> 4) * 2 + (c >> 5), rr = r & 15, cc = c & 31, ob = rr * 64 + cc * 2; return st * 1024 + (ob ^ (((ob >> 9) & 1) << 5)); }
DI void stage_rc(int b, int& R, int& C) { const int st = b / 1024, sb = b % 1024, swz = sb ^ (((sb >> 9) & 1) << 5); R = (st >> 1) * 16 + swz / 64; C = (st & 1) * 32 + (swz % 64) / 2; }
DI int perm32(int rho) { const int n = rho >> 4, i = rho & 15; return 8 * (i >> 2) + 4 * n + (i & 3); }
struct Unit { int pm, pn; };
struct Gemm { const bf16_t* A; const bf16_t* Bt; int M, N, K; };
struct StaticOrder {
    int nM, nN, nwg, G, c;
    DI void init(int M, int N, int G_, int c_) { nM = M / BM; nN = N / BM; nwg = nM * nN; G = G_; c = c_; }
    DI bool next(int i, Unit& u) const {
        const long L = (long)i * G + c; if (L >= nwg) return false;
        int wgid = (int)L; { const int q = nwg / NXCD, r = nwg % NXCD, xcd = wgid % NXCD, off = wgid / NXCD; wgid = (xcd < r ? xcd * (q + 1) : r * (q + 1) + (xcd - r) * q) + off; }
        const int nig = WGM * nN, gid = wgid / nig, fm = gid * WGM, gsz = (nM - fm) < WGM ? (nM - fm) : WGM;
        u.pm = fm + ((wgid % nig) % gsz); u.pn = (wgid % nig) / gsz; return true;
    }
};

template <class Epi>
DI void gemm_phase(LAS unsigned char* lds, const Gemm g, const StaticOrder& S, const Epi& E) {
    const int tid = TID(), wid = __builtin_amdgcn_readfirstlane(tid >> 6), lane = tid & 63, wr = wid >> 2, wc = wid & 3, fr = lane & 15, fq = lane >> 4;
    const int K = g.K, nt = K / BK;
    unsigned voffA[2], voffB[2];
#pragma unroll
    for (int i = 0; i < 2; ++i) { int R, C; stage_rc(tid * 16 + i * 8192, R, C); const int Rb = (R & ~31) + perm32(R & 31);
        voffA[i] = (unsigned)(R * K + C) * 2u; voffB[i] = (unsigned)(Rb * K + C) * 2u; }
    const size_t kstep = (size_t)(BK * 2);
    const size_t hstep = (size_t)HALF * K * 2;
    const size_t tstep = 2 * hstep;
    const unsigned ldsw = (unsigned)wid * 1024u;
    const int aoff = lds_byte(wr * 64 + fr, fq * 8), boff = lds_byte(wc * 32 + fr, fq * 8);
#define PG8_SA(b, h) (((b) * 2 + (h)) * HTB)
#define PG8_SB(b, h) ((4 + (b) * 2 + (h)) * HTB)
#define PG8_STAGE(bufoff, gbase, voff) do { _Pragma("unroll") for (int _i = 0; _i < 2; ++_i) \
        __builtin_amdgcn_global_load_lds((const unsigned*)((const char*)(gbase) + (voff)[_i]), (LAS unsigned*)(lds + (bufoff) + ldsw + _i * 8192), 16, 0, 0); } while (0)
#define PG8_LDA(dst, b, h) do { _Pragma("unroll") for (int m = 0; m < 4; ++m) _Pragma("unroll") for (int k = 0; k < 2; ++k) dst[m][k] = *(const LAS bf16x8*)(lds + PG8_SA(b, h) + aoff + m * 2048 + k * 1024); } while (0)
#define PG8_LDB(dst, b, h) do { _Pragma("unroll") for (int n = 0; n < 2; ++n) _Pragma("unroll") for (int k = 0; k < 2; ++k) dst[n][k] = *(const LAS bf16x8*)(lds + PG8_SB(b, h) + boff + n * 2048 + k * 1024); } while (0)
#define PG8_MMA(ai, bj, At, Bt) do { __builtin_amdgcn_s_setprio(1); _Pragma("unroll") for (int m = 0; m < 4; ++m) _Pragma("unroll") for (int n = 0; n < 2; ++n) _Pragma("unroll") for (int k = 0; k < 2; ++k) \
        acc[ai][bj][m][n] = __builtin_amdgcn_mfma_f32_16x16x32_bf16(Bt[n][k], At[m][k], acc[ai][bj][m][n], 0, 0, 0); __builtin_amdgcn_s_setprio(0); } while (0)
#define PG8_WAIT_V(n) asm volatile("s_waitcnt vmcnt(" #n ")" ::: "memory")
#define PG8_WAIT_L(n) asm volatile("s_waitcnt lgkmcnt(" #n ")" ::: "memory")
#define PG8_BAR __builtin_amdgcn_s_barrier()
#define PG8_SCHED __builtin_amdgcn_sched_barrier(0)
    Unit cur, nxt; int ui = 0;
    if (!S.next(0, cur)) return;
    f32x4 acc[2][2][4][2];
#pragma unroll
    for (int a = 0; a < 2; ++a)
#pragma unroll
        for (int b = 0; b < 2; ++b)
#pragma unroll
            for (int m = 0; m < 4; ++m)
#pragma unroll
                for (int n = 0; n < 2; ++n) acc[a][b][m][n] = (f32x4){0.f, 0.f, 0.f, 0.f};
    bf16x8 At[4][2], B0[2][2], B1[2][2];
    const char* cA = (const char*)g.A + (size_t)cur.pm * tstep; const char* cB = (const char*)g.Bt + (size_t)cur.pn * tstep;
    PG8_STAGE(PG8_SB(0, 0), cB, voffB); PG8_STAGE(PG8_SA(0, 0), cA, voffA); PG8_STAGE(PG8_SB(0, 1), cB + hstep, voffB); PG8_STAGE(PG8_SA(0, 1), cA + hstep, voffA);
    if (wr == 1) PG8_BAR;
    PG8_WAIT_V(4); PG8_BAR;
    PG8_STAGE(PG8_SB(1, 0), cB + kstep, voffB); PG8_STAGE(PG8_SA(1, 0), cA + kstep, voffA); PG8_STAGE(PG8_SB(1, 1), cB + hstep + kstep, voffB);
    PG8_WAIT_V(6); PG8_BAR;
    for (;;) {
        const bool has_next = S.next(ui + 1, nxt);
        const char* nA = has_next ? (const char*)g.A + (size_t)nxt.pm * tstep : cA; const char* nB = has_next ? (const char*)g.Bt + (size_t)nxt.pn * tstep : cB;
        for (int t = 0; t < nt; t += 2) {
            const bool last = (t == nt - 2);
            const char* a1 = cA + (size_t)(t + 1) * kstep;
            const char* a2 = last ? nA : cA + (size_t)(t + 2) * kstep; const char* b2 = last ? nB : cB + (size_t)(t + 2) * kstep;
            const char* a3 = a2 + kstep; const char* b3 = b2 + kstep;
            PG8_LDB(B0, 0, 0); PG8_SCHED; PG8_LDA(At, 0, 0); PG8_STAGE(PG8_SA(1, 1), a1 + hstep, voffA);
            PG8_WAIT_L(8); PG8_BAR; PG8_WAIT_L(0); PG8_MMA(0, 0, At, B0); PG8_BAR; PG8_SCHED;
            PG8_LDB(B1, 0, 1); PG8_STAGE(PG8_SB(0, 0), b2, voffB);
            PG8_BAR; PG8_WAIT_L(0); PG8_MMA(0, 1, At, B1); PG8_BAR;
            PG8_LDA(At, 0, 1); PG8_STAGE(PG8_SA(0, 0), a2, voffA);
            PG8_BAR; PG8_WAIT_L(0); PG8_MMA(1, 0, At, B0); PG8_BAR; PG8_SCHED;
            PG8_STAGE(PG8_SB(0, 1), b2 + hstep, voffB);
            PG8_WAIT_V(6); PG8_BAR; PG8_MMA(1, 1, At, B1); PG8_BAR;
            PG8_LDB(B0, 1, 0); PG8_SCHED; PG8_LDA(At, 1, 0); PG8_STAGE(PG8_SA(0, 1), a2 + hstep, voffA);
            PG8_WAIT_L(8); PG8_BAR; PG8_WAIT_L(0); PG8_MMA(0, 0, At, B0); PG8_BAR; PG8_SCHED;
            PG8_LDB(B1, 1, 1); PG8_STAGE(PG8_SB(1, 0), b3, voffB);
            PG8_BAR; PG8_WAIT_L(0); PG8_MMA(0, 1, At, B1); PG8_BAR;
            PG8_LDA(At, 1, 1); PG8_STAGE(PG8_SA(1, 0), a3, voffA);
            PG8_BAR; PG8_WAIT_L(0); PG8_MMA(1, 0, At, B0); PG8_BAR; PG8_SCHED;
            PG8_STAGE(PG8_SB(1, 1), b3 + hstep, voffB);
            PG8_WAIT_V(6); PG8_BAR; PG8_MMA(1, 1, At, B1); PG8_BAR;
        }
        E(acc, cur, wr, wc, fr, fq);
        if (!has_next) break;
#pragma unroll
        for (int a = 0; a < 2; ++a)
#pragma unroll
            for (int b = 0; b < 2; ++b)
#pragma unroll
                for (int m = 0; m < 4; ++m)
#pragma unroll
                    for (int n = 0; n < 2; ++n) acc[a][b][m][n] = (f32x4){0.f, 0.f, 0.f, 0.f};
        cur = nxt; cA = nA; cB = nB; ++ui;
    }
    PG8_WAIT_V(0);
    if (wr == 0) PG8_BAR;
    PG8_BAR;
#undef PG8_SA
#undef PG8_SB
#undef PG8_STAGE
#undef PG8_LDA
#undef PG8_LDB
#undef PG8_MMA
#undef PG8_WAIT_V
#undef PG8_WAIT_L
#undef PG8_BAR
#undef PG8_SCHED
}
}

template <class F> struct Epi8 {
    F f;
    DI void operator()(const f32x4 (&acc)[2][2][4][2], const pg8::Unit& u, int wr, int wc, int fr, int fq) const {
        const int row0 = u.pm * 256 + wr * 64 + fr, col0 = u.pn * 256 + wc * 32 + 8 * fq;
        if constexpr (F::HAS_TILE) { f.tile(acc, row0, col0); return; }
#pragma unroll
        for (int ai = 0; ai < 2; ++ai)
#pragma unroll
            for (int m = 0; m < 4; ++m)
#pragma unroll
                for (int bj = 0; bj < 2; ++bj) f.store8(row0 + ai * 128 + m * 16, col0 + bj * 128, acc[ai][bj][m][0], acc[ai][bj][m][1]);
    }
};

template <class F> DI void small_gemm(const bf16_t* A, const bf16_t* Wt, int N, int rowbase, const F& f) {
    const int lane = TID() & 63, wid = TID() >> 6, r16 = lane & 15, fq = lane >> 4;
    const int ntile = 16 * (N / 32), nw = gridDim.x * 8;
    for (int t = blockIdx.x * 8 + wid; t < ntile; t += nw) {
        const int rt = t & 15, ct = t >> 4;
        const bf16_t* ap = A + (size_t)(rt * 16 + r16) * 1024 + fq * 8;
        const bf16_t* b0 = Wt + (size_t)(ct * 32 + pg8::perm32(r16)) * 1024 + fq * 8;
        const bf16_t* b1 = Wt + (size_t)(ct * 32 + pg8::perm32(16 + r16)) * 1024 + fq * 8;
        f32x4 acc0 = {0.f, 0.f, 0.f, 0.f}, acc1 = {0.f, 0.f, 0.f, 0.f};
#pragma unroll 1
        for (int kb = 0; kb < 4; ++kb) {
            bf16x8 a[8], x0[8], x1[8];
#pragma unroll
            for (int u = 0; u < 8; ++u) { const int ko = (kb * 8 + u) * 32; a[u] = *(const bf16x8*)(ap + ko); x0[u] = *(const bf16x8*)(b0 + ko); x1[u] = *(const bf16x8*)(b1 + ko); }
            asm volatile("" : "+v"(a[0]), "+v"(x0[0]), "+v"(x1[0]), "+v"(a[1]), "+v"(x0[1]), "+v"(x1[1]), "+v"(a[2]), "+v"(x0[2]), "+v"(x1[2]), "+v"(a[3]), "+v"(x0[3]), "+v"(x1[3]), "+v"(a[4]), "+v"(x0[4]), "+v"(x1[4]), "+v"(a[5]), "+v"(x0[5]), "+v"(x1[5]), "+v"(a[6]), "+v"(x0[6]), "+v"(x1[6]), "+v"(a[7]), "+v"(x0[7]), "+v"(x1[7]));
#pragma unroll
            for (int u = 0; u < 8; ++u) { acc0 = mfma16(x0[u], a[u], acc0); acc1 = mfma16(x1[u], a[u], acc1); }
        }
        f.store8(rowbase + rt * 16 + r16, ct * 32 + 8 * fq, acc0, acc1);
    }
}

template <class F> DI void gemm_all(LAS unsigned char* lds, const bf16_t* A, const bf16_t* Wt, int N, const F& f) {
    pg8::Gemm g{A, Wt, MP, N, 1024}; pg8::StaticOrder S; S.init(MP, N, (int)gridDim.x, (int)blockIdx.x); Epi8<F> E{f};
    pg8::gemm_phase(lds, g, S, E);
    small_gemm(A + (size_t)MP * 1024, Wt, N, MP, f);
}

DI void st_bf16x8(bf16_t* p, f32x4 v0, f32x4 v1) { u32x4 w; w.x = pk2(v0[0], v0[1]); w.y = pk2(v0[2], v0[3]); w.z = pk2(v1[0], v1[1]); w.w = pk2(v1[2], v1[3]); *(u32x4*)p = w; }

struct EpiA {
    static constexpr bool HAS_TILE = true;
    bf16_t* P0; float* out;
    DI void tile(const f32x4 (&acc)[2][2][4][2], int row0, int col0) const {
        const int ucol = col0 & ~255, urow = row0 & ~255;
        const bool tail = ucol < 3072 && (urow & 2047) == 1792;
#pragma unroll
        for (int ai = 0; ai < 2; ++ai)
#pragma unroll
            for (int m = 0; m < 4; ++m) {
                const int row = row0 + ai * 128 + m * 16, s = row & 2047;
#pragma unroll
                for (int bj = 0; bj < 2; ++bj) {
                    const f32x4 v0 = acc[ai][bj][m][0], v1 = acc[ai][bj][m][1];
                    if (tail && s >= 2045) { float* o = out + O_CP + (size_t)((row >> 11) * 3 + (s - 2045)) * 3072 + col0 + bj * 128; *(f32x4*)o = v0; *(f32x4*)(o + 4) = v1; }
                    st_bf16x8(P0 + (size_t)row * 4096 + col0 + bj * 128, v0, v1);
                }
            }
    }
    DI void store8(int row, int col, f32x4 v0, f32x4 v1) const {
        st_bf16x8(P0 + (size_t)row * 4096 + col, v0, v1);
        if (col < 3072) {
            float* o = nullptr;
            if (row < MP) { const int s = row & 2047; if (s >= 2045) o = out + O_CP + (size_t)((row >> 11) * 3 + (s - 2045)) * 3072 + col; }
            else { const int r = row - MP, l = r & 7; if (l >= 5) o = out + O_CS + (size_t)((r >> 3) * 3 + (l - 5)) * 3072 + col; }
            if (o) { *(f32x4*)o = v0; *(f32x4*)(o + 4) = v1; }
        }
    }
};
DI void ld8_as_f32(const float* p, f32x4& a, f32x4& b) { a = *(const f32x4*)p; b = *(const f32x4*)(p + 4); }
DI void ld8_as_f32(const bf16_t* p, f32x4& a, f32x4& b) { const u32x4 w = *(const u32x4*)p; a = (f32x4){bflo(w.x), bfhi(w.x), bflo(w.y), bfhi(w.y)}; b = (f32x4){bflo(w.z), bfhi(w.z), bflo(w.w), bfhi(w.w)}; }
DI void st8_from_f32(float* p, f32x4 a, f32x4 b) { *(f32x4*)p = a; *(f32x4*)(p + 4) = b; }
DI void st8_from_f32(bf16_t* p, f32x4 a, f32x4 b) { st_bf16x8(p, a, b); }
template <class TI, class TO> struct EpiRes {
    static constexpr bool HAS_TILE = true;
    const TI* xp; const TI* xs; const float* mod; TO* dst;
    DI void tile(const f32x4 (&acc)[2][2][4][2], int row0, int col0) const {
        const float* gt = mod + (size_t)(row0 >> 11) * 3072 + 2048 + col0;
        f32x4 g[2][2];
#pragma unroll
        for (int bj = 0; bj < 2; ++bj) { g[bj][0] = *(const f32x4*)(gt + bj * 128); g[bj][1] = *(const f32x4*)(gt + bj * 128 + 4); }
#pragma unroll
        for (int ai = 0; ai < 2; ++ai) {
            f32x4 xv[16];
            if constexpr (sizeof(TI) == 2) {
                u32x4 xr[8];
#pragma unroll
                for (int m = 0; m < 4; ++m)
#pragma unroll
                    for (int bj = 0; bj < 2; ++bj) xr[m * 2 + bj] = *(const u32x4*)(xp + (size_t)(row0 + ai * 128 + m * 16) * 1024 + col0 + bj * 128);
                pin8(xr);
#pragma unroll
                for (int q = 0; q < 8; ++q) { const u32x4 w = xr[q]; xv[2 * q] = (f32x4){bflo(w.x), bfhi(w.x), bflo(w.y), bfhi(w.y)}; xv[2 * q + 1] = (f32x4){bflo(w.z), bfhi(w.z), bflo(w.w), bfhi(w.w)}; }
            } else {
#pragma unroll
                for (int m = 0; m < 4; ++m) { const TI* x = xp + (size_t)(row0 + ai * 128 + m * 16) * 1024 + col0;
#pragma unroll
                    for (int bj = 0; bj < 2; ++bj) ld8_as_f32(x + bj * 128, xv[m * 4 + bj * 2], xv[m * 4 + bj * 2 + 1]); }
                asm volatile("" : "+v"(xv[0]), "+v"(xv[1]), "+v"(xv[2]), "+v"(xv[3]), "+v"(xv[4]), "+v"(xv[5]), "+v"(xv[6]), "+v"(xv[7]), "+v"(xv[8]), "+v"(xv[9]), "+v"(xv[10]), "+v"(xv[11]), "+v"(xv[12]), "+v"(xv[13]), "+v"(xv[14]), "+v"(xv[15]));
            }
#pragma unroll
            for (int m = 0; m < 4; ++m) { TO* d = dst + (size_t)(row0 + ai * 128 + m * 16) * 1024 + col0;
#pragma unroll
                for (int bj = 0; bj < 2; ++bj) st8_from_f32(d + bj * 128, xv[m * 4 + bj * 2] + g[bj][0] * acc[ai][bj][m][0], xv[m * 4 + bj * 2 + 1] + g[bj][1] * acc[ai][bj][m][1]); }
        }
    }
    DI void store8(int row, int col, f32x4 v0, f32x4 v1) const {
        const TI* x = (row < MP ? xp + (size_t)row * 1024 : xs + (size_t)(row - MP) * 1024) + col;
        const float* gt = mod + (size_t)batch_of(row) * 3072 + 2048 + col;
        f32x4 x0, x1; ld8_as_f32(x, x0, x1);
        const f32x4 g0 = *(const f32x4*)gt, g1 = *(const f32x4*)(gt + 4);
        st8_from_f32(dst + (size_t)row * 1024 + col, x0 + g0 * v0, x1 + g1 * v1);
    }
};
struct EpiB {
    static constexpr bool HAS_TILE = true;
    bf16_t* P1; float* out;
    DI void tile(const f32x4 (&acc)[2][2][4][2], int row0, int col0) const {
        const int ucol = col0 & ~255, urow = row0 & ~255;
        const bool isq = ucol < 3072, iskv = ucol >= 3072 && ucol < 9216;
        const int cc = ucol - 3072, kv = cc >= 3072 ? 1 : 0, g = ((cc - kv * 3072) >> 10), W = g == 0 ? 128 : (g == 1 ? 512 : 2048);
        const int b = urow >> 11, s0 = urow & 2047;
        const bool any_out = iskv && (s0 + 256 > 2048 - W);
        const size_t obase = (g == 0 ? O_KVP0 : (g == 1 ? O_KVP1 : O_KVP2)) + ((size_t)b * W * 2 + kv) * 1024 + ((col0 - 3072 - kv * 3072) & 1023);
        const float sc = isq ? QSCALE : 1.f;
#pragma unroll
        for (int ai = 0; ai < 2; ++ai)
#pragma unroll
            for (int m = 0; m < 4; ++m) {
                const int row = row0 + ai * 128 + m * 16, s = row & 2047;
#pragma unroll
                for (int bj = 0; bj < 2; ++bj) {
                    const f32x4 v0 = acc[ai][bj][m][0], v1 = acc[ai][bj][m][1];
                    if (any_out && s >= 2048 - W) { float* o = out + obase + (size_t)(s - (2048 - W)) * 2048 + bj * 128; *(f32x4*)o = v0; *(f32x4*)(o + 4) = v1; }
                    st_bf16x8(P1 + (size_t)row * 10240 + col0 + bj * 128, v0 * sc, v1 * sc);
                }
            }
    }
    DI void store8(int row, int col, f32x4 v0, f32x4 v1) const {
        if (col >= 3072 && col < 9216) {
            const int cc = col - 3072, kv = cc / 3072, g = (cc - kv * 3072) >> 10, he = cc & 1023;
            float* o = nullptr;
            if (row < MP) {
                const int b = row >> 11, s = row & 2047, W = g == 0 ? 128 : (g == 1 ? 512 : 2048);
                const size_t base = g == 0 ? O_KVP0 : (g == 1 ? O_KVP1 : O_KVP2);
                if (s >= 2048 - W) o = out + base + ((size_t)(b * W + (s - (2048 - W))) * 2 + kv) * 1024 + he;
            } else {
                const size_t base = g == 0 ? O_KVS0 : (g == 1 ? O_KVS1 : O_KVS2);
                o = out + base + ((size_t)(row - MP) * 2 + kv) * 1024 + he;
            }
            if (o) { *(f32x4*)o = v0; *(f32x4*)(o + 4) = v1; }
        }
        if (col < 3072) { v0 *= QSCALE; v1 *= QSCALE; }
        st_bf16x8(P1 + (size_t)row * 10240 + col, v0, v1);
    }
};

DI void ada_item(const Params& p, LAS unsigned char* lds, int it) {
    const int tid = TID(), l = it / 96, col0 = (it % 96) * 32, col = tid & 31, ks = tid >> 5;
    LAS float* cs = (LAS float*)lds;
    const float* aw = p.in[I_ADAW] + (size_t)l * 1024 * 3072;
    float acc[40];
#pragma unroll
    for (int b = 0; b < 40; ++b) acc[b] = 0.f;
    for (int half = 0; half < 2; ++half) {
        __syncthreads();
        {
            f32x4 c4[10];
#pragma unroll
            for (int b4 = 0; b4 < 10; ++b4)
#pragma unroll
                for (int e = 0; e < 4; ++e) { const int b = 4 * b4 + e; c4[b4][e] = b < 8 ? p.in[I_CP][b * 1024 + half * 512 + tid] : p.in[I_CS][(b - 8) * 1024 + half * 512 + tid]; }
            asm volatile("" : "+v"(c4[0]), "+v"(c4[1]), "+v"(c4[2]), "+v"(c4[3]), "+v"(c4[4]), "+v"(c4[5]), "+v"(c4[6]), "+v"(c4[7]), "+v"(c4[8]), "+v"(c4[9]));
#pragma unroll
            for (int b4 = 0; b4 < 10; ++b4) { f32x4 sv; sv[0] = siluf(c4[b4][0]); sv[1] = siluf(c4[b4][1]); sv[2] = siluf(c4[b4][2]); sv[3] = siluf(c4[b4][3]); *(LAS f32x4*)(cs + tid * 44 + b4 * 4) = sv; }
        }
        __syncthreads();
        float wv[32];
#pragma unroll
        for (int kk = 0; kk < 32; ++kk) wv[kk] = aw[(size_t)(half * 512 + ks * 32 + kk) * 3072 + col0 + col];
        { float (&w0)[16] = *reinterpret_cast<float (*)[16]>(&wv[0]); float (&w1)[16] = *reinterpret_cast<float (*)[16]>(&wv[16]); pin16x2(w0, w1); }
#pragma unroll 4
        for (int kk = 0; kk < 32; ++kk) {
            const int k = ks * 32 + kk;
            const float w = wv[kk];
#pragma unroll
            for (int b4 = 0; b4 < 10; ++b4) {
                const f32x4 c4 = *(const LAS f32x4*)(cs + k * 44 + b4 * 4);
                acc[b4 * 4 + 0] += c4[0] * w; acc[b4 * 4 + 1] += c4[1] * w; acc[b4 * 4 + 2] += c4[2] * w; acc[b4 * 4 + 3] += c4[3] * w;
            }
        }
    }
    __syncthreads();
    LAS float* red = (LAS float*)lds;
#pragma unroll
    for (int b = 0; b < 40; ++b) red[(ks * 40 + b) * 32 + col] = acc[b];
    __syncthreads();
    float* MOD = (float*)(p.ws + WS_MOD);
    for (int idx = tid; idx < 1280; idx += 512) {
        const int b = idx >> 5, c = idx & 31;
        float s = p.in[I_ADAB][l * 3072 + col0 + c];
#pragma unroll
        for (int k16 = 0; k16 < 16; ++k16) s += red[(k16 * 40 + b) * 32 + c];
        MOD[(size_t)(l * 40 + b) * 3072 + col0 + c] = s;
    }
}
struct TileRef { const float* src; bf16_t* dst; int pitch, k0, n0; };
DI TileRef tile_ref(const Params& p, int t) {
    TileRef r; int tt;
    if (t < 512) { r.src = p.in[I_AWIN]; r.dst = (bf16_t*)(p.ws + WS_WTA); r.pitch = 4112; tt = t; }
    else if (t < 640) { r.src = p.in[I_AWOUT]; r.dst = (bf16_t*)(p.ws + WS_WTAO); r.pitch = 1024; tt = t - 512; }
    else if (t < 1920) { r.src = p.in[I_BWIN]; r.dst = (bf16_t*)(p.ws + WS_WTB); r.pitch = 10240; tt = t - 640; }
    else { r.src = p.in[I_BWOUT]; r.dst = (bf16_t*)(p.ws + WS_WTBO); r.pitch = 1024; tt = t - 1920; }
    r.k0 = (tt & 15) * 64; r.n0 = (tt >> 4) * 128; return r;
}
DI void tile_load(const TileRef& r, int tid, f32x4 (&v)[4]) {
#pragma unroll
    for (int i = 0; i < 4; ++i) { const int kk = (tid >> 5) + 16 * i, nn = (tid & 31) * 4; v[i] = *(const f32x4*)(r.src + (size_t)(r.k0 + kk) * r.pitch + r.n0 + nn); }
}
DI void phase_prep(const Params& p, LAS unsigned char* lds) {
    const int bid = blockIdx.x, G = gridDim.x;
    for (int it = bid; it < 192; it += G) ada_item(p, lds, it);
    int t, tstep, tend;
    if (G == 256) { if (bid < 192) { t = bid * 2; tstep = 1; tend = t + 2; } else { t = 384 + (bid - 192); tstep = 64; tend = 640; } }
    else { t = bid; tstep = G; tend = 640; }
    const int tid = TID();
    LAS float* T = (LAS float*)lds;
    f32x4 cur[4], nxt[4];
    TileRef rc, rn;
    if (t < tend) { rc = tile_ref(p, t); tile_load(rc, tid, cur); }
    for (; t < tend; t += tstep) {
        const int tn = t + tstep;
        if (tn < tend) { rn = tile_ref(p, tn); tile_load(rn, tid, nxt); }
        lds_sync();
#pragma unroll
        for (int i = 0; i < 4; ++i) { const int kk = (tid >> 5) + 16 * i, nn = (tid & 31) * 4;
            T[kk * 129 + nn] = cur[i][0]; T[kk * 129 + nn + 1] = cur[i][1]; T[kk * 129 + nn + 2] = cur[i][2]; T[kk * 129 + nn + 3] = cur[i][3]; }
        lds_sync();
#pragma unroll
        for (int q = 0; q < 2; ++q) {
            const int task = tid + 512 * q, nn = task >> 3, kc = task & 7;
            u32x4 w;
            w.x = pk2(T[(kc * 8 + 0) * 129 + nn], T[(kc * 8 + 1) * 129 + nn]); w.y = pk2(T[(kc * 8 + 2) * 129 + nn], T[(kc * 8 + 3) * 129 + nn]);
            w.z = pk2(T[(kc * 8 + 4) * 129 + nn], T[(kc * 8 + 5) * 129 + nn]); w.w = pk2(T[(kc * 8 + 6) * 129 + nn], T[(kc * 8 + 7) * 129 + nn]);
            *(u32x4*)(rc.dst + (size_t)(rc.n0 + nn) * 1024 + rc.k0 + kc * 8) = w;
        }
#pragma unroll
        for (int i = 0; i < 4; ++i) cur[i] = nxt[i];
        rc = rn;
    }
}

template <bool AB> DI void phase_norm(const Params& p, LAS unsigned char* lds, const float* xp, const float* xs, int layer) {
    const int tid = TID(), lane = tid & 63, wid = tid >> 6;
    LAS float* wab = (LAS float*)lds;
    if (AB) {
        for (int idx = tid; idx < 16384; idx += 512) { const int k = idx >> 4, j = idx & 15; wab[k * 20 + j] = p.in[I_AWIN][(size_t)k * 4112 + 4096 + j]; }
        __syncthreads();
    }
    const float* MODl = (const float*)(p.ws + WS_MOD) + (size_t)layer * 40 * 3072;
    const float* ng = p.in[I_NG] + layer * 1024;
    bf16_t* ACT = (bf16_t*)(p.ws + WS_ACT);
    float* GB = (float*)(p.ws + WS_GB);
    const int nw = gridDim.x * 8;
    float gsv[16], shv[16];
    auto ld_mod = [&](int b) {
        const float* mb = MODl + (size_t)b * 3072;
        float sc[16], g16[16];
#pragma unroll
        for (int i = 0; i < 16; ++i) { const int c = lane + 64 * i; sc[i] = mb[1024 + c]; shv[i] = mb[c]; g16[i] = ng[c]; }
#pragma unroll
        for (int i = 0; i < 16; ++i) gsv[i] = g16[i] * (1.f + sc[i]);
    };
    auto ld_row = [&](int row, float (&v)[16]) {
        const float* x = row < MP ? xp + (size_t)row * 1024 : xs + (size_t)(row - MP) * 1024;
#pragma unroll
        for (int i = 0; i < 16; ++i) v[i] = x[lane + 64 * i];
    };
    auto do_row = [&](int row, float (&v)[16]) {
        float ss = 0.f;
#pragma unroll
        for (int i = 0; i < 16; ++i) ss += v[i] * v[i];
        ss = wave_sum(ss);
        const float rstd = rsqrtf(ss * (1.f / 1024.f) + EPS);
#pragma unroll
        for (int i = 0; i < 16; ++i) {
            const int c = lane + 64 * i;
            v[i] = v[i] * rstd * gsv[i] + shv[i];
            ACT[(size_t)row * 1024 + c] = (bf16_t)(pk2(v[i], 0.f) & 0xffffu);
        }
        if (AB) {
            float pa[16];
#pragma unroll
            for (int j = 0; j < 16; ++j) pa[j] = 0.f;
#pragma unroll
            for (int i = 0; i < 16; ++i) {
                const int c = lane + 64 * i;
                asm volatile("" ::: "memory");
#pragma unroll
                for (int q = 0; q < 4; ++q) { const f32x4 w = *(const LAS f32x4*)(wab + c * 20 + q * 4); pa[q * 4] += v[i] * w[0]; pa[q * 4 + 1] += v[i] * w[1]; pa[q * 4 + 2] += v[i] * w[2]; pa[q * 4 + 3] += v[i] * w[3]; }
            }
            float mine = 0.f;
#pragma unroll
            for (int j = 0; j < 16; ++j) { const float sm = wave_sum(pa[j]); if (lane == j) mine = sm; }
            if (lane < 16) {
                float r;
                if (lane < 8) { const float a = mine + p.in[I_ADT][lane]; const float sp = a > 20.f ? a : log1pf(__expf(a)); r = -__expf(p.in[I_ALOG][lane]) * sp; }
                else r = 1.f / (1.f + __expf(-mine));
                GB[(size_t)row * 16 + lane] = r;
            }
        }
    };
    for (int chunk = blockIdx.x * 8 + wid; chunk < MP / 8; chunk += nw) {
        const int r0 = chunk * 8;
        ld_mod(r0 >> 11);
#pragma unroll 1
        for (int h4 = 0; h4 < 2; ++h4) {
            float va[16], vb[16], vc[16], vd[16];
            const int r = r0 + 4 * h4;
            ld_row(r, va); ld_row(r + 1, vb); ld_row(r + 2, vc); ld_row(r + 3, vd);
            pin16x4(va, vb, vc, vd);
            do_row(r, va); do_row(r + 1, vb); do_row(r + 2, vc); do_row(r + 3, vd);
        }
    }
    for (int r = blockIdx.x * 8 + wid; r < MS; r += nw) {
        float va[16];
        ld_mod(8 + (r >> 3));
        ld_row(MP + r, va);
        do_row(MP + r, va);
    }
}

DI void phase_norm1(const Params& p) {
    const int lane = TID() & 63, wid = TID() >> 6;
    const float* MODl = (const float*)(p.ws + WS_MOD) + (size_t)40 * 3072;
    const float* ng = p.in[I_NG] + 1024;
    const bf16_t* X1 = (const bf16_t*)(p.ws + WS_X1);
    bf16_t* ACT = (bf16_t*)(p.ws + WS_ACT);
    const int nw = gridDim.x * 8;
    float gsv[16], shv[16];
    auto ld_mod = [&](int b) {
        const float* mb = MODl + (size_t)b * 3072 + lane * 16;
#pragma unroll
        for (int q = 0; q < 4; ++q) { const f32x4 sc = *(const f32x4*)(mb + 1024 + q * 4), sh = *(const f32x4*)(mb + q * 4), g = *(const f32x4*)(ng + lane * 16 + q * 4);
#pragma unroll
            for (int e = 0; e < 4; ++e) { gsv[q * 4 + e] = g[e] * (1.f + sc[e]); shv[q * 4 + e] = sh[e]; } }
    };
    auto do_row = [&](int row, u32x4 a, u32x4 b) {
        float v[16] = {bflo(a.x), bfhi(a.x), bflo(a.y), bfhi(a.y), bflo(a.z), bfhi(a.z), bflo(a.w), bfhi(a.w), bflo(b.x), bfhi(b.x), bflo(b.y), bfhi(b.y), bflo(b.z), bfhi(b.z), bflo(b.w), bfhi(b.w)};
        float ss = 0.f;
#pragma unroll
        for (int i = 0; i < 16; ++i) ss += v[i] * v[i];
        ss = wave_sum(ss);
        const float rstd = rsqrtf(ss * (1.f / 1024.f) + EPS);
#pragma unroll
        for (int i = 0; i < 16; ++i) v[i] = v[i] * rstd * gsv[i] + shv[i];
        u32x4 w0, w1;
        w0.x = pk2(v[0], v[1]); w0.y = pk2(v[2], v[3]); w0.z = pk2(v[4], v[5]); w0.w = pk2(v[6], v[7]);
        w1.x = pk2(v[8], v[9]); w1.y = pk2(v[10], v[11]); w1.z = pk2(v[12], v[13]); w1.w = pk2(v[14], v[15]);
        u32x4* d = (u32x4*)(ACT + (size_t)row * 1024 + lane * 16); d[0] = w0; d[1] = w1;
    };
    for (int chunk = blockIdx.x * 8 + wid; chunk < MP / 8; chunk += nw) {
        const int r0 = chunk * 8;
        ld_mod(r0 >> 11);
#pragma unroll 1
        for (int h4 = 0; h4 < 2; ++h4) {
            u32x4 r[8];
#pragma unroll
            for (int j = 0; j < 4; ++j) { const u32x4* src = (const u32x4*)(X1 + (size_t)(r0 + 4 * h4 + j) * 1024 + lane * 16); r[2 * j] = src[0]; r[2 * j + 1] = src[1]; }
            pin8(r);
#pragma unroll
            for (int j = 0; j < 4; ++j) do_row(r0 + 4 * h4 + j, r[2 * j], r[2 * j + 1]);
        }
    }
    for (int rr = blockIdx.x * 8 + wid; rr < MS; rr += nw) {
        ld_mod(8 + (rr >> 3));
        const u32x4* src = (const u32x4*)(X1 + (size_t)(MP + rr) * 1024 + lane * 16);
        const u32x4 a = src[0], b = src[1];
        do_row(MP + rr, a, b);
    }
}

constexpr int WT_TASKS = 5120 + 512;
DI void wt_task(const Params& p, int t, int lane) {
    const float* src; bf16_t* dst; int pitch;
    if (t < 5120) { src = p.in[I_BWIN]; dst = (bf16_t*)(p.ws + WS_WTB); pitch = 10240; }
    else { src = p.in[I_BWOUT]; dst = (bf16_t*)(p.ws + WS_WTBO); pitch = 1024; t -= 5120; }
    const int k0 = (t & 31) * 32, n = (t >> 5) * 64 + lane;
    const float* sp = src + (size_t)k0 * pitch + n;
    f32x4 v[8];
#pragma unroll
    for (int q = 0; q < 8; ++q) { v[q][0] = sp[(size_t)(4 * q) * pitch]; v[q][1] = sp[(size_t)(4 * q + 1) * pitch]; v[q][2] = sp[(size_t)(4 * q + 2) * pitch]; v[q][3] = sp[(size_t)(4 * q + 3) * pitch]; }
    pin8(v);
    u32x4* dp = (u32x4*)(dst + (size_t)n * 1024 + k0);
#pragma unroll
    for (int q = 0; q < 4; ++q) { u32x4 w; w.x = pk2(v[2 * q][0], v[2 * q][1]); w.y = pk2(v[2 * q][2], v[2 * q][3]); w.z = pk2(v[2 * q + 1][0], v[2 * q + 1][1]); w.w = pk2(v[2 * q + 1][2], v[2 * q + 1][3]); dp[q] = w; }
}

constexpr int PQ = 0, PK = 17408, PT = 34816, PR = 53248, PN = 118784, PG = 136192;
DI void prep_item(const Params& p, LAS unsigned char* lds, int ci) {
    const int tid = TID(), lane = tid & 63, wid = tid >> 6;
    const bf16_t* P0 = (const bf16_t*)(p.ws + WS_P0);
    const float* GB = (const float*)(p.ws + WS_GB);
    int h, row0, nvalid, nprev; const float* sconv = nullptr;
    if (ci < 2048) { const int bh = ci >> 5, n = ci & 31; h = bh & 7; row0 = (bh >> 3) * 2048 + n * 64; nvalid = 64; nprev = n * 64; }
    else { const int sb = (ci - 2048) >> 3; h = (ci - 2048) & 7; row0 = MP + sb * 8; nvalid = 8; nprev = 0; sconv = p.in[I_SC] + (size_t)sb * 3 * 3072; }
    LAS float* sg = (LAS float*)(lds + PG);
    LAS float* cw = (LAS float*)(lds + PG + 1024);
    const int i = tid >> 3, sub = tid & 7;
    lds_sync();
    u32x4 raw[4][3][2];
#pragma unroll
    for (int t = 0; t < 4; ++t) {
        const int rel = i - 3 + t;
#pragma unroll
        for (int sct = 0; sct < 3; ++sct) {
            const int ch = sct * 1024 + h * 128 + sub * 16;
            raw[t][sct][0] = (u32x4){0u, 0u, 0u, 0u}; raw[t][sct][1] = (u32x4){0u, 0u, 0u, 0u};
            if (i < nvalid) {
                if (rel >= 0 || nprev > 0) {
                    const u32x4* src = (const u32x4*)(P0 + (size_t)(row0 + rel) * 4096 + ch);
                    raw[t][sct][0] = src[0]; raw[t][sct][1] = src[1];
                } else if (sconv) {
                    const f32x4* src = (const f32x4*)(sconv + (size_t)(3 + rel) * 3072 + ch);
                    const f32x4 a = src[0], b = src[1], c = src[2], d = src[3];
                    raw[t][sct][0] = (u32x4){pk2(a[0], a[1]), pk2(a[2], a[3]), pk2(b[0], b[1]), pk2(b[2], b[3])};
                    raw[t][sct][1] = (u32x4){pk2(c[0], c[1]), pk2(c[2], c[3]), pk2(d[0], d[1]), pk2(d[2], d[3])};
                }
            }
        }
    }
    for (int idx = tid; idx < 1536; idx += 512) { const int t = idx / 384, rem = idx - t * 384, sct = rem >> 7, c = rem & 127; cw[idx] = p.in[I_ACONV][(size_t)t * 3072 + sct * 1024 + h * 128 + c]; }
    if (wid == 0) {
        float g = lane < nvalid ? GB[(size_t)(row0 + lane) * 16 + h] : 0.f;
        const float be = lane < nvalid ? GB[(size_t)(row0 + lane) * 16 + 8 + h] : 0.f;
#pragma unroll
        for (int o = 1; o < 64; o <<= 1) { const float t = __shfl_up(g, o); if (lane >= o) g += t; }
        sg[lane] = g; sg[64 + lane] = be; sg[128 + lane] = __expf(g);
        if (lane == 63) { sg[192] = g; ((float*)(p.ws + WS_GT))[ci] = __expf(g); }
    }
    asm volatile("" : "+v"(raw[0][0][0]), "+v"(raw[0][0][1]), "+v"(raw[0][1][0]), "+v"(raw[0][1][1]), "+v"(raw[0][2][0]), "+v"(raw[0][2][1]), "+v"(raw[1][0][0]), "+v"(raw[1][0][1]), "+v"(raw[1][1][0]), "+v"(raw[1][1][1]), "+v"(raw[1][2][0]), "+v"(raw[1][2][1]), "+v"(raw[2][0][0]), "+v"(raw[2][0][1]), "+v"(raw[2][1][0]), "+v"(raw[2][1][1]), "+v"(raw[2][2][0]), "+v"(raw[2][2][1]), "+v"(raw[3][0][0]), "+v"(raw[3][0][1]), "+v"(raw[3][1][0]), "+v"(raw[3][1][1]), "+v"(raw[3][2][0]), "+v"(raw[3][2][1]));
    lds_sync();
    {
        float y[3][16];
#pragma unroll
        for (int sct = 0; sct < 3; ++sct) {
#pragma unroll
            for (int j = 0; j < 16; ++j) y[sct][j] = 0.f;
#pragma unroll
            for (int t = 0; t < 4; ++t) {
                const u32x4 a = raw[t][sct][0], b = raw[t][sct][1];
                const float u[16] = {bflo(a.x), bfhi(a.x), bflo(a.y), bfhi(a.y), bflo(a.z), bfhi(a.z), bflo(a.w), bfhi(a.w),
                                     bflo(b.x), bfhi(b.x), bflo(b.y), bfhi(b.y), bflo(b.z), bfhi(b.z), bflo(b.w), bfhi(b.w)};
#pragma unroll
                for (int q = 0; q < 4; ++q) { const f32x4 w = *(const LAS f32x4*)(cw + (t * 3 + sct) * 128 + sub * 16 + q * 4);
                    y[sct][q * 4] += w[0] * u[q * 4]; y[sct][q * 4 + 1] += w[1] * u[q * 4 + 1]; y[sct][q * 4 + 2] += w[2] * u[q * 4 + 2]; y[sct][q * 4 + 3] += w[3] * u[q * 4 + 3]; }
            }
#pragma unroll
            for (int j = 0; j < 16; ++j) y[sct][j] = siluf(y[sct][j]);
        }
        float sq = 0.f, sk = 0.f;
#pragma unroll
        for (int j = 0; j < 16; ++j) { sq += y[0][j] * y[0][j]; sk += y[1][j] * y[1][j]; }
        sq += dpp_f<0xB1>(sq); sq += dpp_f<0x4E>(sq); sq += dpp_f<0x141>(sq);
        sk += dpp_f<0xB1>(sk); sk += dpp_f<0x4E>(sk); sk += dpp_f<0x141>(sk);
        const float rq = rsqrtf(sq + EPS) * 0.08838834764831845f, rk = rsqrtf(sk + EPS);
        const float gci = sg[i], bei = sg[64 + i], egi = sg[128 + i], ekd = __expf(sg[192] - gci);
        LAS float* R = (LAS float*)(lds + PR) + i * 256;
        u32x4 qa, qb, ka, kb, da, db;
        float qn[16], kn[16];
#pragma unroll
        for (int j = 0; j < 16; ++j) { qn[j] = y[0][j] * rq; kn[j] = y[1][j] * rk; }
        qa.x = pk2(qn[0], qn[1]); qa.y = pk2(qn[2], qn[3]); qa.z = pk2(qn[4], qn[5]); qa.w = pk2(qn[6], qn[7]);
        qb.x = pk2(qn[8], qn[9]); qb.y = pk2(qn[10], qn[11]); qb.z = pk2(qn[12], qn[13]); qb.w = pk2(qn[14], qn[15]);
        ka.x = pk2(kn[0], kn[1]); ka.y = pk2(kn[2], kn[3]); ka.z = pk2(kn[4], kn[5]); ka.w = pk2(kn[6], kn[7]);
        kb.x = pk2(kn[8], kn[9]); kb.y = pk2(kn[10], kn[11]); kb.z = pk2(kn[12], kn[13]); kb.w = pk2(kn[14], kn[15]);
        *(LAS u32x4*)(lds + PQ + i * 272 + sub * 32) = qa; *(LAS u32x4*)(lds + PQ + i * 272 + sub * 32 + 16) = qb;
        *(LAS u32x4*)(lds + PK + i * 272 + sub * 32) = ka; *(LAS u32x4*)(lds + PK + i * 272 + sub * 32 + 16) = kb;
        da.x = pk2(qn[0] * egi, qn[1] * egi); da.y = pk2(qn[2] * egi, qn[3] * egi); da.z = pk2(qn[4] * egi, qn[5] * egi); da.w = pk2(qn[6] * egi, qn[7] * egi);
        db.x = pk2(qn[8] * egi, qn[9] * egi); db.y = pk2(qn[10] * egi, qn[11] * egi); db.z = pk2(qn[12] * egi, qn[13] * egi); db.w = pk2(qn[14] * egi, qn[15] * egi);
        bf16_t* qd = (bf16_t*)(p.ws + WS_QD) + (size_t)ci * 8192 + i * 128 + sub * 16;
        *(u32x4*)qd = da; *(u32x4*)(qd + 8) = db;
        LAS bf16_t* T = (LAS bf16_t*)(lds + PT);
#pragma unroll
        for (int j = 0; j < 16; ++j) T[(sub * 16 + j) * 72 + i] = (bf16_t)(pk2(kn[j] * ekd, 0.f) & 0xffffu);
        const float kbs = bei * egi;
#pragma unroll
        for (int q = 0; q < 4; ++q) {
            *(LAS f32x4*)(R + sub * 16 + q * 4) = (f32x4){y[2][q * 4] * bei, y[2][q * 4 + 1] * bei, y[2][q * 4 + 2] * bei, y[2][q * 4 + 3] * bei};
            *(LAS f32x4*)(R + 128 + sub * 16 + q * 4) = (f32x4){kn[q * 4] * kbs, kn[q * 4 + 1] * kbs, kn[q * 4 + 2] * kbs, kn[q * 4 + 3] * kbs};
        }
    }
    lds_sync();
    {
        const int r16 = lane & 15, fq = lane >> 4;
        bf16_t* QK = (bf16_t*)(p.ws + WS_QK) + (size_t)ci * 4096;
        LAS float* Nm = (LAS float*)(lds + PN);
#pragma unroll
        for (int t = 0; t < 4; ++t) {
            const int id = wid * 4 + t, mat = id >> 4, ti = (id & 15) >> 2, tj = id & 3;
            f32x4 acc = {0.f, 0.f, 0.f, 0.f};
            if (tj <= ti) {
                const LAS unsigned char* xa = lds + PK + (tj * 16 + r16) * 272 + fq * 16;
                const LAS unsigned char* xb = lds + (mat ? PQ : PK) + (ti * 16 + r16) * 272 + fq * 16;
#pragma unroll
                for (int ks = 0; ks < 4; ++ks) acc = mfma16(lds_ld8(xa + ks * 64), lds_ld8(xb + ks * 64), acc);
            }
            const int i = ti * 16 + r16, j0 = tj * 16 + fq * 4;
            const float gi = sg[i], bi = sg[64 + i];
            f32x4 o;
#pragma unroll
            for (int r = 0; r < 4; ++r) {
                const int j = j0 + r;
                const bool ok = mat ? (j <= i) : (j < i);
                const float dec = ok ? __expf(gi - sg[j]) : 0.f;
                o[r] = ok ? acc[r] * dec * (mat ? 1.f : bi) : 0.f;
            }
            if (mat) { u32x2 w; w.x = pk2(o[0], o[1]); w.y = pk2(o[2], o[3]); *(u32x2*)(QK + i * 64 + j0) = w; }
            else *(LAS f32x4*)(Nm + i * 68 + j0) = o;
        }
    }
    lds_sync();
    if (tid < 256) {
        const LAS float* R = (const LAS float*)(lds + PR) + tid;
        int zv = 0; asm volatile("" : "+v"(zv));
        const LAS float* Nm = (const LAS float*)(lds + PN + zv);
        float x[64];
        f32x4 nb[2][16];
        x[0] = R[0];
        float rn = R[256];
        nb[1][0] = *(const LAS f32x4*)(Nm + 68);
#pragma unroll
        for (int i = 1; i < 64; ++i) {
            const float r = rn;
            if (i + 1 < 64) {
                rn = R[(i + 1) * 256];
#pragma unroll
                for (int j4 = 0; j4 < (i + 4) / 4; ++j4) nb[(i + 1) & 1][j4] = *(const LAS f32x4*)(Nm + (i + 1) * 68 + j4 * 4);
            }
            float a0 = 0.f, a1 = 0.f, a2 = 0.f, a3 = 0.f;
#pragma unroll
            for (int j4 = 0; j4 < (i + 3) / 4; ++j4) {
                const f32x4 nv = nb[i & 1][j4];
                if (j4 * 4 + 0 < i) a0 += nv[0] * x[j4 * 4 + 0];
                if (j4 * 4 + 1 < i) a1 += nv[1] * x[j4 * 4 + 1];
                if (j4 * 4 + 2 < i) a2 += nv[2] * x[j4 * 4 + 2];
                if (j4 * 4 + 3 < i) a3 += nv[3] * x[j4 * 4 + 3];
            }
            x[i] = r - ((a0 + a1) + (a2 + a3));
            asm volatile("" ::: "memory");
        }
        if (tid < 128) {
            u32x4* d = (u32x4*)((bf16_t*)(p.ws + WS_WV) + (size_t)ci * 8192 + tid * 64);
#pragma unroll
            for (int q = 0; q < 8; ++q) { u32x4 w; w.x = pk2(x[q * 8], x[q * 8 + 1]); w.y = pk2(x[q * 8 + 2], x[q * 8 + 3]); w.z = pk2(x[q * 8 + 4], x[q * 8 + 5]); w.w = pk2(x[q * 8 + 6], x[q * 8 + 7]); d[q] = w; }
        } else {
            bf16_t* d = (bf16_t*)(p.ws + WS_KC) + (size_t)ci * 8192 + (tid - 128);
#pragma unroll
            for (int i = 0; i < 64; ++i) d[i * 128] = (bf16_t)(pk2(x[i], 0.f) & 0xffffu);
        }
    } else {
        bf16_t* d = (bf16_t*)(p.ws + WS_KDT) + (size_t)ci * 8192;
#pragma unroll
        for (int q = 0; q < 4; ++q) { const int idx = (tid - 256) + q * 256, r = idx >> 3, c8 = idx & 7; *(u32x4*)(d + r * 64 + c8 * 8) = *(const LAS u32x4*)(lds + PT + r * 144 + c8 * 16); }
        const int wtask = ci * 4 + (wid - 4);
        if (wtask < WT_TASKS) wt_task(p, wtask, lane);
    }
}
DI void phase_dprep(const Params& p, LAS unsigned char* lds) { for (int ci = blockIdx.x; ci < NCH; ci += gridDim.x) prep_item(p, lds, ci); }

constexpr int SKC = 0, SQD = 17408, SKD = 34816, SQK = 53248, SST = 62464, SUT = 71168;
DI void scan_item(const Params& p, LAS unsigned char* lds, int item) {
    const int tid = TID(), lane = tid & 63, wid = tid >> 6, r16 = lane & 15, fq = lane >> 4;
    int ch0, nch, rowbase, h, dvs, nvalid; const float* S0 = nullptr; float* Sout;
    if (item < 256) { const int bh = item >> 2; dvs = item & 3; h = bh & 7; ch0 = bh * 32; nch = 32; rowbase = (bh >> 3) * 2048; nvalid = 64; Sout = p.out + O_DP + (size_t)bh * 16384; }
    else { const int it = item - 256, sbh = it >> 2; dvs = it & 3; h = sbh & 7; ch0 = 2048 + sbh; nch = 1; rowbase = MP + (sbh >> 3) * 8; nvalid = 8;
           S0 = p.in[I_SD] + (size_t)sbh * 16384; Sout = p.out + O_DS + (size_t)sbh * 16384; }
    const int dvoff = dvs * 32;
    const int dk0 = wid * 16;
    f32x4 accS[2];
#pragma unroll
    for (int vt = 0; vt < 2; ++vt)
#pragma unroll
        for (int r = 0; r < 4; ++r) accS[vt][r] = S0 ? S0[(size_t)(dk0 + 4 * fq + r) * 128 + dvoff + vt * 16 + r16] : 0.f;
    const bf16_t* gKC = (const bf16_t*)(p.ws + WS_KC); const bf16_t* gQD = (const bf16_t*)(p.ws + WS_QD);
    const bf16_t* gKD = (const bf16_t*)(p.ws + WS_KDT); const bf16_t* gQK = (const bf16_t*)(p.ws + WS_QK);
    const bf16_t* gWV = (const bf16_t*)(p.ws + WS_WV); const float* gGT = (const float*)(p.ws + WS_GT);
    bf16_t* O0 = (bf16_t*)(p.ws + WS_O0);
    u32x4 st[7];
    auto issue = [&](int ci) {
        const u32x4* a = (const u32x4*)(gKC + (size_t)ci * 8192); const u32x4* b = (const u32x4*)(gQD + (size_t)ci * 8192);
        const u32x4* c = (const u32x4*)(gKD + (size_t)ci * 8192); const u32x4* d = (const u32x4*)(gQK + (size_t)ci * 4096);
        st[0] = a[tid]; st[1] = a[tid + 512]; st[2] = b[tid]; st[3] = b[tid + 512]; st[4] = c[tid]; st[5] = c[tid + 512]; st[6] = d[tid];
    };
    auto commit = [&]() {
#pragma unroll
        for (int l = 0; l < 2; ++l) { const int idx = tid + 512 * l;
            *(LAS u32x4*)(lds + SKC + (idx >> 4) * 272 + (idx & 15) * 16) = st[l];
            *(LAS u32x4*)(lds + SQD + (idx >> 4) * 272 + (idx & 15) * 16) = st[2 + l];
            *(LAS u32x4*)(lds + SKD + (idx >> 3) * 144 + (idx & 7) * 16) = st[4 + l]; }
        *(LAS u32x4*)(lds + SQK + (tid >> 3) * 144 + (tid & 7) * 16) = st[6];
    };
    auto put_St = [&]() {
#pragma unroll
        for (int vt = 0; vt < 2; ++vt) { u32x2 w; w.x = pk2(accS[vt][0], accS[vt][1]); w.y = pk2(accS[vt][2], accS[vt][3]);
            *(LAS u32x2*)(lds + SST + (vt * 16 + r16) * 272 + (dk0 + 4 * fq) * 2) = w; }
    };
    lds_sync();
    issue(ch0); put_St(); commit();
    lds_sync();
    const int c0 = (wid & 3) * 16, v0 = (wid >> 2) * 16;
    u32x2 wv_n = *(const u32x2*)(gWV + (size_t)ch0 * 8192 + (dvoff + v0 + r16) * 64 + c0 + 4 * fq);
    float gtot_n = gGT[ch0];
    for (int n = 0; n < nch; ++n) {
        const int ci = ch0 + n;
        const u32x2 wv = wv_n; const float gtot = gtot_n;
        if (n + 1 < nch) { issue(ci + 1); wv_n = *(const u32x2*)(gWV + (size_t)(ci + 1) * 8192 + (dvoff + v0 + r16) * 64 + c0 + 4 * fq); gtot_n = gGT[ci + 1]; }
        f32x4 a1 = {0.f, 0.f, 0.f, 0.f};
        { bf16x8 fa[4], fb[4];
#pragma unroll
          for (int ks = 0; ks < 4; ++ks) { fa[ks] = lds_ld8(lds + SKC + (c0 + r16) * 272 + ks * 64 + fq * 16); fb[ks] = lds_ld8(lds + SST + (v0 + r16) * 272 + ks * 64 + fq * 16); }
          pin4x4(fa, fb);
#pragma unroll
          for (int ks = 0; ks < 4; ++ks) a1 = mfma16(fa[ks], fb[ks], a1); }
        { u32x2 w; w.x = pk2(bflo(wv.x) - a1[0], bfhi(wv.x) - a1[1]); w.y = pk2(bflo(wv.y) - a1[2], bfhi(wv.y) - a1[3]);
          *(LAS u32x2*)(lds + SUT + (v0 + r16) * 144 + (c0 + 4 * fq) * 2) = w; }
        lds_sync();
        f32x4 a2 = {0.f, 0.f, 0.f, 0.f};
        bf16x8 ga[8], gb[8];
#pragma unroll
        for (int ks = 0; ks < 4; ++ks) { ga[ks] = lds_ld8(lds + SST + (v0 + r16) * 272 + ks * 64 + fq * 16); gb[ks] = lds_ld8(lds + SQD + (c0 + r16) * 272 + ks * 64 + fq * 16); }
#pragma unroll
        for (int ks = 0; ks < 2; ++ks) { ga[4 + ks] = lds_ld8(lds + SUT + (v0 + r16) * 144 + ks * 64 + fq * 16); gb[4 + ks] = lds_ld8(lds + SQK + (c0 + r16) * 144 + ks * 64 + fq * 16); }
#pragma unroll
        for (int ks = 0; ks < 2; ++ks) { ga[6 + ks] = lds_ld8(lds + SKD + (dk0 + r16) * 144 + ks * 64 + fq * 16); gb[6 + ks] = lds_ld8(lds + SUT + ((1 - (wid >> 2)) * 16 + r16) * 144 + ks * 64 + fq * 16); }
        pin8x8(ga, gb);
#pragma unroll
        for (int ks = 0; ks < 6; ++ks) a2 = mfma16(ga[ks], gb[ks], a2);
        if (c0 + r16 < nvalid) { u32x2 w; w.x = pk2(a2[0], a2[1]); w.y = pk2(a2[2], a2[3]);
            *(u32x2*)(O0 + (size_t)(rowbase + n * 64 + c0 + r16) * 1024 + h * 128 + dvoff + v0 + 4 * fq) = w; }
#pragma unroll
        for (int vt = 0; vt < 2; ++vt) {
            accS[vt] *= gtot;
            const bool own = (vt == (wid >> 2));
#pragma unroll
            for (int ks = 0; ks < 2; ++ks) accS[vt] = mfma16(ga[6 + ks], own ? ga[4 + ks] : gb[6 + ks], accS[vt]);
        }
        lds_sync();
        put_St();
        if (n + 1 < nch) commit();
        lds_sync();
    }
#pragma unroll
    for (int vt = 0; vt < 2; ++vt)
#pragma unroll
        for (int r = 0; r < 4; ++r) Sout[(size_t)(dk0 + 4 * fq + r) * 128 + dvoff + vt * 16 + r16] = accS[vt][r];
}
DI void phase_scan(const Params& p, LAS unsigned char* lds) {
    const int bid = blockIdx.x, G = gridDim.x;
    if (G == 256) {
        const int xcd = bid & 7, idx = bid >> 3, dvs = idx & 3, hx = xcd * 8 + (idx >> 2);
        scan_item(p, lds, hx * 4 + dvs);
        for (int i = 0; i < 4; ++i) scan_item(p, lds, 256 + (i * 64 + hx) * 4 + dvs);
    } else {
        for (int it = bid; it < 256 + 1024; it += G) scan_item(p, lds, it);
    }
}

DI void phase_gate0(const Params& p) {
    const int lane = TID() & 63, wid = TID() >> 6;
    const bf16_t* O0 = (const bf16_t*)(p.ws + WS_O0); const bf16_t* P0 = (const bf16_t*)(p.ws + WS_P0); bf16_t* ACT = (bf16_t*)(p.ws + WS_ACT);
    const float* og = p.in[I_AOG] + (lane & 7) * 16;
    const int nw = gridDim.x * 8;
    auto ld_row = [&](int row, u32x4 (&r)[4]) {
        const u32x4* so = (const u32x4*)(O0 + (size_t)row * 1024 + lane * 16); const u32x4* sz = (const u32x4*)(P0 + (size_t)row * 4096 + 3072 + lane * 16);
        r[0] = so[0]; r[1] = so[1]; r[2] = sz[0]; r[3] = sz[1];
    };
    auto do_row = [&](int row, const u32x4 (&r)[4]) {
        float o[16], z[16];
#pragma unroll
        for (int q = 0; q < 2; ++q) { const u32x4 a = r[q], b = r[2 + q];
            o[q * 8] = bflo(a.x); o[q * 8 + 1] = bfhi(a.x); o[q * 8 + 2] = bflo(a.y); o[q * 8 + 3] = bfhi(a.y); o[q * 8 + 4] = bflo(a.z); o[q * 8 + 5] = bfhi(a.z); o[q * 8 + 6] = bflo(a.w); o[q * 8 + 7] = bfhi(a.w);
            z[q * 8] = bflo(b.x); z[q * 8 + 1] = bfhi(b.x); z[q * 8 + 2] = bflo(b.y); z[q * 8 + 3] = bfhi(b.y); z[q * 8 + 4] = bflo(b.z); z[q * 8 + 5] = bfhi(b.z); z[q * 8 + 6] = bflo(b.w); z[q * 8 + 7] = bfhi(b.w); }
        float ss = 0.f;
#pragma unroll
        for (int j = 0; j < 16; ++j) ss += o[j] * o[j];
        ss += dpp_f<0xB1>(ss); ss += dpp_f<0x4E>(ss); ss += dpp_f<0x141>(ss);
        const float rstd = rsqrtf(ss * (1.f / 128.f) + EPS);
        float rr[16];
#pragma unroll
        for (int j = 0; j < 16; ++j) rr[j] = o[j] * rstd * og[j] * siluf(z[j]);
        u32x4 w0, w1;
        w0.x = pk2(rr[0], rr[1]); w0.y = pk2(rr[2], rr[3]); w0.z = pk2(rr[4], rr[5]); w0.w = pk2(rr[6], rr[7]);
        w1.x = pk2(rr[8], rr[9]); w1.y = pk2(rr[10], rr[11]); w1.z = pk2(rr[12], rr[13]); w1.w = pk2(rr[14], rr[15]);
        u32x4* d = (u32x4*)(ACT + (size_t)row * 1024 + lane * 16); d[0] = w0; d[1] = w1;
    };
    for (int row = blockIdx.x * 8 + wid; row < MT; row += 4 * nw) {
        u32x4 ra[4], rb[4], rc[4], rd[4];
        const int r1 = row + nw, r2 = row + 2 * nw, r3 = row + 3 * nw;
        if (r3 < MT) { ld_row(row, ra); ld_row(r1, rb); ld_row(r2, rc); ld_row(r3, rd); pin4x4x4x4(ra, rb, rc, rd); do_row(row, ra); do_row(r1, rb); do_row(r2, rc); do_row(r3, rd); }
        else { ld_row(row, ra); do_row(row, ra); if (r1 < MT) { ld_row(r1, rb); do_row(r1, rb); } if (r2 < MT) { ld_row(r2, rc); do_row(r2, rc); } }
    }
}

constexpr int AK = 0, AV = 73984;
struct AttnPre { u32x4 k[8]; u32x4 v[8]; bf16x8 q[4]; };
struct AttnIt { int g, b, h, r, j0, d, Sd; };
DI AttnIt attn_decode(int item) {
    AttnIt a; const int x = item & 15; a.h = (item >> 4) & 7; a.b = (item >> 7) & 7; a.g = item >> 10;
    const int dshift = a.g * 2; a.d = 1 << dshift; a.Sd = 2048 >> dshift; const int nqb = a.Sd >> 7;
    a.r = x / nqb; a.j0 = (x % nqb) * 128; return a;
}
DI void attn_issue(const Params& p, int item, AttnPre& pre) {
    const int tid = TID(), lane = tid & 63, wid = tid >> 6, r16 = lane & 15, fq = lane >> 4;
    const AttnIt a = attn_decode(item);
    const bf16_t* base = (const bf16_t*)(p.ws + WS_P1) + (size_t)a.b * 2048 * 10240 + a.g * 1024 + a.h * 128;
    const size_t rstride = (size_t)a.d * 10240;
    const bf16_t* kbase = base + (long)((a.j0 - 128) * a.d + a.r) * 10240;
    const int kg = tid >> 4, ec = tid & 15;
    if (a.j0 != 0) {
#pragma unroll
        for (int k = 0; k < 8; ++k) { const int idx = tid + 512 * k; pre.k[k] = *(const u32x4*)(kbase + (size_t)(idx >> 4) * rstride + 3072 + (idx & 15) * 8); }
#pragma unroll
        for (int i = 0; i < 8; ++i) pre.v[i] = *(const u32x4*)(kbase + (size_t)(kg * 8 + i) * rstride + 6144 + ec * 8);
    } else {
#pragma unroll
        for (int k = 0; k < 4; ++k) pre.k[k] = (u32x4){0u, 0u, 0u, 0u};
#pragma unroll
        for (int k = 4; k < 8; ++k) { const int idx = tid + 512 * k; pre.k[k] = *(const u32x4*)(kbase + (size_t)(idx >> 4) * rstride + 3072 + (idx & 15) * 8); }
#pragma unroll
        for (int i = 0; i < 8; ++i) { pre.v[i] = (u32x4){0u, 0u, 0u, 0u}; if (tid >= 256) pre.v[i] = *(const u32x4*)(kbase + (size_t)(kg * 8 + i) * rstride + 6144 + ec * 8); }
    }
    const int qtok = (a.j0 + 16 * wid + r16) * a.d + a.r;
#pragma unroll
    for (int ks = 0; ks < 4; ++ks) pre.q[ks] = *(const bf16x8*)(base + (size_t)qtok * 10240 + ks * 32 + fq * 8);
}
DI void st_f32x8_from_bf16(float* d, u32x4 w) {
    *(f32x4*)d = (f32x4){bflo(w.x), bfhi(w.x), bflo(w.y), bfhi(w.y)}; *(f32x4*)(d + 4) = (f32x4){bflo(w.z), bfhi(w.z), bflo(w.w), bfhi(w.w)};
}
DI void attn_commit(LAS unsigned char* lds, const AttnPre& pre, const Params& p, int item) {
    const int tid = TID();
    const AttnIt a = attn_decode(item);
#pragma unroll
    for (int k = 0; k < 8; ++k) { const int idx = tid + 512 * k; *(LAS u32x4*)(lds + AK + (idx >> 4) * 272 + (idx & 15) * 16) = pre.k[k]; }
    const int kg = tid >> 4, ec = tid & 15;
#pragma unroll
    for (int e2 = 0; e2 < 4; ++e2) {
        u32x4 lo, hi;
#pragma unroll
        for (int pq = 0; pq < 4; ++pq) { const unsigned x0 = pre.v[2 * pq][e2], x1 = pre.v[2 * pq + 1][e2]; lo[pq] = (x0 & 0xffffu) | (x1 << 16); hi[pq] = (x0 >> 16) | (x1 & 0xffff0000u); }
        *(LAS u32x4*)(lds + AV + (ec * 8 + 2 * e2) * 560 + kg * 16) = lo;
        *(LAS u32x4*)(lds + AV + (ec * 8 + 2 * e2 + 1) * 560 + kg * 16) = hi;
    }
}
DI void attn_compute(const Params& p, LAS unsigned char* lds, int item, const bf16x8 (&qf)[4]) {
    const int tid = TID(), lane = tid & 63, wid = tid >> 6, r16 = lane & 15, fq = lane >> 4;
    const AttnIt a = attn_decode(item);
    const int g = a.g, b = a.b, h = a.h;
    const int qj = a.j0 + 16 * wid + r16, qtok = qj * a.d + a.r;
    f32x4 s[10];
    const LAS unsigned char* kbase = lds + AK + (16 * wid + r16) * 272 + fq * 16;
#pragma unroll
    for (int T2 = 0; T2 < 5; ++T2) {
        bf16x8 kf[8];
#pragma unroll
        for (int u = 0; u < 8; ++u) { const int T = 2 * T2 + (u >> 2); kf[u] = lds_ld8(kbase + (T < 9 ? T : 8) * (16 * 272) + (u & 3) * 64); }
        pin8(kf);
#pragma unroll
        for (int u = 0; u < 8; ++u) { const int T = 2 * T2 + (u >> 2); if (T < 9) { if ((u & 3) == 0) s[T] = (f32x4){0.f, 0.f, 0.f, 0.f}; s[T] = mfma16(kf[u], qf[u & 3], s[T]); } }
    }
#pragma unroll
    for (int rr = 0; rr < 4; ++rr) {
        if (r16 - 4 * fq - rr > 0) s[0][rr] = -INFINITY;
        if (r16 - 4 * fq - rr < 0) s[8][rr] = -INFINITY;
    }
    if (a.j0 == 0) {
#pragma unroll
        for (int T = 0; T < 9; ++T)
#pragma unroll
            for (int rr = 0; rr < 4; ++rr) { const int rel = 128 + r16 - 16 * T - 4 * fq - rr; if (qj - rel < 0) s[T][rr] = -INFINITY; }
    }
    float m = -INFINITY;
#pragma unroll
    for (int T = 0; T < 9; ++T) m = fmaxf(m, fmaxf(fmaxf(s[T][0], s[T][1]), fmaxf(s[T][2], s[T][3])));
    m = fmaxf(m, __shfl_xor(m, 16)); m = fmaxf(m, __shfl_xor(m, 32));
    float l = 0.f;
#pragma unroll
    for (int T = 0; T < 9; ++T)
#pragma unroll
        for (int rr = 0; rr < 4; ++rr) { const float pv = __builtin_amdgcn_exp2f(s[T][rr] - m); s[T][rr] = pv; l += pv; }
    s[9] = (f32x4){0.f, 0.f, 0.f, 0.f};
    l += __shfl_xor(l, 16); l += __shfl_xor(l, 32);
    f32x4 o[8];
#pragma unroll
    for (int et = 0; et < 8; ++et) o[et] = (f32x4){0.f, 0.f, 0.f, 0.f};
    const LAS unsigned char* vbase = lds + AV + r16 * 560 + (16 * wid + 4 * fq) * 2;
#pragma unroll
    for (int tp = 0; tp < 5; ++tp) {
        u32x4 pb; pb.x = pk2(s[2 * tp][0], s[2 * tp][1]); pb.y = pk2(s[2 * tp][2], s[2 * tp][3]); pb.z = pk2(s[2 * tp + 1][0], s[2 * tp + 1][1]); pb.w = pk2(s[2 * tp + 1][2], s[2 * tp + 1][3]);
        const bf16x8 pf = __builtin_bit_cast(bf16x8, pb);
        u32x4 vv[8];
#pragma unroll
        for (int et = 0; et < 8; ++et) {
            const LAS unsigned char* vp = vbase + et * (16 * 560) + tp * 64;
            const u32x2 va = *(const LAS u32x2*)vp, vb = *(const LAS u32x2*)(vp + 32);
            vv[et] = (u32x4){va.x, va.y, vb.x, vb.y};
        }
        pin8(vv);
#pragma unroll
        for (int et = 0; et < 8; ++et) o[et] = mfma16(__builtin_bit_cast(bf16x8, vv[et]), pf, o[et]);
    }
    const float il = 1.f / l;
    const size_t orow = (size_t)b * 2048 + qtok;
    bf16_t* og = (bf16_t*)(p.ws + WS_OG) + ((size_t)g * MT + orow) * 1024 + h * 128;
#pragma unroll
    for (int et = 0; et < 8; ++et) { u32x2 w; w.x = pk2(o[et][0] * il, o[et][1] * il); w.y = pk2(o[et][2] * il, o[et][3] * il); *(u32x2*)(og + 16 * et + 4 * fq) = w; }
    if (fq == 0) ((float*)(p.ws + WS_LSE))[((size_t)g * MT + orow) * 8 + h] = 0.6931471805599453f * (m + log2f(l));
}
DI void attn_prompt_all(const Params& p, LAS unsigned char* lds) {
    const int tid = TID();
    lds_sync();
    if (tid < 256) *(LAS u32x4*)(lds + AK + (256 + (tid >> 4)) * 272 + (tid & 15) * 16) = (u32x4){0u, 0u, 0u, 0u};
    else { const int t2 = tid - 256; *(LAS u32x4*)(lds + AV + (t2 >> 1) * 560 + (256 + (t2 & 1) * 8) * 2) = (u32x4){0u, 0u, 0u, 0u}; }
    AttnPre pre;
    const int bid = blockIdx.x, G = gridDim.x, nround = G == 256 ? 12 : (3072 - bid + G - 1) / G;
    auto item_of = [&](int i) { return G == 256 ? ((i * 16 + (bid & 7) * 2 + (bid >> 7)) * 16 + ((bid >> 3) & 15)) : bid + i * G; };
    if (nround > 0) attn_issue(p, item_of(0), pre);
    for (int i = 0; i < nround; ++i) {
        const int it = item_of(i);
        lds_sync();
        attn_commit(lds, pre, p, it);
        bf16x8 qf[4];
#pragma unroll
        for (int ks = 0; ks < 4; ++ks) qf[ks] = pre.q[ks];
        if (i + 1 < nround) attn_issue(p, item_of(i + 1), pre);
        lds_sync();
        attn_compute(p, lds, it, qf);
    }
    lds_sync();
}
DI void attn_sample_item(const Params& p, LAS unsigned char* lds, int witem) {
    const int lane = TID() & 63, wid = TID() >> 6;
    const int h = witem & 7, l = (witem >> 3) & 7, bg = witem >> 6, g = bg % 3, b = bg / 3;
    const int d = 1 << (2 * g), Lbuf = 128 << (2 * g);
    const float* cache = p.in[I_C128 + g] + (size_t)b * Lbuf * 2048;
    const float* fresh = p.out + (g == 0 ? O_KVS0 : (g == 1 ? O_KVS1 : O_KVS2)) + (size_t)b * 8 * 2048;
    const int row = MP + b * 8 + l;
    const bf16_t* qp = (const bf16_t*)(p.ws + WS_P1) + (size_t)row * 10240 + g * 1024 + h * 128;
    LAS float* sc = (LAS float*)lds + wid * 136;
    const int sub = lane & 15, kq = lane >> 4;
    float q[8];
    { const u32x2 a = *(const u32x2*)(qp + sub * 4), c = *(const u32x2*)(qp + 64 + sub * 4);
      q[0] = bflo(a.x); q[1] = bfhi(a.x); q[2] = bflo(a.y); q[3] = bfhi(a.y); q[4] = bflo(c.x); q[5] = bfhi(c.x); q[6] = bflo(c.y); q[7] = bfhi(c.y); }
#pragma unroll 1
    for (int bt = 0; bt < 4; ++bt) {
        f32x4 ka[8], kb[8];
#pragma unroll
        for (int u = 0; u < 8; ++u) {
            const int mk = (bt * 8 + u) * 4 + kq, idx = Lbuf + l - d * mk;
            const float* kr = (idx >= Lbuf ? fresh + (size_t)(idx - Lbuf) * 2048 : cache + (size_t)idx * 2048) + h * 128 + sub * 4;
            ka[u] = *(const f32x4*)kr; kb[u] = *(const f32x4*)(kr + 64);
        }
        asm volatile("" ::: "memory");
        float dots[8];
#pragma unroll
        for (int u = 0; u < 8; ++u) dots[u] = q[0] * ka[u][0] + q[1] * ka[u][1] + q[2] * ka[u][2] + q[3] * ka[u][3] + q[4] * kb[u][0] + q[5] * kb[u][1] + q[6] * kb[u][2] + q[7] * kb[u][3];
#pragma unroll
        for (int u = 0; u < 8; ++u) dots[u] = row16_sum(dots[u]);
#pragma unroll
        for (int u = 0; u < 8; ++u) sc[(bt * 8 + u) * 4 + kq] = dots[u];
    }
    {
        const int idx = Lbuf + l - d * 128;
        const float* kr = cache + (size_t)idx * 2048 + h * 128 + sub * 4;
        const f32x4 k0 = *(const f32x4*)kr, k1 = *(const f32x4*)(kr + 64);
        float dot = q[0] * k0[0] + q[1] * k0[1] + q[2] * k0[2] + q[3] * k0[3] + q[4] * k1[0] + q[5] * k1[1] + q[6] * k1[2] + q[7] * k1[3];
        dot = row16_sum(dot);
        sc[128 + kq] = dot;
    }
    __builtin_amdgcn_s_waitcnt(0xc07f);
    __builtin_amdgcn_wave_barrier();
    const float s0 = sc[lane], s1 = sc[64 + lane], s2 = lane == 0 ? sc[128] : -INFINITY;
    const float m = wave_max(fmaxf(fmaxf(s0, s1), s2));
    const float p0 = exp2f(s0 - m), p1 = exp2f(s1 - m), p2 = lane == 0 ? exp2f(s2 - m) : 0.f;
    const float lsum = wave_sum(p0 + p1 + p2);
    __builtin_amdgcn_wave_barrier();
    sc[lane] = p0; sc[64 + lane] = p1; if (lane == 0) sc[128] = p2;
    __builtin_amdgcn_s_waitcnt(0xc07f);
    __builtin_amdgcn_wave_barrier();
    const int half = lane >> 5, l32 = lane & 31;
    f32x4 o = {0.f, 0.f, 0.f, 0.f};
#pragma unroll 1
    for (int bt = 0; bt < 8; ++bt) {
        f32x4 vb[8]; float pw[8];
#pragma unroll
        for (int u = 0; u < 8; ++u) {
            const int mk = 2 * (bt * 8 + u) + half, idx = Lbuf + l - d * mk;
            const float* vr = (idx >= Lbuf ? fresh + (size_t)(idx - Lbuf) * 2048 : cache + (size_t)idx * 2048) + 1024 + h * 128 + l32 * 4;
            vb[u] = *(const f32x4*)vr; pw[u] = sc[mk];
        }
        asm volatile("" ::: "memory");
#pragma unroll
        for (int u = 0; u < 8; ++u) o += pw[u] * vb[u];
    }
    { const int idx = Lbuf + l - d * 128;
      const f32x4 v = *(const f32x4*)(cache + (size_t)idx * 2048 + 1024 + h * 128 + l32 * 4); const float pw = half ? 0.f : sc[128];
      o += pw * v; }
    o[0] += __shfl_xor(o[0], 32); o[1] += __shfl_xor(o[1], 32); o[2] += __shfl_xor(o[2], 32); o[3] += __shfl_xor(o[3], 32);
    const float il = 1.f / lsum;
    if (half == 0) { u32x2 w; w.x = pk2(o[0] * il, o[1] * il); w.y = pk2(o[2] * il, o[3] * il);
        *(u32x2*)((bf16_t*)(p.ws + WS_OG) + ((size_t)g * MT + row) * 1024 + h * 128 + l32 * 4) = w; }
    if (lane == 0) ((float*)(p.ws + WS_LSE))[((size_t)g * MT + row) * 8 + h] = 0.6931471805599453f * (m + log2f(lsum));
    __builtin_amdgcn_wave_barrier();
}
DI void attn_sample_all(const Params& p, LAS unsigned char* lds) {
    const int bid = blockIdx.x, G = gridDim.x, wv = TID() >> 6;
    if (G == 256) { for (int i = 0; i < 3; ++i) { const int bg = i * 32 + (bid & 7) * 4 + (bid >> 6), l = (bid >> 3) & 7; attn_sample_item(p, lds, (bg * 8 + l) * 8 + wv); } }
    else for (int it = bid; it < 768; it += G) attn_sample_item(p, lds, it * 8 + wv);
}
DI void phase_attn(const Params& p, LAS unsigned char* lds) {
    if (blockIdx.x & 1) { attn_sample_all(p, lds); __syncthreads(); }
    attn_prompt_all(p, lds);
    if (!(blockIdx.x & 1)) attn_sample_all(p, lds);
}

DI void phase_gate1(const Params& p) {
    const int lane = TID() & 63, wid = TID() >> 6;
    const bf16_t* OG = (const bf16_t*)(p.ws + WS_OG); const bf16_t* P1 = (const bf16_t*)(p.ws + WS_P1); const float* LSE = (const float*)(p.ws + WS_LSE);
    bf16_t* ACT = (bf16_t*)(p.ws + WS_ACT);
    const int nw = gridDim.x * 8, hd = lane >> 3;
    auto ld_row = [&](int row, u32x4 (&r)[8], float (&ls)[3]) {
#pragma unroll
        for (int g = 0; g < 3; ++g) { const u32x4* so = (const u32x4*)(OG + ((size_t)g * MT + row) * 1024 + lane * 16); r[2 * g] = so[0]; r[2 * g + 1] = so[1]; ls[g] = LSE[((size_t)g * MT + row) * 8 + hd]; }
        const u32x4* sz = (const u32x4*)(P1 + (size_t)row * 10240 + 9216 + lane * 16); r[6] = sz[0]; r[7] = sz[1];
    };
    auto do_row = [&](int row, const u32x4 (&r)[8], const float (&ls)[3]) {
        const float mx = fmaxf(ls[0], fmaxf(ls[1], ls[2]));
        float w[3] = {__expf(ls[0] - mx), __expf(ls[1] - mx), __expf(ls[2] - mx)};
        const float iw = 1.f / (w[0] + w[1] + w[2]);
        float acc[16];
#pragma unroll
        for (int j = 0; j < 16; ++j) acc[j] = 0.f;
#pragma unroll
        for (int g = 0; g < 3; ++g) {
            const float wg = w[g] * iw;
#pragma unroll
            for (int q = 0; q < 2; ++q) { const u32x4 a = r[2 * g + q];
                acc[q * 8] += wg * bflo(a.x); acc[q * 8 + 1] += wg * bfhi(a.x); acc[q * 8 + 2] += wg * bflo(a.y); acc[q * 8 + 3] += wg * bfhi(a.y);
                acc[q * 8 + 4] += wg * bflo(a.z); acc[q * 8 + 5] += wg * bfhi(a.z); acc[q * 8 + 6] += wg * bflo(a.w); acc[q * 8 + 7] += wg * bfhi(a.w); }
        }
        float z[16];
#pragma unroll
        for (int q = 0; q < 2; ++q) { const u32x4 b = r[6 + q];
            z[q * 8] = bflo(b.x); z[q * 8 + 1] = bfhi(b.x); z[q * 8 + 2] = bflo(b.y); z[q * 8 + 3] = bfhi(b.y); z[q * 8 + 4] = bflo(b.z); z[q * 8 + 5] = bfhi(b.z); z[q * 8 + 6] = bflo(b.w); z[q * 8 + 7] = bfhi(b.w); }
        float rr[16];
#pragma unroll
        for (int j = 0; j < 16; ++j) rr[j] = acc[j] * siluf(z[j]);
        u32x4 w0, w1;
        w0.x = pk2(rr[0], rr[1]); w0.y = pk2(rr[2], rr[3]); w0.z = pk2(rr[4], rr[5]); w0.w = pk2(rr[6], rr[7]);
        w1.x = pk2(rr[8], rr[9]); w1.y = pk2(rr[10], rr[11]); w1.z = pk2(rr[12], rr[13]); w1.w = pk2(rr[14], rr[15]);
        u32x4* d = (u32x4*)(ACT + (size_t)row * 1024 + lane * 16); d[0] = w0; d[1] = w1;
    };
    for (int row = blockIdx.x * 8 + wid; row < MT; row += 2 * nw) {
        u32x4 ra[8], rb[8]; float la[3], lb[3];
        const int rowb = row + nw;
        ld_row(row, ra, la);
        if (rowb < MT) { ld_row(rowb, rb, lb); pin8x8(ra, rb); }
        do_row(row, ra, la);
        if (rowb < MT) do_row(rowb, rb, lb);
    }
}

DI void phase_final(const Params& p) {
    const int lane = TID() & 63, wid = TID() >> 6;
    const float* fg = p.in[I_FNG];
    const int nw = gridDim.x * 8;
    auto ld_row = [&](int row, f32x4 (&v)[4]) {
        const float* x = p.out + (size_t)row * 1024;
#pragma unroll
        for (int i = 0; i < 4; ++i) v[i] = *(const f32x4*)(x + lane * 4 + 256 * i);
    };
    f32x4 gg[4];
#pragma unroll
    for (int i = 0; i < 4; ++i) gg[i] = *(const f32x4*)(fg + lane * 4 + 256 * i);
    auto do_row = [&](int row, const f32x4 (&v)[4]) {
        float* x = p.out + (size_t)row * 1024;
        float ss = 0.f;
#pragma unroll
        for (int i = 0; i < 4; ++i) ss += v[i][0] * v[i][0] + v[i][1] * v[i][1] + v[i][2] * v[i][2] + v[i][3] * v[i][3];
        ss = wave_sum(ss);
        const float rstd = rsqrtf(ss * (1.f / 1024.f) + EPS);
#pragma unroll
        for (int i = 0; i < 4; ++i) *(f32x4*)(x + lane * 4 + 256 * i) = v[i] * rstd * gg[i];
    };
    for (int row = blockIdx.x * 8 + wid; row < MT; row += 4 * nw) {
        f32x4 va[4], vb[4], vc[4], vd[4];
        const int r1 = row + nw, r2 = row + 2 * nw, r3 = row + 3 * nw;
        if (r3 < MT) { ld_row(row, va); ld_row(r1, vb); ld_row(r2, vc); ld_row(r3, vd); pin4x4x4x4(va, vb, vc, vd); do_row(row, va); do_row(r1, vb); do_row(r2, vc); do_row(r3, vd); }
        else { ld_row(row, va); do_row(row, va); if (r1 < MT) { ld_row(r1, vb); do_row(r1, vb); } if (r2 < MT) { ld_row(r2, vc); do_row(r2, vc); } }
    }
}

#define XB_TMO      128
#define XB_XCNT(j)  (256  + 64 * (j))
#define XB_XSUB(j)  (1280 + 64 * (j))
#define XB_XGEN(j)  (2304 + 64 * (j))
#define XB_TOP      3328
#define XB_TOPGEN   3392
#define XCD_BAR_WORDS 3456
#define XB_SPIN_CAP (1u << 20)
DI unsigned xb_ld(unsigned* p)              { return __hip_atomic_load(p, __ATOMIC_RELAXED, __HIP_MEMORY_SCOPE_AGENT); }
DI unsigned xb_add(unsigned* p, unsigned v) { return __hip_atomic_fetch_add(p, v, __ATOMIC_RELAXED, __HIP_MEMORY_SCOPE_AGENT); }
DI unsigned xb_xcc_id() { return (unsigned)__builtin_amdgcn_s_getreg((3 << 11) | 20) & 0xFu; }
#define XB_SPIN(cond, bar) do { unsigned _sp = 0; while (cond) { __builtin_amdgcn_s_sleep(1); \
    if ((++_sp & 255u) == 0u) { if (xb_ld(&(bar)[XB_TMO])) break; if (_sp > XB_SPIN_CAP) { atomicAdd(&(bar)[XB_TMO], 1u); break; } } } } while (0)
struct XcdBarrier { unsigned* bar; unsigned x; volatile LAS unsigned* st; };
DI XcdBarrier xcd_barrier_post(unsigned* bar, volatile LAS unsigned* st) {
    XcdBarrier b; b.bar = bar; b.x = xb_xcc_id(); b.st = st;
    if (threadIdx.x == 0) (void)xb_add(&bar[XB_XCNT(b.x)], 1u);
    return b;
}
DI void xcd_barrier_complete(unsigned* bar, unsigned x, unsigned& nloc, unsigned& nx) {
    const unsigned G = gridDim.x * gridDim.y * gridDim.z;
    unsigned sum, cnt, mine, sp = 0u;
    for (;;) {
        sum = 0u; cnt = 0u; mine = 0u;
#pragma unroll
        for (unsigned j = 0; j < 16; ++j) { const unsigned c = xb_ld(&bar[XB_XCNT(j)]); sum += c; cnt += (c > 0u) ? 1u : 0u; mine = (j == x) ? c : mine; }
        if (sum == G) break;
        __builtin_amdgcn_s_sleep(1);
        if ((++sp & 255u) == 0u) { if (xb_ld(&bar[XB_TMO])) break; if (sp > XB_SPIN_CAP) { atomicAdd(&bar[XB_TMO], 1u); break; } }
    }
    nloc = mine > 0u ? mine : 1u; nx = cnt > 0u ? cnt : 1u;
}
DI void xcd_barrier(const XcdBarrier& b) {
    asm volatile("s_waitcnt vmcnt(0)" ::: "memory");
    __syncthreads();
    if (threadIdx.x == 0) {
        unsigned* bar = b.bar;
        __builtin_amdgcn_s_waitcnt(0);
        unsigned nloc = b.st[0], nx = b.st[1];
        if (nloc == 0u) { xcd_barrier_complete(bar, b.x, nloc, nx); b.st[0] = nloc; b.st[1] = nx; }
        const unsigned old = xb_add(&bar[XB_XSUB(b.x)], 1u);
        const unsigned gen = old / nloc;
        if (old + 1u == (gen + 1u) * nloc) {
            __builtin_amdgcn_fence(__ATOMIC_RELEASE, "agent");
            asm volatile("s_waitcnt vmcnt(0)" ::: "memory");
            const unsigned og = xb_add(&bar[XB_TOP], 1u);
            const unsigned tg = og / nx;
            if (og + 1u == (tg + 1u) * nx) xb_add(&bar[XB_TOPGEN], 1u);
            else XB_SPIN(xb_ld(&bar[XB_TOPGEN]) == tg, bar);
            __builtin_amdgcn_fence(__ATOMIC_ACQUIRE, "agent");
            xb_add(&bar[XB_XGEN(b.x)], 1u);
            asm volatile("s_waitcnt vmcnt(0)" ::: "memory");
        } else {
            XB_SPIN(xb_ld(&bar[XB_XGEN(b.x)]) == gen, bar);
            __builtin_amdgcn_fence(__ATOMIC_ACQUIRE, "agent");
            asm volatile("s_waitcnt vmcnt(0)" ::: "memory");
        }
    }
    __syncthreads();
}

#ifndef EXTRA_SYNCS
#define EXTRA_SYNCS 0
#endif

#ifndef DUP_MASK
#define DUP_MASK 0u
#endif
__global__ void __launch_bounds__(512, 2) hybrid_fwd(Params p) {
    extern __shared__ __attribute__((aligned(16))) unsigned char shm[];
    LAS unsigned char* lds = (LAS unsigned char*)shm;
    cg::grid_group grid = cg::this_grid();
    const float* MOD = (const float*)(p.ws + WS_MOD);
    bf16_t* ACT = (bf16_t*)(p.ws + WS_ACT);
    bf16_t* X1 = (bf16_t*)(p.ws + WS_X1);
    if (p.ws == nullptr) grid.sync();
    volatile LAS unsigned* xst = (volatile LAS unsigned*)(lds + LDS_BYTES - 16);
    if (threadIdx.x == 0) { xst[0] = 0u; xst[1] = 0u; }
    __syncthreads();
    const XcdBarrier xb = xcd_barrier_post((unsigned*)(p.ws + WS_BAR), xst);

    for (int rep = 0; rep < EXTRA_SYNCS; ++rep) xcd_barrier(xb);
    for (int rep = 0; rep < 1 + (int)((DUP_MASK >> 0) & 1u); ++rep) {
    phase_prep(p, lds);
    xcd_barrier(xb);
    }
    for (int rep = 0; rep < 1 + (int)((DUP_MASK >> 1) & 1u); ++rep) {
    phase_norm<true>(p, lds, p.in[I_XP], p.in[I_XS], 0);
    xcd_barrier(xb);
    }
    for (int rep = 0; rep < 1 + (int)((DUP_MASK >> 2) & 1u); ++rep) {
    { EpiA e{(bf16_t*)(p.ws + WS_P0), p.out}; gemm_all(lds, ACT, (const bf16_t*)(p.ws + WS_WTA), 4096, e); }
    xcd_barrier(xb);
    }
    for (int rep = 0; rep < 1 + (int)((DUP_MASK >> 3) & 1u); ++rep) {
    phase_dprep(p, lds);
    xcd_barrier(xb);
    }
    for (int rep = 0; rep < 1 + (int)((DUP_MASK >> 4) & 1u); ++rep) {
    phase_scan(p, lds);
    xcd_barrier(xb);
    }
    for (int rep = 0; rep < 1 + (int)((DUP_MASK >> 5) & 1u); ++rep) {
    phase_gate0(p);
    xcd_barrier(xb);
    }
    for (int rep = 0; rep < 1 + (int)((DUP_MASK >> 6) & 1u); ++rep) {
    { EpiRes<float, bf16_t> e{p.in[I_XP], p.in[I_XS], MOD, X1}; gemm_all(lds, ACT, (const bf16_t*)(p.ws + WS_WTAO), 1024, e); }
    xcd_barrier(xb);
    }
    for (int rep = 0; rep < 1 + (int)((DUP_MASK >> 7) & 1u); ++rep) {
    phase_norm1(p);
    xcd_barrier(xb);
    }
    for (int rep = 0; rep < 1 + (int)((DUP_MASK >> 8) & 1u); ++rep) {
    { EpiB e{(bf16_t*)(p.ws + WS_P1), p.out}; gemm_all(lds, ACT, (const bf16_t*)(p.ws + WS_WTB), 10240, e); }
    xcd_barrier(xb);
    }
    for (int rep = 0; rep < 1 + (int)((DUP_MASK >> 9) & 1u); ++rep) {
    phase_attn(p, lds);
    xcd_barrier(xb);
    }
    for (int rep = 0; rep < 1 + (int)((DUP_MASK >> 10) & 1u); ++rep) {
    phase_gate1(p);
    xcd_barrier(xb);
    }
    for (int rep = 0; rep < 1 + (int)((DUP_MASK >> 11) & 1u); ++rep) {
    { EpiRes<bf16_t, float> e{X1, X1 + (size_t)MP * 1024, MOD + 40 * 3072, p.out}; gemm_all(lds, ACT, (const bf16_t*)(p.ws + WS_WTBO), 1024, e); }
    xcd_barrier(xb);
    }
    phase_final(p);
}

extern "C" void kernel_launch(void* const* d_in, const int* in_sizes, int n_in, void* d_out, int out_size, void* d_ws, size_t ws_size, hipStream_t stream) {
    static int grid_blocks = 0;
    if (!grid_blocks) {
        if (n_in != 21 || ws_size < WS_END) { fprintf(stderr, "kernel_launch: unexpected inputs (n_in %d, ws %zu < %zu)\n", n_in, ws_size, (size_t)WS_END); grid_blocks = -1; return; }
        int dev = 0, cus = 0, per_cu = 0;
        hipGetDevice(&dev);
        hipDeviceGetAttribute(&cus, hipDeviceAttributeMultiprocessorCount, dev);
        if (hipFuncSetAttribute((const void*)hybrid_fwd, hipFuncAttributeMaxDynamicSharedMemorySize, LDS_BYTES) != hipSuccess) { fprintf(stderr, "kernel_launch: hipFuncSetAttribute failed\n"); }
        hipOccupancyMaxActiveBlocksPerMultiprocessor(&per_cu, (const void*)hybrid_fwd, 512, LDS_BYTES);
        per_cu = 1;
        grid_blocks = cus * per_cu;
    }
    if (grid_blocks < 0) return;
    Params p{};
    for (int i = 0; i < 21; ++i) p.in[i] = (const float*)d_in[i];
    p.out = (float*)d_out; p.ws = (unsigned char*)d_ws;
    if (hipMemsetAsync((unsigned char*)d_ws + WS_BAR, 0, XCD_BAR_WORDS * 4, stream) != hipSuccess) { fprintf(stderr, "kernel_launch: memset of barrier words failed\n"); return; }
    void* args[] = {&p};
    hipError_t e = hipLaunchCooperativeKernel((const void*)hybrid_fwd, dim3(grid_blocks), dim3(512), args, LDS_BYTES, stream);
    if (e != hipSuccess) fprintf(stderr, "cooperative launch failed: %s (grid %d)\n", hipGetErrorString(e), grid_blocks);
}
```

```cpp
#include <hip/hip_runtime.h>
#include <hip/hip_cooperative_groups.h>
#include <cstdio>
namespace cg = cooperative_groups;

#define LAS __attribute__((address_space(3)))
#define DI __device__ __forceinline__
typedef unsigned short bf16_t;
typedef short bf16x8 __attribute__((ext_vector_type(8)));
typedef short s16x4 __attribute__((ext_vector_type(4)));
typedef float f32x4 __attribute__((ext_vector_type(4)));
typedef float f32x2 __attribute__((ext_vector_type(2)));
typedef unsigned u32x4 __attribute__((ext_vector_type(4)));
typedef unsigned u32x2 __attribute__((ext_vector_type(2)));
typedef __bf16 bf16x2_t __attribute__((ext_vector_type(2)));

constexpr int DM = 1024, MP = 16384, MS = 256, MT = MP + MS;
constexpr int NCH = 2048 + 256;
constexpr float EPS = 1e-6f;
constexpr float QSCALE = 0.08838834764831845f * 1.4426950408889634f;
constexpr int LDS_BYTES = 151552;

constexpr size_t WS_WTA  = 0;
constexpr size_t WS_WTAO = WS_WTA  + (size_t)4096 * 1024 * 2;
constexpr size_t WS_WTB  = WS_WTAO + (size_t)1024 * 1024 * 2;
constexpr size_t WS_WTBO = WS_WTB  + (size_t)10240 * 1024 * 2;
constexpr size_t WS_MOD  = WS_WTBO + (size_t)1024 * 1024 * 2;
constexpr size_t WS_ACT  = WS_MOD  + (size_t)2 * 40 * 3072 * 4;
constexpr size_t WS_P0   = WS_ACT  + (size_t)MT * 1024 * 2;
constexpr size_t WS_GB   = WS_P0   + (size_t)MT * 4096 * 2;
constexpr size_t WS_WV   = WS_GB   + (size_t)MT * 16 * 4;
constexpr size_t WS_KC   = WS_WV   + (size_t)NCH * 8192 * 2;
constexpr size_t WS_QD   = WS_KC   + (size_t)NCH * 8192 * 2;
constexpr size_t WS_KDT  = WS_QD   + (size_t)NCH * 8192 * 2;
constexpr size_t WS_QK   = WS_KDT  + (size_t)NCH * 8192 * 2;
constexpr size_t WS_GT   = WS_QK   + (size_t)NCH * 4096 * 2;
constexpr size_t WS_O0   = WS_GT   + (size_t)NCH * 4;
constexpr size_t WS_X1   = WS_O0   + (size_t)MT * 1024 * 2;
constexpr size_t WS_P1   = WS_X1   + (size_t)MT * 1024 * 4;
constexpr size_t WS_OG   = WS_P0;
constexpr size_t WS_LSE  = WS_P1   + (size_t)MT * 10240 * 2;
constexpr size_t WS_BAR  = WS_LSE  + (size_t)3 * MT * 8 * 4;
constexpr size_t WS_END  = WS_BAR  + 16384;

constexpr size_t O_YP   = 0;
constexpr size_t O_YS   = O_YP + (size_t)MP * 1024;
constexpr size_t O_DP   = O_YS + (size_t)MS * 1024;
constexpr size_t O_DS   = O_DP + (size_t)8 * 8 * 128 * 128;
constexpr size_t O_CP   = O_DS + (size_t)32 * 8 * 128 * 128;
constexpr size_t O_CS   = O_CP + (size_t)8 * 3 * 3072;
constexpr size_t O_KVP0 = O_CS + (size_t)32 * 3 * 3072;
constexpr size_t O_KVS0 = O_KVP0 + (size_t)8 * 128 * 2048;
constexpr size_t O_KVP1 = O_KVS0 + (size_t)32 * 8 * 2048;
constexpr size_t O_KVS1 = O_KVP1 + (size_t)8 * 512 * 2048;
constexpr size_t O_KVP2 = O_KVS1 + (size_t)32 * 8 * 2048;
constexpr size_t O_KVS2 = O_KVP2 + (size_t)8 * 2048 * 2048;

struct Params { const float* in[21]; float* out; unsigned char* ws; };
enum { I_XP = 0, I_XS, I_SD, I_SC, I_C128, I_C512, I_C2048, I_CP, I_CS, I_NG, I_ADAW, I_ADAB, I_AWIN, I_ACONV, I_ALOG, I_ADT, I_AOG, I_AWOUT, I_BWIN, I_BWOUT, I_FNG };

DI int TID() { int t = (int)threadIdx.x; asm volatile("" : "+v"(t)); return t; }
DI unsigned pk2(float a, float b) { f32x2 v = {a, b}; bf16x2_t r = __builtin_convertvector(v, bf16x2_t); return __builtin_bit_cast(unsigned, r); }
DI float bflo(unsigned u) { return __uint_as_float(u << 16); }
DI float bfhi(unsigned u) { return __uint_as_float(u & 0xffff0000u); }

DI float wave_max(float v) { for (int o = 32; o > 0; o >>= 1) v = fmaxf(v, __shfl_xor(v, o)); return v; }
template <int CTRL> DI float dpp_f(float v) { return __builtin_bit_cast(float, __builtin_amdgcn_update_dpp(0, __builtin_bit_cast(int, v), CTRL, 0xf, 0xf, true)); }
DI float row16_sum(float v) { v += dpp_f<0xB1>(v); v += dpp_f<0x4E>(v); v += dpp_f<0x141>(v); v += dpp_f<0x140>(v); return v; }
DI float wave_sum(float v) {
    v = row16_sum(v);
    const int iv = __builtin_bit_cast(int, v);
    const float r0 = __builtin_bit_cast(float, __builtin_amdgcn_readlane(iv, 0)), r1 = __builtin_bit_cast(float, __builtin_amdgcn_readlane(iv, 16));
    const float r2 = __builtin_bit_cast(float, __builtin_amdgcn_readlane(iv, 32)), r3 = __builtin_bit_cast(float, __builtin_amdgcn_readlane(iv, 48));
    return (r0 + r1) + (r2 + r3);
}
DI float siluf(float x) { return x * __builtin_amdgcn_rcpf(1.f + __expf(-x)); }
DI int batch_of(int row) { return row < MP ? (row >> 11) : 8 + ((row - MP) >> 3); }
DI f32x4 mfma16(bf16x8 a, bf16x8 b, f32x4 c) { return __builtin_amdgcn_mfma_f32_16x16x32_bf16(a, b, c, 0, 0, 0); }
DI void lds_sync() { asm volatile("s_waitcnt lgkmcnt(0)" ::: "memory"); __builtin_amdgcn_s_barrier(); asm volatile("" ::: "memory"); }
DI bf16x8 lds_ld8(const LAS unsigned char* p) { return *(const LAS bf16x8*)p; }


DI void pin16x2(float (&a)[16], float (&b)[16]) {
    f32x4 p0 = {a[0], a[1], a[2], a[3]}, p1 = {a[4], a[5], a[6], a[7]}, p2 = {a[8], a[9], a[10], a[11]}, p3 = {a[12], a[13], a[14], a[15]};
    f32x4 q0 = {b[0], b[1], b[2], b[3]}, q1 = {b[4], b[5], b[6], b[7]}, q2 = {b[8], b[9], b[10], b[11]}, q3 = {b[12], b[13], b[14], b[15]};
    asm volatile("" : "+v"(p0), "+v"(p1), "+v"(p2), "+v"(p3), "+v"(q0), "+v"(q1), "+v"(q2), "+v"(q3));
#pragma unroll
    for (int j = 0; j < 4; ++j) { a[j] = p0[j]; a[4 + j] = p1[j]; a[8 + j] = p2[j]; a[12 + j] = p3[j]; b[j] = q0[j]; b[4 + j] = q1[j]; b[8 + j] = q2[j]; b[12 + j] = q3[j]; }
}
DI void pin16x4(float (&a)[16], float (&b)[16], float (&c)[16], float (&d)[16]) {
    f32x4 p[16];
#pragma unroll
    for (int j = 0; j < 4; ++j) { p[j] = (f32x4){a[4 * j], a[4 * j + 1], a[4 * j + 2], a[4 * j + 3]}; p[4 + j] = (f32x4){b[4 * j], b[4 * j + 1], b[4 * j + 2], b[4 * j + 3]};
                                  p[8 + j] = (f32x4){c[4 * j], c[4 * j + 1], c[4 * j + 2], c[4 * j + 3]}; p[12 + j] = (f32x4){d[4 * j], d[4 * j + 1], d[4 * j + 2], d[4 * j + 3]}; }
    asm volatile("" : "+v"(p[0]), "+v"(p[1]), "+v"(p[2]), "+v"(p[3]), "+v"(p[4]), "+v"(p[5]), "+v"(p[6]), "+v"(p[7]), "+v"(p[8]), "+v"(p[9]), "+v"(p[10]), "+v"(p[11]), "+v"(p[12]), "+v"(p[13]), "+v"(p[14]), "+v"(p[15]));
#pragma unroll
    for (int j = 0; j < 4; ++j)
#pragma unroll
        for (int e = 0; e < 4; ++e) { a[4 * j + e] = p[j][e]; b[4 * j + e] = p[4 + j][e]; c[4 * j + e] = p[8 + j][e]; d[4 * j + e] = p[12 + j][e]; }
}
template <class T> DI void pin4x4x4x4(T (&a)[4], T (&b)[4], T (&c)[4], T (&d)[4]) {
    asm volatile("" : "+v"(a[0]), "+v"(a[1]), "+v"(a[2]), "+v"(a[3]), "+v"(b[0]), "+v"(b[1]), "+v"(b[2]), "+v"(b[3]), "+v"(c[0]), "+v"(c[1]), "+v"(c[2]), "+v"(c[3]), "+v"(d[0]), "+v"(d[1]), "+v"(d[2]), "+v"(d[3]));
}
template <class T> DI void pin4(T (&a)[4]) { asm volatile("" : "+v"(a[0]), "+v"(a[1]), "+v"(a[2]), "+v"(a[3])); }
template <class T> DI void pin8(T (&a)[8]) { asm volatile("" : "+v"(a[0]), "+v"(a[1]), "+v"(a[2]), "+v"(a[3]), "+v"(a[4]), "+v"(a[5]), "+v"(a[6]), "+v"(a[7])); }
template <class T, class U> DI void pin4x4(T (&a)[4], U (&b)[4]) { asm volatile("" : "+v"(a[0]), "+v"(a[1]), "+v"(a[2]), "+v"(a[3]), "+v"(b[0]), "+v"(b[1]), "+v"(b[2]), "+v"(b[3])); }
template <class T, class U> DI void pin8x8(T (&a)[8], U (&b)[8]) { asm volatile("" : "+v"(a[0]), "+v"(a[1]), "+v"(a[2]), "+v"(a[3]), "+v"(a[4]), "+v"(a[5]), "+v"(a[6]), "+v"(a[7]),
                                                                                      "+v"(b[0]), "+v"(b[1]), "+v"(b[2]), "+v"(b[3]), "+v"(b[4]), "+v"(b[5]), "+v"(b[6]), "+v"(b[7])); }

namespace pg8 {
constexpr int BM = 256, BK = 64, HALF = 128, HTB = HALF * BK * 2, STAGE_BYTES = 8 * HTB, NXCD = 8, WGM = 8;
DI int lds_byte(int r, int c) { const int st = (r >> 4) * 2 + (c >> 5), rr = r & 15, cc = c & 31, ob = rr * 64 + cc * 2; return st * 1024 + (ob ^ (((ob >> 9) & 1) << 5)); }
DI void stage_rc(int b, int& R, int& C) { const int st = b / 1024, sb = b % 1024, swz = sb ^ (((sb >> 9) & 1) << 5); R = (st >> 1) * 16 + swz / 64; C = (st & 1) * 32 + (swz % 64) / 2; }
DI int perm32(int rho) { const int n = rho >> 4, i = rho & 15; return 8 * (i >> 2) + 4 * n + (i & 3); }
struct Unit { int pm, pn; };
struct Gemm { const bf16_t* A; const bf16_t* Bt; int M, N, K; };
struct StaticOrder {
    int nM, nN, nwg, G, c;
    DI void init(int M, int N, int G_, int c_) { nM = M / BM; nN = N / BM; nwg = nM * nN; G = G_; c = c_; }
    DI bool next(int i, Unit& u) const {
        const long L = (long)i * G + c; if (L >= nwg) return false;
        int wgid = (int)L; { const int q = nwg / NXCD, r = nwg % NXCD, xcd = wgid % NXCD, off = wgid / NXCD; wgid = (xcd < r ? xcd * (q + 1) : r * (q + 1) + (xcd - r) * q) + off; }
        const int nig = WGM * nN, gid = wgid / nig, fm = gid * WGM, gsz = (nM - fm) < WGM ? (nM - fm) : WGM;
        u.pm = fm + ((wgid % nig) % gsz); u.pn = (wgid % nig) / gsz; return true;
    }
};

template <class Epi>
DI void gemm_phase(LAS unsigned char* lds, const Gemm g, const StaticOrder& S, const Epi& E) {
    const int tid = TID(), wid = __builtin_amdgcn_readfirstlane(tid >> 6), lane = tid & 63, wr = wid >> 2, wc = wid & 3, fr = lane & 15, fq = lane >> 4;
    const int K = g.K, nt = K / BK;
    unsigned voffA[2], voffB[2];
#pragma unroll
    for (int i = 0; i < 2; ++i) { int R, C; stage_rc(tid * 16 + i * 8192, R, C); const int Rb = (R & ~31) + perm32(R & 31);
        voffA[i] = (unsigned)(R * K + C) * 2u; voffB[i] = (unsigned)(Rb * K + C) * 2u; }
    const size_t kstep = (size_t)(BK * 2);
    const size_t hstep = (size_t)HALF * K * 2;
    const size_t tstep = 2 * hstep;
    const unsigned ldsw = (unsigned)wid * 1024u;
    const int aoff = lds_byte(wr * 64 + fr, fq * 8), boff = lds_byte(wc * 32 + fr, fq * 8);
#define PG8_SA(b, h) (((b) * 2 + (h)) * HTB)
#define PG8_SB(b, h) ((4 + (b) * 2 + (h)) * HTB)
#define PG8_STAGE(bufoff, gbase, voff) do { _Pragma("unroll") for (int _i = 0; _i < 2; ++_i) \
        __builtin_amdgcn_global_load_lds((const unsigned*)((const char*)(gbase) + (voff)[_i]), (LAS unsigned*)(lds + (bufoff) + ldsw + _i * 8192), 16, 0, 0); } while (0)
#define PG8_LDA(dst, b, h) do { _Pragma("unroll") for (int m = 0; m < 4; ++m) _Pragma("unroll") for (int k = 0; k < 2; ++k) dst[m][k] = *(const LAS bf16x8*)(lds + PG8_SA(b, h) + aoff + m * 2048 + k * 1024); } while (0)
#define PG8_LDB(dst, b, h) do { _Pragma("unroll") for (int n = 0; n < 2; ++n) _Pragma("unroll") for (int k = 0; k < 2; ++k) dst[n][k] = *(const LAS bf16x8*)(lds + PG8_SB(b, h) + boff + n * 2048 + k * 1024); } while (0)
#define PG8_MMA(ai, bj, At, Bt) do { __builtin_amdgcn_s_setprio(1); _Pragma("unroll") for (int m = 0; m < 4; ++m) _Pragma("unroll") for (int n = 0; n < 2; ++n) _Pragma("unroll") for (int k = 0; k < 2; ++k) \
        acc[ai][bj][m][n] = __builtin_amdgcn_mfma_f32_16x16x32_bf16(Bt[n][k], At[m][k], acc[ai][bj][m][n], 0, 0, 0); __builtin_amdgcn_s_setprio(0); } while (0)
#define PG8_WAIT_V(n) asm volatile("s_waitcnt vmcnt(" #n ")" ::: "memory")
#define PG8_WAIT_L(n) asm volatile("s_waitcnt lgkmcnt(" #n ")" ::: "memory")
#define PG8_BAR __builtin_amdgcn_s_barrier()
#define PG8_SCHED __builtin_amdgcn_sched_barrier(0)
    Unit cur, nxt; int ui = 0;
    if (!S.next(0, cur)) return;
    f32x4 acc[2][2][4][2];
#pragma unroll
    for (int a = 0; a < 2; ++a)
#pragma unroll
        for (int b = 0; b < 2; ++b)
#pragma unroll
            for (int m = 0; m < 4; ++m)
#pragma unroll
                for (int n = 0; n < 2; ++n) acc[a][b][m][n] = (f32x4){0.f, 0.f, 0.f, 0.f};
    bf16x8 At[4][2], B0[2][2], B1[2][2];
    const char* cA = (const char*)g.A + (size_t)cur.pm * tstep; const char* cB = (const char*)g.Bt + (size_t)cur.pn * tstep;
    PG8_STAGE(PG8_SB(0, 0), cB, voffB); PG8_STAGE(PG8_SA(0, 0), cA, voffA); PG8_STAGE(PG8_SB(0, 1), cB + hstep, voffB); PG8_STAGE(PG8_SA(0, 1), cA + hstep, voffA);
    if (wr == 1) PG8_BAR;
    PG8_WAIT_V(4); PG8_BAR;
    PG8_STAGE(PG8_SB(1, 0), cB + kstep, voffB); PG8_STAGE(PG8_SA(1, 0), cA + kstep, voffA); PG8_STAGE(PG8_SB(1, 1), cB + hstep + kstep, voffB);
    PG8_WAIT_V(6); PG8_BAR;
    for (;;) {
        const bool has_next = S.next(ui + 1, nxt);
        const char* nA = has_next ? (const char*)g.A + (size_t)nxt.pm * tstep : cA; const char* nB = has_next ? (const char*)g.Bt + (size_t)nxt.pn * tstep : cB;
        for (int t = 0; t < nt; t += 2) {
            const bool last = (t == nt - 2);
            const char* a1 = cA + (size_t)(t + 1) * kstep;
            const char* a2 = last ? nA : cA + (size_t)(t + 2) * kstep; const char* b2 = last ? nB : cB + (size_t)(t + 2) * kstep;
            const char* a3 = a2 + kstep; const char* b3 = b2 + kstep;
            PG8_LDB(B0, 0, 0); PG8_SCHED; PG8_LDA(At, 0, 0); PG8_STAGE(PG8_SA(1, 1), a1 + hstep, voffA);
            PG8_WAIT_L(8); PG8_BAR; PG8_WAIT_L(0); PG8_MMA(0, 0, At, B0); PG8_BAR; PG8_SCHED;
            PG8_LDB(B1, 0, 1); PG8_STAGE(PG8_SB(0, 0), b2, voffB);
            PG8_BAR; PG8_WAIT_L(0); PG8_MMA(0, 1, At, B1); PG8_BAR;
            PG8_LDA(At, 0, 1); PG8_STAGE(PG8_SA(0, 0), a2, voffA);
            PG8_BAR; PG8_WAIT_L(0); PG8_MMA(1, 0, At, B0); PG8_BAR; PG8_SCHED;
            PG8_STAGE(PG8_SB(0, 1), b2 + hstep, voffB);
            PG8_WAIT_V(6); PG8_BAR; PG8_MMA(1, 1, At, B1); PG8_BAR;
            PG8_LDB(B0, 1, 0); PG8_SCHED; PG8_LDA(At, 1, 0); PG8_STAGE(PG8_SA(0, 1), a2 + hstep, voffA);
            PG8_WAIT_L(8); PG8_BAR; PG8_WAIT_L(0); PG8_MMA(0, 0, At, B0); PG8_BAR; PG8_SCHED;
            PG8_LDB(B1, 1, 1); PG8_STAGE(PG8_SB(1, 0), b3, voffB);
            PG8_BAR; PG8_WAIT_L(0); PG8_MMA(0, 1, At, B1); PG8_BAR;
            PG8_LDA(At, 1, 1); PG8_STAGE(PG8_SA(1, 0), a3, voffA);
            PG8_BAR; PG8_WAIT_L(0); PG8_MMA(1, 0, At, B0); PG8_BAR; PG8_SCHED;
            PG8_STAGE(PG8_SB(1, 1), b3 + hstep, voffB);
            PG8_WAIT_V(6); PG8_BAR; PG8_MMA(1, 1, At, B1); PG8_BAR;
        }
        E(acc, cur, wr, wc, fr, fq);
        if (!has_next) break;
#pragma unroll
        for (int a = 0; a < 2; ++a)
#pragma unroll
            for (int b = 0; b < 2; ++b)
#pragma unroll
                for (int m = 0; m < 4; ++m)
#pragma unroll
                    for (int n = 0; n < 2; ++n) acc[a][b][m][n] = (f32x4){0.f, 0.f, 0.f, 0.f};
        cur = nxt; cA = nA; cB = nB; ++ui;
    }
    PG8_WAIT_V(0);
    if (wr == 0) PG8_BAR;
    PG8_BAR;
#undef PG8_SA
#undef PG8_SB
#undef PG8_STAGE
#undef PG8_LDA
#undef PG8_LDB
#undef PG8_MMA
#undef PG8_WAIT_V
#undef PG8_WAIT_L
#undef PG8_BAR
#undef PG8_SCHED
}
}

template <class F> struct Epi8 {
    F f;
    DI void operator()(const f32x4 (&acc)[2][2][4][2], const pg8::Unit& u, int wr, int wc, int fr, int fq) const {
        const int row0 = u.pm * 256 + wr * 64 + fr, col0 = u.pn * 256 + wc * 32 + 8 * fq;
        if constexpr (F::HAS_TILE) { f.tile(acc, row0, col0); return; }
#pragma unroll
        for (int ai = 0; ai < 2; ++ai)
#pragma unroll
            for (int m = 0; m < 4; ++m)
#pragma unroll
                for (int bj = 0; bj < 2; ++bj) f.store8(row0 + ai * 128 + m * 16, col0 + bj * 128, acc[ai][bj][m][0], acc[ai][bj][m][1]);
    }
};

template <class F> DI void small_gemm(const bf16_t* A, const bf16_t* Wt, int N, int rowbase, const F& f) {
    const int lane = TID() & 63, wid = TID() >> 6, r16 = lane & 15, fq = lane >> 4;
    const int ntile = 16 * (N / 32), nw = gridDim.x * 8;
    for (int t = blockIdx.x * 8 + wid; t < ntile; t += nw) {
        const int rt = t & 15, ct = t >> 4;
        const bf16_t* ap = A + (size_t)(rt * 16 + r16) * 1024 + fq * 8;
        const bf16_t* b0 = Wt + (size_t)(ct * 32 + pg8::perm32(r16)) * 1024 + fq * 8;
        const bf16_t* b1 = Wt + (size_t)(ct * 32 + pg8::perm32(16 + r16)) * 1024 + fq * 8;
        f32x4 acc0 = {0.f, 0.f, 0.f, 0.f}, acc1 = {0.f, 0.f, 0.f, 0.f};
#pragma unroll 1
        for (int kb = 0; kb < 4; ++kb) {
            bf16x8 a[8], x0[8], x1[8];
#pragma unroll
            for (int u = 0; u < 8; ++u) { const int ko = (kb * 8 + u) * 32; a[u] = *(const bf16x8*)(ap + ko); x0[u] = *(const bf16x8*)(b0 + ko); x1[u] = *(const bf16x8*)(b1 + ko); }
            asm volatile("" : "+v"(a[0]), "+v"(x0[0]), "+v"(x1[0]), "+v"(a[1]), "+v"(x0[1]), "+v"(x1[1]), "+v"(a[2]), "+v"(x0[2]), "+v"(x1[2]), "+v"(a[3]), "+v"(x0[3]), "+v"(x1[3]), "+v"(a[4]), "+v"(x0[4]), "+v"(x1[4]), "+v"(a[5]), "+v"(x0[5]), "+v"(x1[5]), "+v"(a[6]), "+v"(x0[6]), "+v"(x1[6]), "+v"(a[7]), "+v"(x0[7]), "+v"(x1[7]));
#pragma unroll
            for (int u = 0; u < 8; ++u) { acc0 = mfma16(x0[u], a[u], acc0); acc1 = mfma16(x1[u], a[u], acc1); }
        }
        f.store8(rowbase + rt * 16 + r16, ct * 32 + 8 * fq, acc0, acc1);
    }
}

template <class F> DI void gemm_all(LAS unsigned char* lds, const bf16_t* A, const bf16_t* Wt, int N, const F& f) {
    pg8::Gemm g{A, Wt, MP, N, 1024}; pg8::StaticOrder S; S.init(MP, N, (int)gridDim.x, (int)blockIdx.x); Epi8<F> E{f};
    pg8::gemm_phase(lds, g, S, E);
    small_gemm(A + (size_t)MP * 1024, Wt, N, MP, f);
}

DI void st_bf16x8(bf16_t* p, f32x4 v0, f32x4 v1) { u32x4 w; w.x = pk2(v0[0], v0[1]); w.y = pk2(v0[2], v0[3]); w.z = pk2(v1[0], v1[1]); w.w = pk2(v1[2], v1[3]); *(u32x4*)p = w; }

struct EpiA {
    static constexpr bool HAS_TILE = true;
    bf16_t* P0; float* out;
    DI void tile(const f32x4 (&acc)[2][2][4][2], int row0, int col0) const {
        const int ucol = col0 & ~255, urow = row0 & ~255;
        const bool tail = ucol < 3072 && (urow & 2047) == 1792;
#pragma unroll
        for (int ai = 0; ai < 2; ++ai)
#pragma unroll
            for (int m = 0; m < 4; ++m) {
                const int row = row0 + ai * 128 + m * 16, s = row & 2047;
#pragma unroll
                for (int bj = 0; bj < 2; ++bj) {
                    const f32x4 v0 = acc[ai][bj][m][0], v1 = acc[ai][bj][m][1];
                    if (tail && s >= 2045) { float* o = out + O_CP + (size_t)((row >> 11) * 3 + (s - 2045)) * 3072 + col0 + bj * 128; *(f32x4*)o = v0; *(f32x4*)(o + 4) = v1; }
                    st_bf16x8(P0 + (size_t)row * 4096 + col0 + bj * 128, v0, v1);
                }
            }
    }
    DI void store8(int row, int col, f32x4 v0, f32x4 v1) const {
        st_bf16x8(P0 + (size_t)row * 4096 + col, v0, v1);
        if (col < 3072) {
            float* o = nullptr;
            if (row < MP) { const int s = row & 2047; if (s >= 2045) o = out + O_CP + (size_t)((row >> 11) * 3 + (s - 2045)) * 3072 + col; }
            else { const int r = row - MP, l = r & 7; if (l >= 5) o = out + O_CS + (size_t)((r >> 3) * 3 + (l - 5)) * 3072 + col; }
            if (o) { *(f32x4*)o = v0; *(f32x4*)(o + 4) = v1; }
        }
    }
};
DI void ld8_as_f32(const float* p, f32x4& a, f32x4& b) { a = *(const f32x4*)p; b = *(const f32x4*)(p + 4); }
DI void ld8_as_f32(const bf16_t* p, f32x4& a, f32x4& b) { const u32x4 w = *(const u32x4*)p; a = (f32x4){bflo(w.x), bfhi(w.x), bflo(w.y), bfhi(w.y)}; b = (f32x4){bflo(w.z), bfhi(w.z), bflo(w.w), bfhi(w.w)}; }
DI void st8_from_f32(float* p, f32x4 a, f32x4 b) { *(f32x4*)p = a; *(f32x4*)(p + 4) = b; }
DI void st8_from_f32(bf16_t* p, f32x4 a, f32x4 b) { st_bf16x8(p, a, b); }
template <class TI, class TO> struct EpiRes {
    static constexpr bool HAS_TILE = true;
    const TI* xp; const TI* xs; const float* mod; TO* dst;
    DI void tile(const f32x4 (&acc)[2][2][4][2], int row0, int col0) const {
        const float* gt = mod + (size_t)(row0 >> 11) * 3072 + 2048 + col0;
        f32x4 g[2][2];
#pragma unroll
        for (int bj = 0; bj < 2; ++bj) { g[bj][0] = *(const f32x4*)(gt + bj * 128); g[bj][1] = *(const f32x4*)(gt + bj * 128 + 4); }
#pragma unroll
        for (int ai = 0; ai < 2; ++ai) {
            f32x4 xv[16];
            if constexpr (sizeof(TI) == 2) {
                u32x4 xr[8];
#pragma unroll
                for (int m = 0; m < 4; ++m)
#pragma unroll
                    for (int bj = 0; bj < 2; ++bj) xr[m * 2 + bj] = *(const u32x4*)(xp + (size_t)(row0 + ai * 128 + m * 16) * 1024 + col0 + bj * 128);
                pin8(xr);
#pragma unroll
                for (int q = 0; q < 8; ++q) { const u32x4 w = xr[q]; xv[2 * q] = (f32x4){bflo(w.x), bfhi(w.x), bflo(w.y), bfhi(w.y)}; xv[2 * q + 1] = (f32x4){bflo(w.z), bfhi(w.z), bflo(w.w), bfhi(w.w)}; }
            } else {
#pragma unroll
                for (int m = 0; m < 4; ++m) { const TI* x = xp + (size_t)(row0 + ai * 128 + m * 16) * 1024 + col0;
#pragma unroll
                    for (int bj = 0; bj < 2; ++bj) ld8_as_f32(x + bj * 128, xv[m * 4 + bj * 2], xv[m * 4 + bj * 2 + 1]); }
                asm volatile("" : "+v"(xv[0]), "+v"(xv[1]), "+v"(xv[2]), "+v"(xv[3]), "+v"(xv[4]), "+v"(xv[5]), "+v"(xv[6]), "+v"(xv[7]), "+v"(xv[8]), "+v"(xv[9]), "+v"(xv[10]), "+v"(xv[11]), "+v"(xv[12]), "+v"(xv[13]), "+v"(xv[14]), "+v"(xv[15]));
            }
#pragma unroll
            for (int m = 0; m < 4; ++m) { TO* d = dst + (size_t)(row0 + ai * 128 + m * 16) * 1024 + col0;
#pragma unroll
                for (int bj = 0; bj < 2; ++bj) st8_from_f32(d + bj * 128, xv[m * 4 + bj * 2] + g[bj][0] * acc[ai][bj][m][0], xv[m * 4 + bj * 2 + 1] + g[bj][1] * acc[ai][bj][m][1]); }
        }
    }
    DI void store8(int row, int col, f32x4 v0, f32x4 v1) const {
        const TI* x = (row < MP ? xp + (size_t)row * 1024 : xs + (size_t)(row - MP) * 1024) + col;
        const float* gt = mod + (size_t)batch_of(row) * 3072 + 2048 + col;
        f32x4 x0, x1; ld8_as_f32(x, x0, x1);
        const f32x4 g0 = *(const f32x4*)gt, g1 = *(const f32x4*)(gt + 4);
        st8_from_f32(dst + (size_t)row * 1024 + col, x0 + g0 * v0, x1 + g1 * v1);
    }
};
struct EpiB {
    static constexpr bool HAS_TILE = true;
    bf16_t* P1; float* out;
    DI void tile(const f32x4 (&acc)[2][2][4][2], int row0, int col0) const {
        const int ucol = col0 & ~255, urow = row0 & ~255;
        const bool isq = ucol < 3072, iskv = ucol >= 3072 && ucol < 9216;
        const int cc = ucol - 3072, kv = cc >= 3072 ? 1 : 0, g = ((cc - kv * 3072) >> 10), W = g == 0 ? 128 : (g == 1 ? 512 : 2048);
        const int b = urow >> 11, s0 = urow & 2047;
        const bool any_out = iskv && (s0 + 256 > 2048 - W);
        const size_t obase = (g == 0 ? O_KVP0 : (g == 1 ? O_KVP1 : O_KVP2)) + ((size_t)b * W * 2 + kv) * 1024 + ((col0 - 3072 - kv * 3072) & 1023);
        const float sc = isq ? QSCALE : 1.f;
#pragma unroll
        for (int ai = 0; ai < 2; ++ai)
#pragma unroll
            for (int m = 0; m < 4; ++m) {
                const int row = row0 + ai * 128 + m * 16, s = row & 2047;
#pragma unroll
                for (int bj = 0; bj < 2; ++bj) {
                    const f32x4 v0 = acc[ai][bj][m][0], v1 = acc[ai][bj][m][1];
                    if (any_out && s >= 2048 - W) { float* o = out + obase + (size_t)(s - (2048 - W)) * 2048 + bj * 128; *(f32x4*)o = v0; *(f32x4*)(o + 4) = v1; }
                    st_bf16x8(P1 + (size_t)row * 10240 + col0 + bj * 128, v0 * sc, v1 * sc);
                }
            }
    }
    DI void store8(int row, int col, f32x4 v0, f32x4 v1) const {
        if (col >= 3072 && col < 9216) {
            const int cc = col - 3072, kv = cc / 3072, g = (cc - kv * 3072) >> 10, he = cc & 1023;
            float* o = nullptr;
            if (row < MP) {
                const int b = row >> 11, s = row & 2047, W = g == 0 ? 128 : (g == 1 ? 512 : 2048);
                const size_t base = g == 0 ? O_KVP0 : (g == 1 ? O_KVP1 : O_KVP2);
                if (s >= 2048 - W) o = out + base + ((size_t)(b * W + (s - (2048 - W))) * 2 + kv) * 1024 + he;
            } else {
                const size_t base = g == 0 ? O_KVS0 : (g == 1 ? O_KVS1 : O_KVS2);
                o = out + base + ((size_t)(row - MP) * 2 + kv) * 1024 + he;
            }
            if (o) { *(f32x4*)o = v0; *(f32x4*)(o + 4) = v1; }
        }
        if (col < 3072) { v0 *= QSCALE; v1 *= QSCALE; }
        st_bf16x8(P1 + (size_t)row * 10240 + col, v0, v1);
    }
};

DI void ada_item(const Params& p, LAS unsigned char* lds, int it) {
    const int tid = TID(), l = it / 96, col0 = (it % 96) * 32, col = tid & 31, ks = tid >> 5;
    LAS float* cs = (LAS float*)lds;
    const float* aw = p.in[I_ADAW] + (size_t)l * 1024 * 3072;
    float acc[40];
#pragma unroll
    for (int b = 0; b < 40; ++b) acc[b] = 0.f;
    for (int half = 0; half < 2; ++half) {
        __syncthreads();
        {
            f32x4 c4[10];
#pragma unroll
            for (int b4 = 0; b4 < 10; ++b4)
#pragma unroll
                for (int e = 0; e < 4; ++e) { const int b = 4 * b4 + e; c4[b4][e] = b < 8 ? p.in[I_CP][b * 1024 + half * 512 + tid] : p.in[I_CS][(b - 8) * 1024 + half * 512 + tid]; }
            asm volatile("" : "+v"(c4[0]), "+v"(c4[1]), "+v"(c4[2]), "+v"(c4[3]), "+v"(c4[4]), "+v"(c4[5]), "+v"(c4[6]), "+v"(c4[7]), "+v"(c4[8]), "+v"(c4[9]));
#pragma unroll
            for (int b4 = 0; b4 < 10; ++b4) { f32x4 sv; sv[0] = siluf(c4[b4][0]); sv[1] = siluf(c4[b4][1]); sv[2] = siluf(c4[b4][2]); sv[3] = siluf(c4[b4][3]); *(LAS f32x4*)(cs + tid * 44 + b4 * 4) = sv; }
        }
        __syncthreads();
        float wv[32];
#pragma unroll
        for (int kk = 0; kk < 32; ++kk) wv[kk] = aw[(size_t)(half * 512 + ks * 32 + kk) * 3072 + col0 + col];
        { float (&w0)[16] = *reinterpret_cast<float (*)[16]>(&wv[0]); float (&w1)[16] = *reinterpret_cast<float (*)[16]>(&wv[16]); pin16x2(w0, w1); }
#pragma unroll 4
        for (int kk = 0; kk < 32; ++kk) {
            const int k = ks * 32 + kk;
            const float w = wv[kk];
#pragma unroll
            for (int b4 = 0; b4 < 10; ++b4) {
                const f32x4 c4 = *(const LAS f32x4*)(cs + k * 44 + b4 * 4);
                acc[b4 * 4 + 0] += c4[0] * w; acc[b4 * 4 + 1] += c4[1] * w; acc[b4 * 4 + 2] += c4[2] * w; acc[b4 * 4 + 3] += c4[3] * w;
            }
        }
    }
    __syncthreads();
    LAS float* red = (LAS float*)lds;
#pragma unroll
    for (int b = 0; b < 40; ++b) red[(ks * 40 + b) * 32 + col] = acc[b];
    __syncthreads();
    float* MOD = (float*)(p.ws + WS_MOD);
    const float bias = p.in[I_ADAB][l * 3072 + col0 + (tid & 31)];
#pragma unroll
    for (int q = 0; q < 3; ++q) {
        const int idx = tid + 512 * q;
        if (idx < 1280) {
            const int b = idx >> 5, c = idx & 31;
            float s = bias;
#pragma unroll
            for (int k16 = 0; k16 < 16; ++k16) s += red[(k16 * 40 + b) * 32 + c];
            MOD[(size_t)(l * 40 + b) * 3072 + col0 + c] = s;
        }
    }
}
struct TileRef { const float* src; bf16_t* dst; int pitch, k0, n0; };
DI TileRef tile_ref(const Params& p, int t) {
    TileRef r; int tt;
    if (t < 512) { r.src = p.in[I_AWIN]; r.dst = (bf16_t*)(p.ws + WS_WTA); r.pitch = 4112; tt = t; }
    else if (t < 640) { r.src = p.in[I_AWOUT]; r.dst = (bf16_t*)(p.ws + WS_WTAO); r.pitch = 1024; tt = t - 512; }
    else if (t < 1920) { r.src = p.in[I_BWIN]; r.dst = (bf16_t*)(p.ws + WS_WTB); r.pitch = 10240; tt = t - 640; }
    else { r.src = p.in[I_BWOUT]; r.dst = (bf16_t*)(p.ws + WS_WTBO); r.pitch = 1024; tt = t - 1920; }
    r.k0 = (tt & 15) * 64; r.n0 = (tt >> 4) * 128; return r;
}
DI void tile_load(const TileRef& r, int tid, f32x4 (&v)[4]) {
#pragma unroll
    for (int i = 0; i < 4; ++i) { const int kk = (tid >> 5) + 16 * i, nn = (tid & 31) * 4; v[i] = *(const f32x4*)(r.src + (size_t)(r.k0 + kk) * r.pitch + r.n0 + nn); }
}
DI void phase_prep(const Params& p, LAS unsigned char* lds) {
    const int bid = blockIdx.x, G = gridDim.x;
    for (int it = bid; it < 192; it += G) ada_item(p, lds, it);
    int t, tstep, tend;
    if (G == 256) { if (bid < 192) { t = bid * 2; tstep = 1; tend = t + 2; } else { t = 384 + (bid - 192); tstep = 64; tend = 640; } }
    else { t = bid; tstep = G; tend = 640; }
    const int tid = TID();
    LAS float* T = (LAS float*)lds;
    f32x4 cur[4], nxt[4];
    TileRef rc, rn;
    if (t < tend) { rc = tile_ref(p, t); tile_load(rc, tid, cur); }
    for (; t < tend; t += tstep) {
        const int tn = t + tstep;
        if (tn < tend) { rn = tile_ref(p, tn); tile_load(rn, tid, nxt); }
        lds_sync();
#pragma unroll
        for (int i = 0; i < 4; ++i) { const int kk = (tid >> 5) + 16 * i, nn = (tid & 31) * 4;
            T[kk * 129 + nn] = cur[i][0]; T[kk * 129 + nn + 1] = cur[i][1]; T[kk * 129 + nn + 2] = cur[i][2]; T[kk * 129 + nn + 3] = cur[i][3]; }
        lds_sync();
#pragma unroll
        for (int q = 0; q < 2; ++q) {
            const int task = tid + 512 * q, nn = task >> 3, kc = task & 7;
            u32x4 w;
            w.x = pk2(T[(kc * 8 + 0) * 129 + nn], T[(kc * 8 + 1) * 129 + nn]); w.y = pk2(T[(kc * 8 + 2) * 129 + nn], T[(kc * 8 + 3) * 129 + nn]);
            w.z = pk2(T[(kc * 8 + 4) * 129 + nn], T[(kc * 8 + 5) * 129 + nn]); w.w = pk2(T[(kc * 8 + 6) * 129 + nn], T[(kc * 8 + 7) * 129 + nn]);
            *(u32x4*)(rc.dst + (size_t)(rc.n0 + nn) * 1024 + rc.k0 + kc * 8) = w;
        }
#pragma unroll
        for (int i = 0; i < 4; ++i) cur[i] = nxt[i];
        rc = rn;
    }
}

template <bool AB> DI void phase_norm(const Params& p, LAS unsigned char* lds, const float* xp, const float* xs, int layer) {
    const int tid = TID(), lane = tid & 63, wid = tid >> 6;
    LAS float* wab = (LAS float*)lds;
    if (AB) {
        float wt[32];
#pragma unroll
        for (int i = 0; i < 32; ++i) { const int idx = tid + 512 * i; wt[i] = p.in[I_AWIN][(size_t)(idx >> 4) * 4112 + 4096 + (idx & 15)]; }
        { float (&w0)[16] = *reinterpret_cast<float (*)[16]>(&wt[0]); float (&w1)[16] = *reinterpret_cast<float (*)[16]>(&wt[16]); pin16x2(w0, w1); }
#pragma unroll
        for (int i = 0; i < 32; ++i) { const int idx = tid + 512 * i; wab[(idx >> 4) * 20 + (idx & 15)] = wt[i]; }
        __syncthreads();
    }
    const float* MODl = (const float*)(p.ws + WS_MOD) + (size_t)layer * 40 * 3072;
    const float* ng = p.in[I_NG] + layer * 1024;
    bf16_t* ACT = (bf16_t*)(p.ws + WS_ACT);
    float* GB = (float*)(p.ws + WS_GB);
    const int nw = gridDim.x * 8;
    float gsv[16], shv[16];
    auto ld_mod = [&](int b) {
        const float* mb = MODl + (size_t)b * 3072;
        float sc[16], g16[16];
#pragma unroll
        for (int i = 0; i < 16; ++i) { const int c = lane + 64 * i; sc[i] = mb[1024 + c]; shv[i] = mb[c]; g16[i] = ng[c]; }
#pragma unroll
        for (int i = 0; i < 16; ++i) gsv[i] = g16[i] * (1.f + sc[i]);
    };
    auto ld_row = [&](int row, float (&v)[16]) {
        const float* x = row < MP ? xp + (size_t)row * 1024 : xs + (size_t)(row - MP) * 1024;
#pragma unroll
        for (int i = 0; i < 16; ++i) v[i] = x[lane + 64 * i];
    };
    auto do_row = [&](int row, float (&v)[16]) {
        float ss = 0.f;
#pragma unroll
        for (int i = 0; i < 16; ++i) ss += v[i] * v[i];
        ss = wave_sum(ss);
        const float rstd = rsqrtf(ss * (1.f / 1024.f) + EPS);
#pragma unroll
        for (int i = 0; i < 16; ++i) {
            const int c = lane + 64 * i;
            v[i] = v[i] * rstd * gsv[i] + shv[i];
            ACT[(size_t)row * 1024 + c] = (bf16_t)(pk2(v[i], 0.f) & 0xffffu);
        }
        if (AB) {
            float pa[16];
#pragma unroll
            for (int j = 0; j < 16; ++j) pa[j] = 0.f;
#pragma unroll
            for (int i = 0; i < 16; ++i) {
                const int c = lane + 64 * i;
                asm volatile("" ::: "memory");
#pragma unroll
                for (int q = 0; q < 4; ++q) { const f32x4 w = *(const LAS f32x4*)(wab + c * 20 + q * 4); pa[q * 4] += v[i] * w[0]; pa[q * 4 + 1] += v[i] * w[1]; pa[q * 4 + 2] += v[i] * w[2]; pa[q * 4 + 3] += v[i] * w[3]; }
            }
            float mine = 0.f;
#pragma unroll
            for (int j = 0; j < 16; ++j) { const float sm = wave_sum(pa[j]); if (lane == j) mine = sm; }
            if (lane < 16) {
                float r;
                if (lane < 8) { const float a = mine + p.in[I_ADT][lane]; const float sp = a > 20.f ? a : log1pf(__expf(a)); r = -__expf(p.in[I_ALOG][lane]) * sp; }
                else r = 1.f / (1.f + __expf(-mine));
                GB[(size_t)row * 16 + lane] = r;
            }
        }
    };
    for (int chunk = blockIdx.x * 8 + wid; chunk < MP / 8; chunk += nw) {
        const int r0 = chunk * 8;
        ld_mod(r0 >> 11);
#pragma unroll 1
        for (int h4 = 0; h4 < 2; ++h4) {
            float va[16], vb[16], vc[16], vd[16];
            const int r = r0 + 4 * h4;
            ld_row(r, va); ld_row(r + 1, vb); ld_row(r + 2, vc); ld_row(r + 3, vd);
            pin16x4(va, vb, vc, vd);
            do_row(r, va); do_row(r + 1, vb); do_row(r + 2, vc); do_row(r + 3, vd);
        }
    }
    for (int r = blockIdx.x * 8 + wid; r < MS; r += nw) {
        float va[16];
        ld_mod(8 + (r >> 3));
        ld_row(MP + r, va);
        do_row(MP + r, va);
    }
}

DI void phase_norm1(const Params& p) {
    const int lane = TID() & 63, wid = TID() >> 6;
    const float* MODl = (const float*)(p.ws + WS_MOD) + (size_t)40 * 3072;
    const float* ng = p.in[I_NG] + 1024;
    const bf16_t* X1 = (const bf16_t*)(p.ws + WS_X1);
    bf16_t* ACT = (bf16_t*)(p.ws + WS_ACT);
    const int nw = gridDim.x * 8;
    float gsv[16], shv[16];
    auto ld_mod = [&](int b) {
        const float* mb = MODl + (size_t)b * 3072 + lane * 16;
#pragma unroll
        for (int q = 0; q < 4; ++q) { const f32x4 sc = *(const f32x4*)(mb + 1024 + q * 4), sh = *(const f32x4*)(mb + q * 4), g = *(const f32x4*)(ng + lane * 16 + q * 4);
#pragma unroll
            for (int e = 0; e < 4; ++e) { gsv[q * 4 + e] = g[e] * (1.f + sc[e]); shv[q * 4 + e] = sh[e]; } }
    };
    auto do_row = [&](int row, u32x4 a, u32x4 b) {
        float v[16] = {bflo(a.x), bfhi(a.x), bflo(a.y), bfhi(a.y), bflo(a.z), bfhi(a.z), bflo(a.w), bfhi(a.w), bflo(b.x), bfhi(b.x), bflo(b.y), bfhi(b.y), bflo(b.z), bfhi(b.z), bflo(b.w), bfhi(b.w)};
        float ss = 0.f;
#pragma unroll
        for (int i = 0; i < 16; ++i) ss += v[i] * v[i];
        ss = wave_sum(ss);
        const float rstd = rsqrtf(ss * (1.f / 1024.f) + EPS);
#pragma unroll
        for (int i = 0; i < 16; ++i) v[i] = v[i] * rstd * gsv[i] + shv[i];
        u32x4 w0, w1;
        w0.x = pk2(v[0], v[1]); w0.y = pk2(v[2], v[3]); w0.z = pk2(v[4], v[5]); w0.w = pk2(v[6], v[7]);
        w1.x = pk2(v[8], v[9]); w1.y = pk2(v[10], v[11]); w1.z = pk2(v[12], v[13]); w1.w = pk2(v[14], v[15]);
        u32x4* d = (u32x4*)(ACT + (size_t)row * 1024 + lane * 16); d[0] = w0; d[1] = w1;
    };
    for (int chunk = blockIdx.x * 8 + wid; chunk < MP / 8; chunk += nw) {
        const int r0 = chunk * 8;
        ld_mod(r0 >> 11);
#pragma unroll 1
        for (int h4 = 0; h4 < 2; ++h4) {
            u32x4 r[8];
#pragma unroll
            for (int j = 0; j < 4; ++j) { const u32x4* src = (const u32x4*)(X1 + (size_t)(r0 + 4 * h4 + j) * 1024 + lane * 16); r[2 * j] = src[0]; r[2 * j + 1] = src[1]; }
            pin8(r);
#pragma unroll
            for (int j = 0; j < 4; ++j) do_row(r0 + 4 * h4 + j, r[2 * j], r[2 * j + 1]);
        }
    }
    for (int rr = blockIdx.x * 8 + wid; rr < MS; rr += nw) {
        ld_mod(8 + (rr >> 3));
        const u32x4* src = (const u32x4*)(X1 + (size_t)(MP + rr) * 1024 + lane * 16);
        const u32x4 a = src[0], b = src[1];
        do_row(MP + rr, a, b);
    }
}

constexpr int WT_TASKS = 5120 + 512;
DI void wt_task(const Params& p, int t, int lane) {
    const float* src; bf16_t* dst; int pitch;
    if (t < 5120) { src = p.in[I_BWIN]; dst = (bf16_t*)(p.ws + WS_WTB); pitch = 10240; }
    else { src = p.in[I_BWOUT]; dst = (bf16_t*)(p.ws + WS_WTBO); pitch = 1024; t -= 5120; }
    const int k0 = (t & 31) * 32, n = (t >> 5) * 64 + lane;
    const float* sp = src + (size_t)k0 * pitch + n;
    f32x4 v[8];
#pragma unroll
    for (int q = 0; q < 8; ++q) { v[q][0] = sp[(size_t)(4 * q) * pitch]; v[q][1] = sp[(size_t)(4 * q + 1) * pitch]; v[q][2] = sp[(size_t)(4 * q + 2) * pitch]; v[q][3] = sp[(size_t)(4 * q + 3) * pitch]; }
    pin8(v);
    u32x4* dp = (u32x4*)(dst + (size_t)n * 1024 + k0);
#pragma unroll
    for (int q = 0; q < 4; ++q) { u32x4 w; w.x = pk2(v[2 * q][0], v[2 * q][1]); w.y = pk2(v[2 * q][2], v[2 * q][3]); w.z = pk2(v[2 * q + 1][0], v[2 * q + 1][1]); w.w = pk2(v[2 * q + 1][2], v[2 * q + 1][3]); dp[q] = w; }
}

constexpr int PQ = 0, PK = 17408, PT = 34816, PR = 53248, PN = 118784, PG = 136192;
DI void prep_item(const Params& p, LAS unsigned char* lds, int ci) {
    const int tid = TID(), lane = tid & 63, wid = tid >> 6;
    const bf16_t* P0 = (const bf16_t*)(p.ws + WS_P0);
    const float* GB = (const float*)(p.ws + WS_GB);
    int h, row0, nvalid, nprev; const float* sconv = nullptr;
    if (ci < 2048) { const int bh = ci >> 5, n = ci & 31; h = bh & 7; row0 = (bh >> 3) * 2048 + n * 64; nvalid = 64; nprev = n * 64; }
    else { const int sb = (ci - 2048) >> 3; h = (ci - 2048) & 7; row0 = MP + sb * 8; nvalid = 8; nprev = 0; sconv = p.in[I_SC] + (size_t)sb * 3 * 3072; }
    LAS float* sg = (LAS float*)(lds + PG);
    LAS float* cw = (LAS float*)(lds + PG + 1024);
    const int i = tid >> 3, sub = tid & 7;
    lds_sync();
    u32x4 raw[4][3][2];
#pragma unroll
    for (int t = 0; t < 4; ++t) {
        const int rel = i - 3 + t;
#pragma unroll
        for (int sct = 0; sct < 3; ++sct) {
            const int ch = sct * 1024 + h * 128 + sub * 16;
            raw[t][sct][0] = (u32x4){0u, 0u, 0u, 0u}; raw[t][sct][1] = (u32x4){0u, 0u, 0u, 0u};
            if (i < nvalid) {
                if (rel >= 0 || nprev > 0) {
                    const u32x4* src = (const u32x4*)(P0 + (size_t)(row0 + rel) * 4096 + ch);
                    raw[t][sct][0] = src[0]; raw[t][sct][1] = src[1];
                } else if (sconv) {
                    const f32x4* src = (const f32x4*)(sconv + (size_t)(3 + rel) * 3072 + ch);
                    const f32x4 a = src[0], b = src[1], c = src[2], d = src[3];
                    raw[t][sct][0] = (u32x4){pk2(a[0], a[1]), pk2(a[2], a[3]), pk2(b[0], b[1]), pk2(b[2], b[3])};
                    raw[t][sct][1] = (u32x4){pk2(c[0], c[1]), pk2(c[2], c[3]), pk2(d[0], d[1]), pk2(d[2], d[3])};
                }
            }
        }
    }
    {
        float cwv[3];
#pragma unroll
        for (int q = 0; q < 3; ++q) { const int idx = tid + 512 * q, t = idx / 384, rem = idx - t * 384, sct = rem >> 7, c = rem & 127; cwv[q] = p.in[I_ACONV][(size_t)t * 3072 + sct * 1024 + h * 128 + c]; }
        asm volatile("" : "+v"(cwv[0]), "+v"(cwv[1]), "+v"(cwv[2]));
#pragma unroll
        for (int q = 0; q < 3; ++q) cw[tid + 512 * q] = cwv[q];
    }
    if (wid == 0) {
        float g = lane < nvalid ? GB[(size_t)(row0 + lane) * 16 + h] : 0.f;
        const float be = lane < nvalid ? GB[(size_t)(row0 + lane) * 16 + 8 + h] : 0.f;
#pragma unroll
        for (int o = 1; o < 64; o <<= 1) { const float t = __shfl_up(g, o); if (lane >= o) g += t; }
        sg[lane] = g; sg[64 + lane] = be; sg[128 + lane] = __expf(g);
        if (lane == 63) { sg[192] = g; ((float*)(p.ws + WS_GT))[ci] = __expf(g); }
    }
    asm volatile("" : "+v"(raw[0][0][0]), "+v"(raw[0][0][1]), "+v"(raw[0][1][0]), "+v"(raw[0][1][1]), "+v"(raw[0][2][0]), "+v"(raw[0][2][1]), "+v"(raw[1][0][0]), "+v"(raw[1][0][1]), "+v"(raw[1][1][0]), "+v"(raw[1][1][1]), "+v"(raw[1][2][0]), "+v"(raw[1][2][1]), "+v"(raw[2][0][0]), "+v"(raw[2][0][1]), "+v"(raw[2][1][0]), "+v"(raw[2][1][1]), "+v"(raw[2][2][0]), "+v"(raw[2][2][1]), "+v"(raw[3][0][0]), "+v"(raw[3][0][1]), "+v"(raw[3][1][0]), "+v"(raw[3][1][1]), "+v"(raw[3][2][0]), "+v"(raw[3][2][1]));
    lds_sync();
    {
        float y[3][16];
#pragma unroll
        for (int sct = 0; sct < 3; ++sct) {
#pragma unroll
            for (int j = 0; j < 16; ++j) y[sct][j] = 0.f;
#pragma unroll
            for (int t = 0; t < 4; ++t) {
                const u32x4 a = raw[t][sct][0], b = raw[t][sct][1];
                const float u[16] = {bflo(a.x), bfhi(a.x), bflo(a.y), bfhi(a.y), bflo(a.z), bfhi(a.z), bflo(a.w), bfhi(a.w),
                                     bflo(b.x), bfhi(b.x), bflo(b.y), bfhi(b.y), bflo(b.z), bfhi(b.z), bflo(b.w), bfhi(b.w)};
#pragma unroll
                for (int q = 0; q < 4; ++q) { const f32x4 w = *(const LAS f32x4*)(cw + (t * 3 + sct) * 128 + sub * 16 + q * 4);
                    y[sct][q * 4] += w[0] * u[q * 4]; y[sct][q * 4 + 1] += w[1] * u[q * 4 + 1]; y[sct][q * 4 + 2] += w[2] * u[q * 4 + 2]; y[sct][q * 4 + 3] += w[3] * u[q * 4 + 3]; }
            }
#pragma unroll
            for (int j = 0; j < 16; ++j) y[sct][j] = siluf(y[sct][j]);
        }
        float sq = 0.f, sk = 0.f;
#pragma unroll
        for (int j = 0; j < 16; ++j) { sq += y[0][j] * y[0][j]; sk += y[1][j] * y[1][j]; }
        sq += dpp_f<0xB1>(sq); sq += dpp_f<0x4E>(sq); sq += dpp_f<0x141>(sq);
        sk += dpp_f<0xB1>(sk); sk += dpp_f<0x4E>(sk); sk += dpp_f<0x141>(sk);
        const float rq = rsqrtf(sq + EPS) * 0.08838834764831845f, rk = rsqrtf(sk + EPS);
        const float gci = sg[i], bei = sg[64 + i], egi = sg[128 + i], ekd = __expf(sg[192] - gci);
        LAS float* R = (LAS float*)(lds + PR) + i * 256;
        u32x4 qa, qb, ka, kb, da, db;
        float qn[16], kn[16];
#pragma unroll
        for (int j = 0; j < 16; ++j) { qn[j] = y[0][j] * rq; kn[j] = y[1][j] * rk; }
        qa.x = pk2(qn[0], qn[1]); qa.y = pk2(qn[2], qn[3]); qa.z = pk2(qn[4], qn[5]); qa.w = pk2(qn[6], qn[7]);
        qb.x = pk2(qn[8], qn[9]); qb.y = pk2(qn[10], qn[11]); qb.z = pk2(qn[12], qn[13]); qb.w = pk2(qn[14], qn[15]);
        ka.x = pk2(kn[0], kn[1]); ka.y = pk2(kn[2], kn[3]); ka.z = pk2(kn[4], kn[5]); ka.w = pk2(kn[6], kn[7]);
        kb.x = pk2(kn[8], kn[9]); kb.y = pk2(kn[10], kn[11]); kb.z = pk2(kn[12], kn[13]); kb.w = pk2(kn[14], kn[15]);
        *(LAS u32x4*)(lds + PQ + i * 272 + sub * 32) = qa; *(LAS u32x4*)(lds + PQ + i * 272 + sub * 32 + 16) = qb;
        *(LAS u32x4*)(lds + PK + i * 272 + sub * 32) = ka; *(LAS u32x4*)(lds + PK + i * 272 + sub * 32 + 16) = kb;
        da.x = pk2(qn[0] * egi, qn[1] * egi); da.y = pk2(qn[2] * egi, qn[3] * egi); da.z = pk2(qn[4] * egi, qn[5] * egi); da.w = pk2(qn[6] * egi, qn[7] * egi);
        db.x = pk2(qn[8] * egi, qn[9] * egi); db.y = pk2(qn[10] * egi, qn[11] * egi); db.z = pk2(qn[12] * egi, qn[13] * egi); db.w = pk2(qn[14] * egi, qn[15] * egi);
        bf16_t* qd = (bf16_t*)(p.ws + WS_QD) + (size_t)ci * 8192 + i * 128 + sub * 16;
        *(u32x4*)qd = da; *(u32x4*)(qd + 8) = db;
        LAS bf16_t* T = (LAS bf16_t*)(lds + PT);
#pragma unroll
        for (int j = 0; j < 16; ++j) T[(sub * 16 + j) * 72 + i] = (bf16_t)(pk2(kn[j] * ekd, 0.f) & 0xffffu);
        const float kbs = bei * egi;
#pragma unroll
        for (int q = 0; q < 4; ++q) {
            *(LAS f32x4*)(R + sub * 16 + q * 4) = (f32x4){y[2][q * 4] * bei, y[2][q * 4 + 1] * bei, y[2][q * 4 + 2] * bei, y[2][q * 4 + 3] * bei};
            *(LAS f32x4*)(R + 128 + sub * 16 + q * 4) = (f32x4){kn[q * 4] * kbs, kn[q * 4 + 1] * kbs, kn[q * 4 + 2] * kbs, kn[q * 4 + 3] * kbs};
        }
    }
    lds_sync();
    {
        const int r16 = lane & 15, fq = lane >> 4;
        bf16_t* QK = (bf16_t*)(p.ws + WS_QK) + (size_t)ci * 4096;
        LAS float* Nm = (LAS float*)(lds + PN);
#pragma unroll
        for (int t = 0; t < 4; ++t) {
            const int id = wid * 4 + t, mat = id >> 4, ti = (id & 15) >> 2, tj = id & 3;
            f32x4 acc = {0.f, 0.f, 0.f, 0.f};
            if (tj <= ti) {
                const LAS unsigned char* xa = lds + PK + (tj * 16 + r16) * 272 + fq * 16;
                const LAS unsigned char* xb = lds + (mat ? PQ : PK) + (ti * 16 + r16) * 272 + fq * 16;
#pragma unroll
                for (int ks = 0; ks < 4; ++ks) acc = mfma16(lds_ld8(xa + ks * 64), lds_ld8(xb + ks * 64), acc);
            }
            const int i = ti * 16 + r16, j0 = tj * 16 + fq * 4;
            const float gi = sg[i], bi = sg[64 + i];
            f32x4 o;
#pragma unroll
            for (int r = 0; r < 4; ++r) {
                const int j = j0 + r;
                const bool ok = mat ? (j <= i) : (j < i);
                const float dec = ok ? __expf(gi - sg[j]) : 0.f;
                o[r] = ok ? acc[r] * dec * (mat ? 1.f : bi) : 0.f;
            }
            if (mat) { u32x2 w; w.x = pk2(o[0], o[1]); w.y = pk2(o[2], o[3]); *(u32x2*)(QK + i * 64 + j0) = w; }
            else *(LAS f32x4*)(Nm + i * 68 + j0) = o;
        }
    }
    lds_sync();
    if (tid < 256) {
        const LAS float* R = (const LAS float*)(lds + PR) + tid;
        int zv = 0; asm volatile("" : "+v"(zv));
        const LAS float* Nm = (const LAS float*)(lds + PN + zv);
        float x[64];
        f32x4 nb[2][16];
        x[0] = R[0];
        float rn = R[256];
        nb[1][0] = *(const LAS f32x4*)(Nm + 68);
#pragma unroll
        for (int i = 1; i < 64; ++i) {
            const float r = rn;
            if (i + 1 < 64) {
                rn = R[(i + 1) * 256];
#pragma unroll
                for (int j4 = 0; j4 < (i + 4) / 4; ++j4) nb[(i + 1) & 1][j4] = *(const LAS f32x4*)(Nm + (i + 1) * 68 + j4 * 4);
            }
            float a0 = 0.f, a1 = 0.f, a2 = 0.f, a3 = 0.f;
#pragma unroll
            for (int j4 = 0; j4 < (i + 3) / 4; ++j4) {
                const f32x4 nv = nb[i & 1][j4];
                if (j4 * 4 + 0 < i) a0 += nv[0] * x[j4 * 4 + 0];
                if (j4 * 4 + 1 < i) a1 += nv[1] * x[j4 * 4 + 1];
                if (j4 * 4 + 2 < i) a2 += nv[2] * x[j4 * 4 + 2];
                if (j4 * 4 + 3 < i) a3 += nv[3] * x[j4 * 4 + 3];
            }
            x[i] = r - ((a0 + a1) + (a2 + a3));
            asm volatile("" ::: "memory");
        }
        if (tid < 128) {
            u32x4* d = (u32x4*)((bf16_t*)(p.ws + WS_WV) + (size_t)ci * 8192 + tid * 64);
#pragma unroll
            for (int q = 0; q < 8; ++q) { u32x4 w; w.x = pk2(x[q * 8], x[q * 8 + 1]); w.y = pk2(x[q * 8 + 2], x[q * 8 + 3]); w.z = pk2(x[q * 8 + 4], x[q * 8 + 5]); w.w = pk2(x[q * 8 + 6], x[q * 8 + 7]); d[q] = w; }
        } else {
            bf16_t* d = (bf16_t*)(p.ws + WS_KC) + (size_t)ci * 8192 + (tid - 128);
#pragma unroll
            for (int i = 0; i < 64; ++i) d[i * 128] = (bf16_t)(pk2(x[i], 0.f) & 0xffffu);
        }
    } else {
        bf16_t* d = (bf16_t*)(p.ws + WS_KDT) + (size_t)ci * 8192;
#pragma unroll
        for (int q = 0; q < 4; ++q) { const int idx = (tid - 256) + q * 256, r = idx >> 3, c8 = idx & 7; *(u32x4*)(d + r * 64 + c8 * 8) = *(const LAS u32x4*)(lds + PT + r * 144 + c8 * 16); }
        const int wtask = ci * 4 + (wid - 4);
        if (wtask < WT_TASKS) wt_task(p, wtask, lane);
    }
}
DI void phase_dprep(const Params& p, LAS unsigned char* lds) { for (int ci = blockIdx.x; ci < NCH; ci += gridDim.x) prep_item(p, lds, ci); }

constexpr int SKC = 0, SQD = 17408, SKD = 34816, SQK = 53248, SST = 62464, SUT = 71168;
DI void scan_item(const Params& p, LAS unsigned char* lds, int item) {
    const int tid = TID(), lane = tid & 63, wid = tid >> 6, r16 = lane & 15, fq = lane >> 4;
    int ch0, nch, rowbase, h, dvs, nvalid; const float* S0 = nullptr; float* Sout;
    if (item < 256) { const int bh = item >> 2; dvs = item & 3; h = bh & 7; ch0 = bh * 32; nch = 32; rowbase = (bh >> 3) * 2048; nvalid = 64; Sout = p.out + O_DP + (size_t)bh * 16384; }
    else { const int it = item - 256, sbh = it >> 2; dvs = it & 3; h = sbh & 7; ch0 = 2048 + sbh; nch = 1; rowbase = MP + (sbh >> 3) * 8; nvalid = 8;
           S0 = p.in[I_SD] + (size_t)sbh * 16384; Sout = p.out + O_DS + (size_t)sbh * 16384; }
    const int dvoff = dvs * 32;
    const int dk0 = wid * 16;
    f32x4 accS[2];
#pragma unroll
    for (int vt = 0; vt < 2; ++vt)
#pragma unroll
        for (int r = 0; r < 4; ++r) accS[vt][r] = S0 ? S0[(size_t)(dk0 + 4 * fq + r) * 128 + dvoff + vt * 16 + r16] : 0.f;
    const bf16_t* gKC = (const bf16_t*)(p.ws + WS_KC); const bf16_t* gQD = (const bf16_t*)(p.ws + WS_QD);
    const bf16_t* gKD = (const bf16_t*)(p.ws + WS_KDT); const bf16_t* gQK = (const bf16_t*)(p.ws + WS_QK);
    const bf16_t* gWV = (const bf16_t*)(p.ws + WS_WV); const float* gGT = (const float*)(p.ws + WS_GT);
    bf16_t* O0 = (bf16_t*)(p.ws + WS_O0);
    u32x4 st[7];
    auto issue = [&](int ci) {
        const u32x4* a = (const u32x4*)(gKC + (size_t)ci * 8192); const u32x4* b = (const u32x4*)(gQD + (size_t)ci * 8192);
        const u32x4* c = (const u32x4*)(gKD + (size_t)ci * 8192); const u32x4* d = (const u32x4*)(gQK + (size_t)ci * 4096);
        st[0] = a[tid]; st[1] = a[tid + 512]; st[2] = b[tid]; st[3] = b[tid + 512]; st[4] = c[tid]; st[5] = c[tid + 512]; st[6] = d[tid];
    };
    auto commit = [&]() {
#pragma unroll
        for (int l = 0; l < 2; ++l) { const int idx = tid + 512 * l;
            *(LAS u32x4*)(lds + SKC + (idx >> 4) * 272 + (idx & 15) * 16) = st[l];
            *(LAS u32x4*)(lds + SQD + (idx >> 4) * 272 + (idx & 15) * 16) = st[2 + l];
            *(LAS u32x4*)(lds + SKD + (idx >> 3) * 144 + (idx & 7) * 16) = st[4 + l]; }
        *(LAS u32x4*)(lds + SQK + (tid >> 3) * 144 + (tid & 7) * 16) = st[6];
    };
    auto put_St = [&]() {
#pragma unroll
        for (int vt = 0; vt < 2; ++vt) { u32x2 w; w.x = pk2(accS[vt][0], accS[vt][1]); w.y = pk2(accS[vt][2], accS[vt][3]);
            *(LAS u32x2*)(lds + SST + (vt * 16 + r16) * 272 + (dk0 + 4 * fq) * 2) = w; }
    };
    lds_sync();
    issue(ch0); put_St(); commit();
    lds_sync();
    const int c0 = (wid & 3) * 16, v0 = (wid >> 2) * 16;
    u32x2 wv_n = *(const u32x2*)(gWV + (size_t)ch0 * 8192 + (dvoff + v0 + r16) * 64 + c0 + 4 * fq);
    float gtot_n = gGT[ch0];
    for (int n = 0; n < nch; ++n) {
        const int ci = ch0 + n;
        const u32x2 wv = wv_n; const float gtot = gtot_n;
        if (n + 1 < nch) { issue(ci + 1); wv_n = *(const u32x2*)(gWV + (size_t)(ci + 1) * 8192 + (dvoff + v0 + r16) * 64 + c0 + 4 * fq); gtot_n = gGT[ci + 1]; }
        f32x4 a1 = {0.f, 0.f, 0.f, 0.f};
        { bf16x8 fa[4], fb[4];
#pragma unroll
          for (int ks = 0; ks < 4; ++ks) { fa[ks] = lds_ld8(lds + SKC + (c0 + r16) * 272 + ks * 64 + fq * 16); fb[ks] = lds_ld8(lds + SST + (v0 + r16) * 272 + ks * 64 + fq * 16); }
          pin4x4(fa, fb);
#pragma unroll
          for (int ks = 0; ks < 4; ++ks) a1 = mfma16(fa[ks], fb[ks], a1); }
        { u32x2 w; w.x = pk2(bflo(wv.x) - a1[0], bfhi(wv.x) - a1[1]); w.y = pk2(bflo(wv.y) - a1[2], bfhi(wv.y) - a1[3]);
          *(LAS u32x2*)(lds + SUT + (v0 + r16) * 144 + (c0 + 4 * fq) * 2) = w; }
        lds_sync();
        f32x4 a2 = {0.f, 0.f, 0.f, 0.f};
        bf16x8 ga[8], gb[8];
#pragma unroll
        for (int ks = 0; ks < 4; ++ks) { ga[ks] = lds_ld8(lds + SST + (v0 + r16) * 272 + ks * 64 + fq * 16); gb[ks] = lds_ld8(lds + SQD + (c0 + r16) * 272 + ks * 64 + fq * 16); }
#pragma unroll
        for (int ks = 0; ks < 2; ++ks) { ga[4 + ks] = lds_ld8(lds + SUT + (v0 + r16) * 144 + ks * 64 + fq * 16); gb[4 + ks] = lds_ld8(lds + SQK + (c0 + r16) * 144 + ks * 64 + fq * 16); }
#pragma unroll
        for (int ks = 0; ks < 2; ++ks) { ga[6 + ks] = lds_ld8(lds + SKD + (dk0 + r16) * 144 + ks * 64 + fq * 16); gb[6 + ks] = lds_ld8(lds + SUT + ((1 - (wid >> 2)) * 16 + r16) * 144 + ks * 64 + fq * 16); }
        pin8x8(ga, gb);
#pragma unroll
        for (int ks = 0; ks < 6; ++ks) a2 = mfma16(ga[ks], gb[ks], a2);
        if (c0 + r16 < nvalid) { u32x2 w; w.x = pk2(a2[0], a2[1]); w.y = pk2(a2[2], a2[3]);
            *(u32x2*)(O0 + (size_t)(rowbase + n * 64 + c0 + r16) * 1024 + h * 128 + dvoff + v0 + 4 * fq) = w; }
#pragma unroll
        for (int vt = 0; vt < 2; ++vt) {
            accS[vt] *= gtot;
            const bool own = (vt == (wid >> 2));
#pragma unroll
            for (int ks = 0; ks < 2; ++ks) accS[vt] = mfma16(ga[6 + ks], own ? ga[4 + ks] : gb[6 + ks], accS[vt]);
        }
        lds_sync();
        put_St();
        if (n + 1 < nch) commit();
        lds_sync();
    }
#pragma unroll
    for (int vt = 0; vt < 2; ++vt)
#pragma unroll
        for (int r = 0; r < 4; ++r) Sout[(size_t)(dk0 + 4 * fq + r) * 128 + dvoff + vt * 16 + r16] = accS[vt][r];
}
DI void phase_scan(const Params& p, LAS unsigned char* lds) {
    const int bid = blockIdx.x, G = gridDim.x;
    if (G == 256) {
        const int xcd = bid & 7, idx = bid >> 3, dvs = idx & 3, hx = xcd * 8 + (idx >> 2);
        scan_item(p, lds, hx * 4 + dvs);
        for (int i = 0; i < 4; ++i) scan_item(p, lds, 256 + (i * 64 + hx) * 4 + dvs);
    } else {
        for (int it = bid; it < 256 + 1024; it += G) scan_item(p, lds, it);
    }
}

DI void phase_gate0(const Params& p) {
    const int lane = TID() & 63, wid = TID() >> 6;
    const bf16_t* O0 = (const bf16_t*)(p.ws + WS_O0); const bf16_t* P0 = (const bf16_t*)(p.ws + WS_P0); bf16_t* ACT = (bf16_t*)(p.ws + WS_ACT);
    const float* og = p.in[I_AOG] + (lane & 7) * 16;
    const int nw = gridDim.x * 8;
    auto ld_row = [&](int row, u32x4 (&r)[4]) {
        const u32x4* so = (const u32x4*)(O0 + (size_t)row * 1024 + lane * 16); const u32x4* sz = (const u32x4*)(P0 + (size_t)row * 4096 + 3072 + lane * 16);
        r[0] = so[0]; r[1] = so[1]; r[2] = sz[0]; r[3] = sz[1];
    };
    auto do_row = [&](int row, const u32x4 (&r)[4]) {
        float o[16], z[16];
#pragma unroll
        for (int q = 0; q < 2; ++q) { const u32x4 a = r[q], b = r[2 + q];
            o[q * 8] = bflo(a.x); o[q * 8 + 1] = bfhi(a.x); o[q * 8 + 2] = bflo(a.y); o[q * 8 + 3] = bfhi(a.y); o[q * 8 + 4] = bflo(a.z); o[q * 8 + 5] = bfhi(a.z); o[q * 8 + 6] = bflo(a.w); o[q * 8 + 7] = bfhi(a.w);
            z[q * 8] = bflo(b.x); z[q * 8 + 1] = bfhi(b.x); z[q * 8 + 2] = bflo(b.y); z[q * 8 + 3] = bfhi(b.y); z[q * 8 + 4] = bflo(b.z); z[q * 8 + 5] = bfhi(b.z); z[q * 8 + 6] = bflo(b.w); z[q * 8 + 7] = bfhi(b.w); }
        float ss = 0.f;
#pragma unroll
        for (int j = 0; j < 16; ++j) ss += o[j] * o[j];
        ss += dpp_f<0xB1>(ss); ss += dpp_f<0x4E>(ss); ss += dpp_f<0x141>(ss);
        const float rstd = rsqrtf(ss * (1.f / 128.f) + EPS);
        float rr[16];
#pragma unroll
        for (int j = 0; j < 16; ++j) rr[j] = o[j] * rstd * og[j] * siluf(z[j]);
        u32x4 w0, w1;
        w0.x = pk2(rr[0], rr[1]); w0.y = pk2(rr[2], rr[3]); w0.z = pk2(rr[4], rr[5]); w0.w = pk2(rr[6], rr[7]);
        w1.x = pk2(rr[8], rr[9]); w1.y = pk2(rr[10], rr[11]); w1.z = pk2(rr[12], rr[13]); w1.w = pk2(rr[14], rr[15]);
        u32x4* d = (u32x4*)(ACT + (size_t)row * 1024 + lane * 16); d[0] = w0; d[1] = w1;
    };
    for (int row = blockIdx.x * 8 + wid; row < MT; row += 4 * nw) {
        u32x4 ra[4], rb[4], rc[4], rd[4];
        const int r1 = row + nw, r2 = row + 2 * nw, r3 = row + 3 * nw;
        if (r3 < MT) { ld_row(row, ra); ld_row(r1, rb); ld_row(r2, rc); ld_row(r3, rd); pin4x4x4x4(ra, rb, rc, rd); do_row(row, ra); do_row(r1, rb); do_row(r2, rc); do_row(r3, rd); }
        else { ld_row(row, ra); do_row(row, ra); if (r1 < MT) { ld_row(r1, rb); do_row(r1, rb); } if (r2 < MT) { ld_row(r2, rc); do_row(r2, rc); } }
    }
}

constexpr int AK = 0, AV = 73984;
struct AttnPre { u32x4 k[8]; u32x4 v[8]; bf16x8 q[4]; };
struct AttnIt { int g, b, h, r, j0, d, Sd; };
DI AttnIt attn_decode(int item) {
    AttnIt a; const int x = item & 15; a.h = (item >> 4) & 7; a.b = (item >> 7) & 7; a.g = item >> 10;
    const int dshift = a.g * 2; a.d = 1 << dshift; a.Sd = 2048 >> dshift; const int nqb = a.Sd >> 7;
    a.r = x / nqb; a.j0 = (x % nqb) * 128; return a;
}
DI void attn_issue(const Params& p, int item, AttnPre& pre) {
    const int tid = TID(), lane = tid & 63, wid = tid >> 6, r16 = lane & 15, fq = lane >> 4;
    const AttnIt a = attn_decode(item);
    const bf16_t* base = (const bf16_t*)(p.ws + WS_P1) + (size_t)a.b * 2048 * 10240 + a.g * 1024 + a.h * 128;
    const size_t rstride = (size_t)a.d * 10240;
    const bf16_t* kbase = base + (long)((a.j0 - 128) * a.d + a.r) * 10240;
    const int kg = tid >> 4, ec = tid & 15;
    if (a.j0 != 0) {
#pragma unroll
        for (int k = 0; k < 8; ++k) { const int idx = tid + 512 * k; pre.k[k] = *(const u32x4*)(kbase + (size_t)(idx >> 4) * rstride + 3072 + (idx & 15) * 8); }
#pragma unroll
        for (int i = 0; i < 8; ++i) pre.v[i] = *(const u32x4*)(kbase + (size_t)(kg * 8 + i) * rstride + 6144 + ec * 8);
    } else {
#pragma unroll
        for (int k = 0; k < 4; ++k) pre.k[k] = (u32x4){0u, 0u, 0u, 0u};
#pragma unroll
        for (int k = 4; k < 8; ++k) { const int idx = tid + 512 * k; pre.k[k] = *(const u32x4*)(kbase + (size_t)(idx >> 4) * rstride + 3072 + (idx & 15) * 8); }
#pragma unroll
        for (int i = 0; i < 8; ++i) { pre.v[i] = (u32x4){0u, 0u, 0u, 0u}; if (tid >= 256) pre.v[i] = *(const u32x4*)(kbase + (size_t)(kg * 8 + i) * rstride + 6144 + ec * 8); }
    }
    const int qtok = (a.j0 + 16 * wid + r16) * a.d + a.r;
#pragma unroll
    for (int ks = 0; ks < 4; ++ks) pre.q[ks] = *(const bf16x8*)(base + (size_t)qtok * 10240 + ks * 32 + fq * 8);
}
DI void st_f32x8_from_bf16(float* d, u32x4 w) {
    *(f32x4*)d = (f32x4){bflo(w.x), bfhi(w.x), bflo(w.y), bfhi(w.y)}; *(f32x4*)(d + 4) = (f32x4){bflo(w.z), bfhi(w.z), bflo(w.w), bfhi(w.w)};
}
DI void attn_commit(LAS unsigned char* lds, const AttnPre& pre, const Params& p, int item) {
    const int tid = TID();
    const AttnIt a = attn_decode(item);
#pragma unroll
    for (int k = 0; k < 8; ++k) { const int idx = tid + 512 * k; *(LAS u32x4*)(lds + AK + (idx >> 4) * 272 + (idx & 15) * 16) = pre.k[k]; }
    const int kg = tid >> 4, ec = tid & 15;
#pragma unroll
    for (int e2 = 0; e2 < 4; ++e2) {
        u32x4 lo, hi;
#pragma unroll
        for (int pq = 0; pq < 4; ++pq) { const unsigned x0 = pre.v[2 * pq][e2], x1 = pre.v[2 * pq + 1][e2]; lo[pq] = (x0 & 0xffffu) | (x1 << 16); hi[pq] = (x0 >> 16) | (x1 & 0xffff0000u); }
        *(LAS u32x4*)(lds + AV + (ec * 8 + 2 * e2) * 560 + kg * 16) = lo;
        *(LAS u32x4*)(lds + AV + (ec * 8 + 2 * e2 + 1) * 560 + kg * 16) = hi;
    }
}
DI void attn_compute(const Params& p, LAS unsigned char* lds, int item, const bf16x8 (&qf)[4]) {
    const int tid = TID(), lane = tid & 63, wid = tid >> 6, r16 = lane & 15, fq = lane >> 4;
    const AttnIt a = attn_decode(item);
    const int g = a.g, b = a.b, h = a.h;
    const int qj = a.j0 + 16 * wid + r16, qtok = qj * a.d + a.r;
    f32x4 s[10];
    const LAS unsigned char* kbase = lds + AK + (16 * wid + r16) * 272 + fq * 16;
#pragma unroll
    for (int T2 = 0; T2 < 5; ++T2) {
        bf16x8 kf[8];
#pragma unroll
        for (int u = 0; u < 8; ++u) { const int T = 2 * T2 + (u >> 2); kf[u] = lds_ld8(kbase + (T < 9 ? T : 8) * (16 * 272) + (u & 3) * 64); }
        pin8(kf);
#pragma unroll
        for (int u = 0; u < 8; ++u) { const int T = 2 * T2 + (u >> 2); if (T < 9) { if ((u & 3) == 0) s[T] = (f32x4){0.f, 0.f, 0.f, 0.f}; s[T] = mfma16(kf[u], qf[u & 3], s[T]); } }
    }
#pragma unroll
    for (int rr = 0; rr < 4; ++rr) {
        if (r16 - 4 * fq - rr > 0) s[0][rr] = -INFINITY;
        if (r16 - 4 * fq - rr < 0) s[8][rr] = -INFINITY;
    }
    if (a.j0 == 0) {
#pragma unroll
        for (int T = 0; T < 9; ++T)
#pragma unroll
            for (int rr = 0; rr < 4; ++rr) { const int rel = 128 + r16 - 16 * T - 4 * fq - rr; if (qj - rel < 0) s[T][rr] = -INFINITY; }
    }
    float m = -INFINITY;
#pragma unroll
    for (int T = 0; T < 9; ++T) m = fmaxf(m, fmaxf(fmaxf(s[T][0], s[T][1]), fmaxf(s[T][2], s[T][3])));
    m = fmaxf(m, __shfl_xor(m, 16)); m = fmaxf(m, __shfl_xor(m, 32));
    float l = 0.f;
#pragma unroll
    for (int T = 0; T < 9; ++T)
#pragma unroll
        for (int rr = 0; rr < 4; ++rr) { const float pv = __builtin_amdgcn_exp2f(s[T][rr] - m); s[T][rr] = pv; l += pv; }
    s[9] = (f32x4){0.f, 0.f, 0.f, 0.f};
    l += __shfl_xor(l, 16); l += __shfl_xor(l, 32);
    f32x4 o[8];
#pragma unroll
    for (int et = 0; et < 8; ++et) o[et] = (f32x4){0.f, 0.f, 0.f, 0.f};
    const LAS unsigned char* vbase = lds + AV + r16 * 560 + (16 * wid + 4 * fq) * 2;
#pragma unroll
    for (int tp = 0; tp < 5; ++tp) {
        u32x4 pb; pb.x = pk2(s[2 * tp][0], s[2 * tp][1]); pb.y = pk2(s[2 * tp][2], s[2 * tp][3]); pb.z = pk2(s[2 * tp + 1][0], s[2 * tp + 1][1]); pb.w = pk2(s[2 * tp + 1][2], s[2 * tp + 1][3]);
        const bf16x8 pf = __builtin_bit_cast(bf16x8, pb);
        u32x4 vv[8];
#pragma unroll
        for (int et = 0; et < 8; ++et) {
            const LAS unsigned char* vp = vbase + et * (16 * 560) + tp * 64;
            const u32x2 va = *(const LAS u32x2*)vp, vb = *(const LAS u32x2*)(vp + 32);
            vv[et] = (u32x4){va.x, va.y, vb.x, vb.y};
        }
        pin8(vv);
#pragma unroll
        for (int et = 0; et < 8; ++et) o[et] = mfma16(__builtin_bit_cast(bf16x8, vv[et]), pf, o[et]);
    }
    const float il = 1.f / l;
    const size_t orow = (size_t)b * 2048 + qtok;
    bf16_t* og = (bf16_t*)(p.ws + WS_OG) + ((size_t)g * MT + orow) * 1024 + h * 128;
#pragma unroll
    for (int et = 0; et < 8; ++et) { u32x2 w; w.x = pk2(o[et][0] * il, o[et][1] * il); w.y = pk2(o[et][2] * il, o[et][3] * il); *(u32x2*)(og + 16 * et + 4 * fq) = w; }
    if (fq == 0) ((float*)(p.ws + WS_LSE))[((size_t)g * MT + orow) * 8 + h] = 0.6931471805599453f * (m + log2f(l));
}
DI void attn_prompt_all(const Params& p, LAS unsigned char* lds) {
    const int tid = TID();
    lds_sync();
    if (tid < 256) *(LAS u32x4*)(lds + AK + (256 + (tid >> 4)) * 272 + (tid & 15) * 16) = (u32x4){0u, 0u, 0u, 0u};
    else { const int t2 = tid - 256; *(LAS u32x4*)(lds + AV + (t2 >> 1) * 560 + (256 + (t2 & 1) * 8) * 2) = (u32x4){0u, 0u, 0u, 0u}; }
    AttnPre pre;
    const int bid = blockIdx.x, G = gridDim.x, nround = G == 256 ? 12 : (3072 - bid + G - 1) / G;
    auto item_of = [&](int i) { return G == 256 ? ((i * 16 + (bid & 7) * 2 + (bid >> 7)) * 16 + ((bid >> 3) & 15)) : bid + i * G; };
    if (nround > 0) attn_issue(p, item_of(0), pre);
    for (int i = 0; i < nround; ++i) {
        const int it = item_of(i);
        lds_sync();
        attn_commit(lds, pre, p, it);
        bf16x8 qf[4];
#pragma unroll
        for (int ks = 0; ks < 4; ++ks) qf[ks] = pre.q[ks];
        if (i + 1 < nround) attn_issue(p, item_of(i + 1), pre);
        lds_sync();
        attn_compute(p, lds, it, qf);
    }
    lds_sync();
}
DI void attn_sample_item(const Params& p, LAS unsigned char* lds, int witem) {
    const int lane = TID() & 63, wid = TID() >> 6;
    const int h = witem & 7, l = (witem >> 3) & 7, bg = witem >> 6, g = bg % 3, b = bg / 3;
    const int d = 1 << (2 * g), Lbuf = 128 << (2 * g);
    const float* cache = p.in[I_C128 + g] + (size_t)b * Lbuf * 2048;
    const float* fresh = p.out + (g == 0 ? O_KVS0 : (g == 1 ? O_KVS1 : O_KVS2)) + (size_t)b * 8 * 2048;
    const int row = MP + b * 8 + l;
    const bf16_t* qp = (const bf16_t*)(p.ws + WS_P1) + (size_t)row * 10240 + g * 1024 + h * 128;
    LAS float* sc = (LAS float*)lds + wid * 136;
    const int sub = lane & 15, kq = lane >> 4;
    float q[8];
    { const u32x2 a = *(const u32x2*)(qp + sub * 4), c = *(const u32x2*)(qp + 64 + sub * 4);
      q[0] = bflo(a.x); q[1] = bfhi(a.x); q[2] = bflo(a.y); q[3] = bfhi(a.y); q[4] = bflo(c.x); q[5] = bfhi(c.x); q[6] = bflo(c.y); q[7] = bfhi(c.y); }
#pragma unroll 1
    for (int bt = 0; bt < 4; ++bt) {
        f32x4 ka[8], kb[8];
#pragma unroll
        for (int u = 0; u < 8; ++u) {
            const int mk = (bt * 8 + u) * 4 + kq, idx = Lbuf + l - d * mk;
            const float* kr = (idx >= Lbuf ? fresh + (size_t)(idx - Lbuf) * 2048 : cache + (size_t)idx * 2048) + h * 128 + sub * 4;
            ka[u] = *(const f32x4*)kr; kb[u] = *(const f32x4*)(kr + 64);
        }
        asm volatile("" ::: "memory");
        float dots[8];
#pragma unroll
        for (int u = 0; u < 8; ++u) dots[u] = q[0] * ka[u][0] + q[1] * ka[u][1] + q[2] * ka[u][2] + q[3] * ka[u][3] + q[4] * kb[u][0] + q[5] * kb[u][1] + q[6] * kb[u][2] + q[7] * kb[u][3];
#pragma unroll
        for (int u = 0; u < 8; ++u) dots[u] = row16_sum(dots[u]);
#pragma unroll
        for (int u = 0; u < 8; ++u) sc[(bt * 8 + u) * 4 + kq] = dots[u];
    }
    {
        const int idx = Lbuf + l - d * 128;
        const float* kr = cache + (size_t)idx * 2048 + h * 128 + sub * 4;
        const f32x4 k0 = *(const f32x4*)kr, k1 = *(const f32x4*)(kr + 64);
        float dot = q[0] * k0[0] + q[1] * k0[1] + q[2] * k0[2] + q[3] * k0[3] + q[4] * k1[0] + q[5] * k1[1] + q[6] * k1[2] + q[7] * k1[3];
        dot = row16_sum(dot);
        sc[128 + kq] = dot;
    }
    __builtin_amdgcn_s_waitcnt(0xc07f);
    __builtin_amdgcn_wave_barrier();
    const float s0 = sc[lane], s1 = sc[64 + lane], s2 = lane == 0 ? sc[128] : -INFINITY;
    const float m = wave_max(fmaxf(fmaxf(s0, s1), s2));
    const float p0 = exp2f(s0 - m), p1 = exp2f(s1 - m), p2 = lane == 0 ? exp2f(s2 - m) : 0.f;
    const float lsum = wave_sum(p0 + p1 + p2);
    __builtin_amdgcn_wave_barrier();
    sc[lane] = p0; sc[64 + lane] = p1; if (lane == 0) sc[128] = p2;
    __builtin_amdgcn_s_waitcnt(0xc07f);
    __builtin_amdgcn_wave_barrier();
    const int half = lane >> 5, l32 = lane & 31;
    f32x4 o = {0.f, 0.f, 0.f, 0.f};
#pragma unroll 1
    for (int bt = 0; bt < 8; ++bt) {
        f32x4 vb[8]; float pw[8];
#pragma unroll
        for (int u = 0; u < 8; ++u) {
            const int mk = 2 * (bt * 8 + u) + half, idx = Lbuf + l - d * mk;
            const float* vr = (idx >= Lbuf ? fresh + (size_t)(idx - Lbuf) * 2048 : cache + (size_t)idx * 2048) + 1024 + h * 128 + l32 * 4;
            vb[u] = *(const f32x4*)vr; pw[u] = sc[mk];
        }
        asm volatile("" ::: "memory");
#pragma unroll
        for (int u = 0; u < 8; ++u) o += pw[u] * vb[u];
    }
    { const int idx = Lbuf + l - d * 128;
      const f32x4 v = *(const f32x4*)(cache + (size_t)idx * 2048 + 1024 + h * 128 + l32 * 4); const float pw = half ? 0.f : sc[128];
      o += pw * v; }
    o[0] += __shfl_xor(o[0], 32); o[1] += __shfl_xor(o[1], 32); o[2] += __shfl_xor(o[2], 32); o[3] += __shfl_xor(o[3], 32);
    const float il = 1.f / lsum;
    if (half == 0) { u32x2 w; w.x = pk2(o[0] * il, o[1] * il); w.y = pk2(o[2] * il, o[3] * il);
        *(u32x2*)((bf16_t*)(p.ws + WS_OG) + ((size_t)g * MT + row) * 1024 + h * 128 + l32 * 4) = w; }
    if (lane == 0) ((float*)(p.ws + WS_LSE))[((size_t)g * MT + row) * 8 + h] = 0.6931471805599453f * (m + log2f(lsum));
    __builtin_amdgcn_wave_barrier();
}
DI void attn_sample_all(const Params& p, LAS unsigned char* lds) {
    const int bid = blockIdx.x, G = gridDim.x, wv = TID() >> 6;
    if (G == 256) { for (int i = 0; i < 3; ++i) { const int bg = i * 32 + (bid & 7) * 4 + (bid >> 6), l = (bid >> 3) & 7; attn_sample_item(p, lds, (bg * 8 + l) * 8 + wv); } }
    else for (int it = bid; it < 768; it += G) attn_sample_item(p, lds, it * 8 + wv);
}
DI void phase_attn(const Params& p, LAS unsigned char* lds) {
    if (blockIdx.x & 1) { attn_sample_all(p, lds); __syncthreads(); }
    attn_prompt_all(p, lds);
    if (!(blockIdx.x & 1)) attn_sample_all(p, lds);
}

DI void phase_gate1(const Params& p) {
    const int lane = TID() & 63, wid = TID() >> 6;
    const bf16_t* OG = (const bf16_t*)(p.ws + WS_OG); const bf16_t* P1 = (const bf16_t*)(p.ws + WS_P1); const float* LSE = (const float*)(p.ws + WS_LSE);
    bf16_t* ACT = (bf16_t*)(p.ws + WS_ACT);
    const int nw = gridDim.x * 8, hd = lane >> 3;
    auto ld_row = [&](int row, u32x4 (&r)[8], float (&ls)[3]) {
#pragma unroll
        for (int g = 0; g < 3; ++g) { const u32x4* so = (const u32x4*)(OG + ((size_t)g * MT + row) * 1024 + lane * 16); r[2 * g] = so[0]; r[2 * g + 1] = so[1]; ls[g] = LSE[((size_t)g * MT + row) * 8 + hd]; }
        const u32x4* sz = (const u32x4*)(P1 + (size_t)row * 10240 + 9216 + lane * 16); r[6] = sz[0]; r[7] = sz[1];
    };
    auto do_row = [&](int row, const u32x4 (&r)[8], const float (&ls)[3]) {
        const float mx = fmaxf(ls[0], fmaxf(ls[1], ls[2]));
        float w[3] = {__expf(ls[0] - mx), __expf(ls[1] - mx), __expf(ls[2] - mx)};
        const float iw = 1.f / (w[0] + w[1] + w[2]);
        float acc[16];
#pragma unroll
        for (int j = 0; j < 16; ++j) acc[j] = 0.f;
#pragma unroll
        for (int g = 0; g < 3; ++g) {
            const float wg = w[g] * iw;
#pragma unroll
            for (int q = 0; q < 2; ++q) { const u32x4 a = r[2 * g + q];
                acc[q * 8] += wg * bflo(a.x); acc[q * 8 + 1] += wg * bfhi(a.x); acc[q * 8 + 2] += wg * bflo(a.y); acc[q * 8 + 3] += wg * bfhi(a.y);
                acc[q * 8 + 4] += wg * bflo(a.z); acc[q * 8 + 5] += wg * bfhi(a.z); acc[q * 8 + 6] += wg * bflo(a.w); acc[q * 8 + 7] += wg * bfhi(a.w); }
        }
        float z[16];
#pragma unroll
        for (int q = 0; q < 2; ++q) { const u32x4 b = r[6 + q];
            z[q * 8] = bflo(b.x); z[q * 8 + 1] = bfhi(b.x); z[q * 8 + 2] = bflo(b.y); z[q * 8 + 3] = bfhi(b.y); z[q * 8 + 4] = bflo(b.z); z[q * 8 + 5] = bfhi(b.z); z[q * 8 + 6] = bflo(b.w); z[q * 8 + 7] = bfhi(b.w); }
        float rr[16];
#pragma unroll
        for (int j = 0; j < 16; ++j) rr[j] = acc[j] * siluf(z[j]);
        u32x4 w0, w1;
        w0.x = pk2(rr[0], rr[1]); w0.y = pk2(rr[2], rr[3]); w0.z = pk2(rr[4], rr[5]); w0.w = pk2(rr[6], rr[7]);
        w1.x = pk2(rr[8], rr[9]); w1.y = pk2(rr[10], rr[11]); w1.z = pk2(rr[12], rr[13]); w1.w = pk2(rr[14], rr[15]);
        u32x4* d = (u32x4*)(ACT + (size_t)row * 1024 + lane * 16); d[0] = w0; d[1] = w1;
    };
    for (int row = blockIdx.x * 8 + wid; row < MT; row += 2 * nw) {
        u32x4 ra[8], rb[8]; float la[3], lb[3];
        const int rowb = row + nw;
        ld_row(row, ra, la);
        if (rowb < MT) { ld_row(rowb, rb, lb); pin8x8(ra, rb); }
        do_row(row, ra, la);
        if (rowb < MT) do_row(rowb, rb, lb);
    }
}

DI void phase_final(const Params& p) {
    const int lane = TID() & 63, wid = TID() >> 6;
    const float* fg = p.in[I_FNG];
    const int nw = gridDim.x * 8;
    auto ld_row = [&](int row, f32x4 (&v)[4]) {
        const float* x = p.out + (size_t)row * 1024;
#pragma unroll
        for (int i = 0; i < 4; ++i) v[i] = *(const f32x4*)(x + lane * 4 + 256 * i);
    };
    f32x4 gg[4];
#pragma unroll
    for (int i = 0; i < 4; ++i) gg[i] = *(const f32x4*)(fg + lane * 4 + 256 * i);
    auto do_row = [&](int row, const f32x4 (&v)[4]) {
        float* x = p.out + (size_t)row * 1024;
        float ss = 0.f;
#pragma unroll
        for (int i = 0; i < 4; ++i) ss += v[i][0] * v[i][0] + v[i][1] * v[i][1] + v[i][2] * v[i][2] + v[i][3] * v[i][3];
        ss = wave_sum(ss);
        const float rstd = rsqrtf(ss * (1.f / 1024.f) + EPS);
#pragma unroll
        for (int i = 0; i < 4; ++i) *(f32x4*)(x + lane * 4 + 256 * i) = v[i] * rstd * gg[i];
    };
    for (int row = blockIdx.x * 8 + wid; row < MT; row += 4 * nw) {
        f32x4 va[4], vb[4], vc[4], vd[4];
        const int r1 = row + nw, r2 = row + 2 * nw, r3 = row + 3 * nw;
        if (r3 < MT) { ld_row(row, va); ld_row(r1, vb); ld_row(r2, vc); ld_row(r3, vd); pin4x4x4x4(va, vb, vc, vd); do_row(row, va); do_row(r1, vb); do_row(r2, vc); do_row(r3, vd); }
        else { ld_row(row, va); do_row(row, va); if (r1 < MT) { ld_row(r1, vb); do_row(r1, vb); } if (r2 < MT) { ld_row(r2, vc); do_row(r2, vc); } }
    }
}

#define XB_TMO      128
#define XB_XCNT(j)  (256  + 64 * (j))
#define XB_XSUB(j)  (1280 + 64 * (j))
#define XB_XGEN(j)  (2304 + 64 * (j))
#define XB_TOP      3328
#define XB_TOPGEN   3392
#define XCD_BAR_WORDS 3456
#define XB_SPIN_CAP (1u << 20)
DI unsigned xb_ld(unsigned* p)              { return __hip_atomic_load(p, __ATOMIC_RELAXED, __HIP_MEMORY_SCOPE_AGENT); }
DI unsigned xb_add(unsigned* p, unsigned v) { return __hip_atomic_fetch_add(p, v, __ATOMIC_RELAXED, __HIP_MEMORY_SCOPE_AGENT); }
DI unsigned xb_xcc_id() { return (unsigned)__builtin_amdgcn_s_getreg((3 << 11) | 20) & 0xFu; }
#define XB_SPIN(cond, bar) do { unsigned _sp = 0; while (cond) { __builtin_amdgcn_s_sleep(1); \
    if ((++_sp & 255u) == 0u) { if (xb_ld(&(bar)[XB_TMO])) break; if (_sp > XB_SPIN_CAP) { atomicAdd(&(bar)[XB_TMO], 1u); break; } } } } while (0)
struct XcdBarrier { unsigned* bar; unsigned x; volatile LAS unsigned* st; };
DI XcdBarrier xcd_barrier_post(unsigned* bar, volatile LAS unsigned* st) {
    XcdBarrier b; b.bar = bar; b.x = xb_xcc_id(); b.st = st;
    if (threadIdx.x == 0) (void)xb_add(&bar[XB_XCNT(b.x)], 1u);
    return b;
}
DI void xcd_barrier_complete(unsigned* bar, unsigned x, unsigned& nloc, unsigned& nx) {
    const unsigned G = gridDim.x * gridDim.y * gridDim.z;
    unsigned sum, cnt, mine, sp = 0u;
    for (;;) {
        sum = 0u; cnt = 0u; mine = 0u;
#pragma unroll
        for (unsigned j = 0; j < 16; ++j) { const unsigned c = xb_ld(&bar[XB_XCNT(j)]); sum += c; cnt += (c > 0u) ? 1u : 0u; mine = (j == x) ? c : mine; }
        if (sum == G) break;
        __builtin_amdgcn_s_sleep(1);
        if ((++sp & 255u) == 0u) { if (xb_ld(&bar[XB_TMO])) break; if (sp > XB_SPIN_CAP) { atomicAdd(&bar[XB_TMO], 1u); break; } }
    }
    nloc = mine > 0u ? mine : 1u; nx = cnt > 0u ? cnt : 1u;
}
DI void xcd_barrier(const XcdBarrier& b) {
    asm volatile("s_waitcnt vmcnt(0)" ::: "memory");
    __syncthreads();
    if (threadIdx.x == 0) {
        unsigned* bar = b.bar;
        __builtin_amdgcn_s_waitcnt(0);
        unsigned nloc = b.st[0], nx = b.st[1];
        if (nloc == 0u) { xcd_barrier_complete(bar, b.x, nloc, nx); b.st[0] = nloc; b.st[1] = nx; }
        const unsigned old = xb_add(&bar[XB_XSUB(b.x)], 1u);
        const unsigned gen = old / nloc;
        if (old + 1u == (gen + 1u) * nloc) {
            __builtin_amdgcn_fence(__ATOMIC_RELEASE, "agent");
            asm volatile("s_waitcnt vmcnt(0)" ::: "memory");
            const unsigned og = xb_add(&bar[XB_TOP], 1u);
            const unsigned tg = og / nx;
            if (og + 1u == (tg + 1u) * nx) xb_add(&bar[XB_TOPGEN], 1u);
            else XB_SPIN(xb_ld(&bar[XB_TOPGEN]) == tg, bar);
            __builtin_amdgcn_fence(__ATOMIC_ACQUIRE, "agent");
            xb_add(&bar[XB_XGEN(b.x)], 1u);
            asm volatile("s_waitcnt vmcnt(0)" ::: "memory");
        } else {
            XB_SPIN(xb_ld(&bar[XB_XGEN(b.x)]) == gen, bar);
            __builtin_amdgcn_fence(__ATOMIC_ACQUIRE, "agent");
            asm volatile("s_waitcnt vmcnt(0)" ::: "memory");
        }
    }
    __syncthreads();
}

#ifndef EXTRA_SYNCS
#define EXTRA_SYNCS 0
#endif

#ifndef DUP_MASK
#define DUP_MASK 0u
#endif
__global__ void __launch_bounds__(512, 2) hybrid_fwd(Params p) {
    extern __shared__ __attribute__((aligned(16))) unsigned char shm[];
    LAS unsigned char* lds = (LAS unsigned char*)shm;
    cg::grid_group grid = cg::this_grid();
    const float* MOD = (const float*)(p.ws + WS_MOD);
    bf16_t* ACT = (bf16_t*)(p.ws + WS_ACT);
    bf16_t* X1 = (bf16_t*)(p.ws + WS_X1);
    if (p.ws == nullptr) grid.sync();
    volatile LAS unsigned* xst = (volatile LAS unsigned*)(lds + LDS_BYTES - 16);
    if (threadIdx.x == 0) { xst[0] = 0u; xst[1] = 0u; }
    __syncthreads();
    const XcdBarrier xb = xcd_barrier_post((unsigned*)(p.ws + WS_BAR), xst);

    for (int rep = 0; rep < EXTRA_SYNCS; ++rep) xcd_barrier(xb);
    for (int rep = 0; rep < 1 + (int)((DUP_MASK >> 0) & 1u); ++rep) {
    phase_prep(p, lds);
    xcd_barrier(xb);
    }
    for (int rep = 0; rep < 1 + (int)((DUP_MASK >> 1) & 1u); ++rep) {
    phase_norm<true>(p, lds, p.in[I_XP], p.in[I_XS], 0);
    xcd_barrier(xb);
    }
    for (int rep = 0; rep < 1 + (int)((DUP_MASK >> 2) & 1u); ++rep) {
    { EpiA e{(bf16_t*)(p.ws + WS_P0), p.out}; gemm_all(lds, ACT, (const bf16_t*)(p.ws + WS_WTA), 4096, e); }
    xcd_barrier(xb);
    }
    for (int rep = 0; rep < 1 + (int)((DUP_MASK >> 3) & 1u); ++rep) {
    phase_dprep(p, lds);
    xcd_barrier(xb);
    }
    for (int rep = 0; rep < 1 + (int)((DUP_MASK >> 4) & 1u); ++rep) {
    phase_scan(p, lds);
    xcd_barrier(xb);
    }
    for (int rep = 0; rep < 1 + (int)((DUP_MASK >> 5) & 1u); ++rep) {
    phase_gate0(p);
    xcd_barrier(xb);
    }
    for (int rep = 0; rep < 1 + (int)((DUP_MASK >> 6) & 1u); ++rep) {
    { EpiRes<float, bf16_t> e{p.in[I_XP], p.in[I_XS], MOD, X1}; gemm_all(lds, ACT, (const bf16_t*)(p.ws + WS_WTAO), 1024, e); }
    xcd_barrier(xb);
    }
    for (int rep = 0; rep < 1 + (int)((DUP_MASK >> 7) & 1u); ++rep) {
    phase_norm1(p);
    xcd_barrier(xb);
    }
    for (int rep = 0; rep < 1 + (int)((DUP_MASK >> 8) & 1u); ++rep) {
    { EpiB e{(bf16_t*)(p.ws + WS_P1), p.out}; gemm_all(lds, ACT, (const bf16_t*)(p.ws + WS_WTB), 10240, e); }
    xcd_barrier(xb);
    }
    for (int rep = 0; rep < 1 + (int)((DUP_MASK >> 9) & 1u); ++rep) {
    phase_attn(p, lds);
    xcd_barrier(xb);
    }
    for (int rep = 0; rep < 1 + (int)((DUP_MASK >> 10) & 1u); ++rep) {
    phase_gate1(p);
    xcd_barrier(xb);
    }
    for (int rep = 0; rep < 1 + (int)((DUP_MASK >> 11) & 1u); ++rep) {
    { EpiRes<bf16_t, float> e{X1, X1 + (size_t)MP * 1024, MOD + 40 * 3072, p.out}; gemm_all(lds, ACT, (const bf16_t*)(p.ws + WS_WTBO), 1024, e); }
    xcd_barrier(xb);
    }
    phase_final(p);
}

extern "C" void kernel_launch(void* const* d_in, const int* in_sizes, int n_in, void* d_out, int out_size, void* d_ws, size_t ws_size, hipStream_t stream) {
    static int grid_blocks = 0;
    if (!grid_blocks) {
        if (n_in != 21 || ws_size < WS_END) { fprintf(stderr, "kernel_launch: unexpected inputs (n_in %d, ws %zu < %zu)\n", n_in, ws_size, (size_t)WS_END); grid_blocks = -1; return; }
        int dev = 0, cus = 0, per_cu = 0;
        hipGetDevice(&dev);
        hipDeviceGetAttribute(&cus, hipDeviceAttributeMultiprocessorCount, dev);
        if (hipFuncSetAttribute((const void*)hybrid_fwd, hipFuncAttributeMaxDynamicSharedMemorySize, LDS_BYTES) != hipSuccess) { fprintf(stderr, "kernel_launch: hipFuncSetAttribute failed\n"); }
        hipOccupancyMaxActiveBlocksPerMultiprocessor(&per_cu, (const void*)hybrid_fwd, 512, LDS_BYTES);
        per_cu = 1;
        grid_blocks = cus * per_cu;
    }
    if (grid_blocks < 0) return;
    Params p{};
    for (int i = 0; i < 21; ++i) p.in[i] = (const float*)d_in[i];
    p.out = (float*)d_out; p.ws = (unsigned char*)d_ws;
    if (hipMemsetAsync((unsigned char*)d_ws + WS_BAR, 0, XCD_BAR_WORDS * 4, stream) != hipSuccess) { fprintf(stderr, "kernel_launch: memset of barrier words failed\n"); return; }
    void* args[] = {&p};
    hipError_t e = hipLaunchCooperativeKernel((const void*)hybrid_fwd, dim3(grid_blocks), dim3(512), args, LDS_BYTES, stream);
    if (e != hipSuccess) fprintf(stderr, "cooperative launch failed: %s (grid %d)\n", hipGetErrorString(e), grid_blocks);
}
```
